# Optimizing an MI355X kernel written in HIP

```python
import jax, jax.numpy as jnp
from jax import lax
import numpy as np

D_MODEL = 1024
BATCH = 16
SEQ = 2048
DEPTH = 4

N_EVEN = (DEPTH + 1) // 2
N_ODD = DEPTH // 2
EPS = 1e-6

RET_HEADS = 4
RET_DK = 64
RET_DV = 128
RET_CHUNK = 128
ROPE_BASE = 10000.0
SB_HEADS = 8
SB_DH = 64
SB_BLOCK = 128
HG_HEADS = 4
HG_DK = 128
HG_DV = 128
HG_CHUNK = 16
LRU_WIDTH = 512
LRU_BLOCKS = 8
LRU_BW = LRU_WIDTH // LRU_BLOCKS
CONV_W = 4
LRU_C = 8.0

RET_QK = RET_HEADS * RET_DK
RET_V = RET_HEADS * RET_DV
SB_W = SB_HEADS * SB_DH
EVEN_SIZES = (RET_QK, RET_QK, RET_V, RET_V, SB_W, SB_W, SB_W, SB_W)
EVEN_IN = sum(EVEN_SIZES)
EVEN_MIX = RET_V + SB_W
HG_KW = HG_HEADS * HG_DK
HG_VW = HG_HEADS * HG_DV
ODD_SIZES = (HG_KW, HG_KW, HG_VW, HG_VW, LRU_WIDTH, LRU_WIDTH)
ODD_IN = sum(ODD_SIZES)
ODD_MIX = HG_VW + LRU_WIDTH

kernel_name = 'hybrid_retention_stickbreak_hgrn2_rglru'


def split_cols(a, sizes):
    idx = [int(v) for v in np.cumsum(sizes)[:-1]]
    return jnp.split(a, idx, axis=-1)


def rms_norm(x, w=None):
    xf = x.astype(jnp.float32)
    y = xf * lax.rsqrt(jnp.mean(xf * xf, axis=-1, keepdims=True) + EPS)
    if w is not None:
        y = y * w.astype(jnp.float32)
    return y


def rotary(x):
    S, D = x.shape[1], x.shape[-1]
    half = D // 2
    inv = ROPE_BASE ** (-jnp.arange(half, dtype=jnp.float32) / half)
    ang = jnp.arange(S, dtype=jnp.float32)[:, None] * inv[None, :]
    cos = jnp.cos(ang)[None, :, None, :]
    sin = jnp.sin(ang)[None, :, None, :]
    x1, x2 = x[..., :half], x[..., half:]
    return jnp.concatenate([x1 * cos - x2 * sin, x1 * sin + x2 * cos], axis=-1)


def retention(q, k, v):
    B, S, H, dk = q.shape
    dv = v.shape[-1]
    C = RET_CHUNK
    N = S // C
    f32 = jnp.float32
    log_g = jnp.log(1.0 - 2.0 ** (-5.0 - jnp.arange(H, dtype=f32)))
    q = rotary(q.astype(f32))
    k = rotary(k.astype(f32)) * (dk ** -0.5)
    v = v.astype(f32)
    to_chunks = lambda a: a.reshape(B, N, C, H, a.shape[-1]).transpose(0, 3, 1, 2, 4)
    qc, kc, vc = to_chunks(q), to_chunks(k), to_chunks(v)
    pos = jnp.arange(C, dtype=f32)
    dist = pos[:, None] - pos[None, :]
    decay = jnp.where(dist >= 0, jnp.exp(log_g[:, None, None] * jnp.maximum(dist, 0.0)), 0.0)
    scores = jnp.einsum('bhnid,bhnjd->bhnij', qc, kc) * decay[None, :, None]
    o_intra = jnp.einsum('bhnij,bhnje->bhnie', scores, vc)
    k_decay = jnp.exp(log_g[:, None] * (C - 1.0 - pos)[None, :])
    q_decay = jnp.exp(log_g[:, None] * (pos + 1.0)[None, :])
    chunk_kv = jnp.einsum('bhnjd,hj,bhnje->nbhde', kc, k_decay, vc)
    g_chunk = jnp.exp(log_g * C)[None, :, None, None]

    def step(state, kv):
        return state * g_chunk + kv, state

    _, r_prev = lax.scan(step, jnp.zeros((B, H, dk, dv), f32), chunk_kv)
    o_inter = jnp.einsum('bhnid,hi,nbhde->bhnie', qc, q_decay, r_prev)
    return (o_intra + o_inter).transpose(0, 2, 3, 1, 4).reshape(B, S, H, dv)


def stick_breaking(q, k, v):
    B, S, H, d = q.shape
    f32 = jnp.float32
    qf, kf, vf = q.astype(f32), k.astype(f32), v.astype(f32)
    scale = d ** -0.5
    outs = []
    for blk in range(S // SB_BLOCK):
        q0 = blk * SB_BLOCK
        kend = q0 + SB_BLOCK
        z = jnp.einsum('bthd,bshd->bhts', qf[:, q0:kend], kf[:, :kend]) * scale
        t_idx = q0 + jnp.arange(SB_BLOCK)[:, None]
        s_idx = jnp.arange(kend)[None, :]
        strict = s_idx < t_idx
        log_beta = jax.nn.log_sigmoid(z)
        log_one_minus = jnp.where(strict, jax.nn.log_sigmoid(-z), 0.0)
        suffix = lax.cumsum(log_one_minus, axis=3, reverse=True) - log_one_minus
        w = jnp.where(strict, jnp.exp(log_beta + suffix), 0.0)
        outs.append(jnp.einsum('bhts,bshd->bthd', w, vf[:, :kend]))
    return jnp.concatenate(outs, axis=1)


def hgrn2(q, f_logit, i, lb):
    B, S, H, dk = q.shape
    dv = i.shape[-1]
    C = HG_CHUNK
    N = S // C
    f32 = jnp.float32
    lb = lb.reshape(H, dk).astype(f32)
    f_logit = f_logit.astype(f32)
    log_f = jnp.logaddexp(jnp.log(lb), jnp.log1p(-lb) + jax.nn.log_sigmoid(f_logit))
    k = (1.0 - lb) * jax.nn.sigmoid(-f_logit)
    to_chunks = lambda a: a.reshape(B, N, C, H, a.shape[-1]).transpose(1, 0, 3, 2, 4)
    xs = (to_chunks(q.astype(f32)), to_chunks(k), to_chunks(log_f), to_chunks(i.astype(f32)))
    tril = jnp.tril(jnp.ones((C, C), dtype=bool))[:, :, None]

    def step(state, inp):
        qc, kc, lfc, vc = inp
        b = jnp.cumsum(lfc, axis=2)
        diff = b[:, :, :, None, :] - b[:, :, None, :, :]
        decay = jnp.exp(jnp.where(tril, diff, -jnp.inf))
        attn = jnp.einsum('bhtk,bhtsk,bhsk->bhts', qc, decay, kc)
        o = jnp.einsum('bhts,bhsv->bhtv', attn, vc) + jnp.einsum('bhtk,bhkv->bhtv', qc * jnp.exp(b), state)
        b_last = b[:, :, -1:, :]
        state = state * jnp.exp(b_last[:, :, 0, :, None]) + jnp.einsum('bhsk,bhsv->bhkv', kc * jnp.exp(b_last - b), vc)
        return state, o

    _, o = lax.scan(step, jnp.zeros((B, H, dk, dv), f32), xs)
    return o.transpose(1, 0, 3, 2, 4).reshape(B, S, H, dv)


def causal_conv(x, w, b):
    S = x.shape[1]
    xp = jnp.pad(x, ((0, 0), (CONV_W - 1, 0), (0, 0)))
    y = b[None, None, :] + xp[:, 0:S] * w[0]
    for j in range(1, CONV_W):
        y = y + xp[:, j:j + S] * w[j]
    return y


def rg_lru(x, w_a, b_a, w_x, b_x, lam):
    B, S, W = x.shape
    xb = x.reshape(B, S, LRU_BLOCKS, LRU_BW)
    r = jax.nn.sigmoid(jnp.einsum('bsni,nij->bsnj', xb, w_a).reshape(B, S, W) + b_a)
    ig = jax.nn.sigmoid(jnp.einsum('bsni,nij->bsnj', xb, w_x).reshape(B, S, W) + b_x)
    log_a = -LRU_C * r * jax.nn.softplus(-lam)
    a = jnp.exp(log_a)
    mult = jnp.sqrt(-jnp.expm1(2.0 * log_a))
    mult = jnp.where(jnp.arange(S)[None, :, None] == 0, 1.0, mult)
    u = mult * ig * x

    def combine(left, right):
        a1, b1 = left
        a2, b2 = right
        return a1 * a2, a2 * b1 + b2

    _, h = lax.associative_scan(combine, (a, u), axis=1)
    return h


def even_mixer(h, w_in, w_out):
    B, S, _ = h.shape
    proj = jnp.einsum('bsd,de->bse', h.astype(w_in.dtype), w_in).astype(jnp.float32)
    rq, rk, rv, rg, sq, sk, sv, sg = split_cols(proj, EVEN_SIZES)
    ret = retention(rq.reshape(B, S, RET_HEADS, RET_DK), rk.reshape(B, S, RET_HEADS, RET_DK),
                    rv.reshape(B, S, RET_HEADS, RET_DV))
    ret = rms_norm(ret).reshape(B, S, RET_V) * jax.nn.silu(rg)
    sb = stick_breaking(sq.reshape(B, S, SB_HEADS, SB_DH), sk.reshape(B, S, SB_HEADS, SB_DH),
                        sv.reshape(B, S, SB_HEADS, SB_DH))
    sb = sb.reshape(B, S, SB_W) * jax.nn.silu(sg)
    mix = jnp.concatenate([ret, sb], axis=-1)
    return jnp.einsum('bse,ed->bsd', mix.astype(w_out.dtype), w_out)


def odd_mixer(h, w_in, w_out, lb, conv_w, conv_b, w_a, b_a, w_x, b_x, lam):
    B, S, _ = h.shape
    f32 = jnp.float32
    proj = jnp.einsum('bsd,de->bse', h.astype(w_in.dtype), w_in).astype(f32)
    hq, hf, hi, hg, lx, lg = split_cols(proj, ODD_SIZES)
    hc = hgrn2(hq.reshape(B, S, HG_HEADS, HG_DK), hf.reshape(B, S, HG_HEADS, HG_DK),
               hi.reshape(B, S, HG_HEADS, HG_DV), lb)
    hc = rms_norm(hc).reshape(B, S, HG_VW) * jax.nn.silu(hg)
    xc = causal_conv(lx, conv_w.astype(f32), conv_b.astype(f32))
    hl = rg_lru(xc, w_a.astype(f32), b_a.astype(f32), w_x.astype(f32), b_x.astype(f32), lam.astype(f32))
    hl = hl * jax.nn.silu(lg)
    mix = jnp.concatenate([hc, hl], axis=-1)
    return jnp.einsum('bse,ed->bsd', mix.astype(w_out.dtype), w_out)


def setup_inputs(seed: int = 0) -> dict:
    key = jax.random.key(seed)
    ks = jax.random.split(key, 16)
    f32 = jnp.float32
    nrm = lambda k, shape, s: jax.random.normal(k, shape, f32) * s
    u = jax.random.uniform(ks[15], (N_ODD, LRU_WIDTH), f32, 0.9, 0.999)
    a0 = u ** (1.0 / LRU_C)
    return {
        'x': nrm(ks[0], (BATCH, SEQ, D_MODEL), 1.0),
        'pre_norm_w': 1.0 + nrm(ks[1], (DEPTH, D_MODEL), 0.02),
        'post_norm_w': 1.0 + nrm(ks[2], (DEPTH, D_MODEL), 0.02),
        'even_w_in': nrm(ks[3], (N_EVEN, D_MODEL, EVEN_IN), D_MODEL ** -0.5),
        'even_w_out': nrm(ks[4], (N_EVEN, EVEN_MIX, D_MODEL), EVEN_MIX ** -0.5),
        'odd_w_in': nrm(ks[5], (N_ODD, D_MODEL, ODD_IN), D_MODEL ** -0.5),
        'odd_w_out': nrm(ks[6], (N_ODD, ODD_MIX, D_MODEL), ODD_MIX ** -0.5),
        'hgrn_lb_logits': nrm(ks[7], (N_ODD, HG_KW), 1.0),
        'conv_w': nrm(ks[8], (N_ODD, CONV_W, LRU_WIDTH), CONV_W ** -0.5),
        'conv_b': nrm(ks[9], (N_ODD, LRU_WIDTH), 0.01),
        'lru_w_a': nrm(ks[10], (N_ODD, LRU_BLOCKS, LRU_BW, LRU_BW), LRU_BW ** -0.5),
        'lru_b_a': nrm(ks[11], (N_ODD, LRU_WIDTH), 0.01),
        'lru_w_x': nrm(ks[12], (N_ODD, LRU_BLOCKS, LRU_BW, LRU_BW), LRU_BW ** -0.5),
        'lru_b_x': nrm(ks[13], (N_ODD, LRU_WIDTH), 0.01),
        'lru_lambda': jnp.log(a0) - jnp.log1p(-a0),
    }


def reference(x, pre_norm_w, post_norm_w, even_w_in, even_w_out, odd_w_in, odd_w_out,
              hgrn_lb_logits, conv_w, conv_b, lru_w_a, lru_b_a, lru_w_x, lru_b_x, lru_lambda):
    cum = jnp.cumsum(jax.nn.softmax(hgrn_lb_logits.astype(jnp.float32), axis=0), axis=0)
    lower_bounds = cum - cum[0:1]
    for layer in range(DEPTH):
        h = rms_norm(x, pre_norm_w[layer])
        if layer % 2 == 0:
            e = layer // 2
            y = even_mixer(h, even_w_in[e], even_w_out[e])
        else:
            o = layer // 2
            y = odd_mixer(h, odd_w_in[o], odd_w_out[o], lower_bounds[o], conv_w[o], conv_b[o],
                          lru_w_a[o], lru_b_a[o], lru_w_x[o], lru_b_x[o], lru_lambda[o])
        x = x + rms_norm(y, post_norm_w[layer]).astype(x.dtype)
    return x
```

```cpp
#include <hip/hip_runtime.h>
#include <cstdio>
#include <cstdint>
#include <cmath>
namespace pg8 {
#define PG8_LAS __attribute__((address_space(3)))
typedef unsigned short bf16_t;
typedef short bf16x8 __attribute__((ext_vector_type(8)));
typedef float f32x4 __attribute__((ext_vector_type(4)));
typedef unsigned u32x4 __attribute__((ext_vector_type(4)));
constexpr int BM = 256, BK = 64, HALF = 128, HTB = HALF * BK * 2  , STAGE_BYTES = 8 * HTB, NXCD = 8, WGM = 8;

__host__ __device__ __forceinline__ int lds_byte(int r, int c) { const int st = (r >> 4) * 2 + (c >> 5), rr = r & 15, cc = c & 31, ob = rr * 64 + cc * 2; return st * 1024 + (ob ^ (((ob >> 9) & 1) << 5)); }
__host__ __device__ __forceinline__ void stage_rc(int b, int& R, int& C) { const int st = b / 1024, sb = b % 1024, swz = sb ^ (((sb >> 9) & 1) << 5); R = (st >> 1) * 16 + swz / 64; C = (st & 1) * 32 + (swz % 64) / 2; }
__host__ __device__ __forceinline__ int perm32(int rho) { const int n = rho >> 4, i = rho & 15; return 8 * (i >> 2) + 4 * n + (i & 3); }

struct Unit { int pm, pn; };
struct Gemm { const bf16_t* A; const bf16_t* Bt; int M, N, K; };

struct StaticOrder {
    int nM, nN, nwg, G, c;
    __host__ __device__ void init(int M, int N, int G_, int c_) { nM = M / BM; nN = N / BM; nwg = nM * nN; G = G_; c = c_; }
    __host__ __device__ bool next(int i, Unit& u) const {
        const long L = (long)i * G + c; if (L >= nwg) return false;
        int wgid = (int)L; { const int q = nwg / NXCD, r = nwg % NXCD, xcd = wgid % NXCD, off = wgid / NXCD; wgid = (xcd < r ? xcd * (q + 1) : r * (q + 1) + (xcd - r) * q) + off; }
        const int nig = WGM * nN, gid = wgid / nig, fm = gid * WGM, gsz = (nM - fm) < WGM ? (nM - fm) : WGM;
        u.pm = fm + ((wgid % nig) % gsz); u.pn = (wgid % nig) / gsz; return true;
    }
    __device__ __forceinline__ void a_ready(const Unit&) const {}
    __device__ __forceinline__ void done(const Unit&) const {}
};

__device__ __forceinline__ unsigned cvt_pk_bf16(float lo, float hi) { unsigned r; asm volatile("v_cvt_pk_bf16_f32 %0, %1, %2" : "=v"(r) : "v"(lo), "v"(hi)); return r; }
struct EpiProj {
    static constexpr bool PERM = true, AFTER_DRAIN = false;
    bf16_t* O; int ldc; bf16_t* T0; int lo0; bf16_t* T1; int lo1; int nat;
    __device__ __forceinline__ void operator()(const f32x4 (&acc)[2][2][4][2], const Unit& u, int wr, int wc, int fr, int fq) const {
        const int row0 = u.pm * BM + wr * 64 + fr; const int colt = u.pn * BM;
        const int col0 = colt + wc * 32 + 8 * fq;
        bf16_t* T = nullptr; int cc0 = 0;
        if (colt >= lo0 && colt < lo0 + 512) { T = T0; cc0 = colt - lo0; } else if (colt >= lo1 && colt < lo1 + 512) { T = T1; cc0 = colt - lo1; }
        if (T == nullptr || nat) {
#pragma unroll
            for (int ai = 0; ai < 2; ++ai)
#pragma unroll
                for (int m = 0; m < 4; ++m) { bf16_t* rowp = O + (size_t)(row0 + ai * HALF + m * 16) * ldc + col0;
#pragma unroll
                    for (int bj = 0; bj < 2; ++bj) { const f32x4 v0 = acc[ai][bj][m][0], v1 = acc[ai][bj][m][1];
                        u32x4 w; w.x = cvt_pk_bf16(v0[0], v0[1]); w.y = cvt_pk_bf16(v0[2], v0[3]); w.z = cvt_pk_bf16(v1[0], v1[1]); w.w = cvt_pk_bf16(v1[2], v1[3]);
                        *(u32x4*)(rowp + bj * HALF) = w; } }
        }
        if (T != nullptr) {
            const int b = (u.pm * BM) >> 11; const int s0 = ((u.pm * BM) & 2047) + wr * 64 + fr;
            bf16_t* tb = T + ((size_t)(b * 512 + cc0 + wc * 32 + 8 * fq)) * 2048 + s0;
#pragma unroll
            for (int ai = 0; ai < 2; ++ai)
#pragma unroll
                for (int m = 0; m < 4; ++m)
#pragma unroll
                    for (int bj = 0; bj < 2; ++bj)
#pragma unroll
                        for (int n = 0; n < 2; ++n) { const f32x4 v = acc[ai][bj][m][n];
                            const unsigned p01 = cvt_pk_bf16(v[0], v[1]), p23 = cvt_pk_bf16(v[2], v[3]);
                            bf16_t* q = tb + (size_t)(bj * HALF + 4 * n) * 2048 + ai * HALF + m * 16;
                            q[0] = (bf16_t)(p01 & 0xffffu); q[2048] = (bf16_t)(p01 >> 16); q[2 * 2048] = (bf16_t)(p23 & 0xffffu); q[3 * 2048] = (bf16_t)(p23 >> 16); }
        }
    }
};
template <class Epi, class Sched, bool ALIGN_EPI = false, bool SP2 = false>
__device__ __forceinline__ void gemm_phase(PG8_LAS unsigned char* lds, const Gemm g, const Sched& S, const Epi& E) {
    const int tid = threadIdx.x, wid = __builtin_amdgcn_readfirstlane(tid >> 6), lane = tid & 63, wr = wid >> 2, wc = wid & 3, fr = lane & 15, fq = lane >> 4;
    const int K = g.K, nt = K / BK;
    unsigned voffA[2], voffB[2];
#pragma unroll
    for (int i = 0; i < 2; ++i) { int R, C; stage_rc(tid * 16 + i * 8192, R, C); const int Rb = Epi::PERM ? ((R & ~31) + perm32(R & 31)) : R;
        voffA[i] = (unsigned)(R * K + C) * 2u; voffB[i] = (unsigned)(Rb * K + C) * 2u; }
    const size_t kstep = (size_t)(BK * 2);
    const size_t hstep = (size_t)HALF * K * 2;
    const size_t tstep = 2 * hstep;
    const unsigned ldsw = (unsigned)wid * 1024u;
    const int aoff = lds_byte(wr * 64 + fr, fq * 8), boff = lds_byte(wc * 32 + fr, fq * 8);
#define PG8_SA(b, h) (((b) * 2 + (h)) * HTB)
#define PG8_SB(b, h) ((4 + (b) * 2 + (h)) * HTB)
#define PG8_STAGE(bufoff, gbase, voff) do { _Pragma("unroll") for (int _i = 0; _i < 2; ++_i) \
        __builtin_amdgcn_global_load_lds((const unsigned*)((const char*)(gbase) + (voff)[_i]), (PG8_LAS unsigned*)(lds + (bufoff) + ldsw + _i * 8192), 16, 0, 0); } while (0)
#define PG8_LDA(dst, b, h) do { _Pragma("unroll") for (int m = 0; m < 4; ++m) _Pragma("unroll") for (int k = 0; k < 2; ++k) dst[m][k] = *(const PG8_LAS bf16x8*)(lds + PG8_SA(b, h) + aoff + m * 2048 + k * 1024); } while (0)
#define PG8_LDB(dst, b, h) do { _Pragma("unroll") for (int n = 0; n < 2; ++n) _Pragma("unroll") for (int k = 0; k < 2; ++k) dst[n][k] = *(const PG8_LAS bf16x8*)(lds + PG8_SB(b, h) + boff + n * 2048 + k * 1024); } while (0)
#define PG8_MMA(ai, bj, At, Bt) do { __builtin_amdgcn_s_setprio(1); _Pragma("unroll") for (int m = 0; m < 4; ++m) _Pragma("unroll") for (int n = 0; n < 2; ++n) _Pragma("unroll") for (int k = 0; k < 2; ++k) \
        acc[ai][bj][m][n] = __builtin_amdgcn_mfma_f32_16x16x32_bf16(Bt[n][k], At[m][k], acc[ai][bj][m][n], 0, 0, 0); __builtin_amdgcn_s_setprio(0); } while (0)
#define PG8_WAIT_V(n) asm volatile("s_waitcnt vmcnt(" #n ")" ::: "memory")
#define PG8_WAIT_L(n) asm volatile("s_waitcnt lgkmcnt(" #n ")" ::: "memory")
#define PG8_BAR __builtin_amdgcn_s_barrier()
#define PG8_SCHED __builtin_amdgcn_sched_barrier(0)
    Unit cur, nxt; int ui = 0;
    if (!S.next(0, cur)) return;
    f32x4 acc[2][2][4][2];
#pragma unroll
    for (int a = 0; a < 2; ++a)
#pragma unroll
        for (int b = 0; b < 2; ++b)
#pragma unroll
            for (int m = 0; m < 4; ++m)
#pragma unroll
                for (int n = 0; n < 2; ++n) acc[a][b][m][n] = (f32x4){0.f, 0.f, 0.f, 0.f};
    bf16x8 At[4][2], B0[2][2], B1[2][2];
    const char* cA = (const char*)g.A + (size_t)cur.pm * tstep; const char* cB = (const char*)g.Bt + (size_t)cur.pn * tstep;
    S.a_ready(cur);
    if constexpr (SP2) {
        PG8_STAGE(PG8_SB(0, 0), cB, voffB); PG8_STAGE(PG8_SB(0, 1), cB + hstep, voffB); PG8_STAGE(PG8_SA(0, 0), cA, voffA); PG8_STAGE(PG8_SA(0, 1), cA + hstep, voffA);
        if (wr == 1) PG8_BAR;
        PG8_WAIT_V(2); PG8_BAR;
        PG8_STAGE(PG8_SB(1, 0), cB + kstep, voffB); PG8_STAGE(PG8_SA(1, 0), cA + kstep, voffA); PG8_STAGE(PG8_SB(1, 1), cB + hstep + kstep, voffB);
        PG8_WAIT_V(6); PG8_BAR;
    } else {
        PG8_STAGE(PG8_SB(0, 0), cB, voffB); PG8_STAGE(PG8_SA(0, 0), cA, voffA); PG8_STAGE(PG8_SB(0, 1), cB + hstep, voffB); PG8_STAGE(PG8_SA(0, 1), cA + hstep, voffA);
        if (wr == 1) PG8_BAR;
        PG8_WAIT_V(4); PG8_BAR;
        PG8_STAGE(PG8_SB(1, 0), cB + kstep, voffB); PG8_STAGE(PG8_SA(1, 0), cA + kstep, voffA); PG8_STAGE(PG8_SB(1, 1), cB + hstep + kstep, voffB);
        PG8_WAIT_V(6); PG8_BAR;
    }
    for (;;) {
        const bool has_next = S.next(ui + 1, nxt);
        const char* nA = has_next ? (const char*)g.A + (size_t)nxt.pm * tstep : cA; const char* nB = has_next ? (const char*)g.Bt + (size_t)nxt.pn * tstep : cB;
        for (int t = 0; t < nt; t += 2) {
            const bool last = (t == nt - 2);
            const char* a1 = cA + (size_t)(t + 1) * kstep;
            const char* a2 = last ? nA : cA + (size_t)(t + 2) * kstep; const char* b2 = last ? nB : cB + (size_t)(t + 2) * kstep;
            const char* a3 = a2 + kstep; const char* b3 = b2 + kstep;
            if (last && has_next) S.a_ready(nxt);
            if constexpr (SP2) {
            PG8_LDB(B0, 0, 0); PG8_LDB(B1, 0, 1); PG8_SCHED; PG8_LDA(At, 0, 0); PG8_STAGE(PG8_SA(1, 1), a1 + hstep, voffA);
            PG8_WAIT_V(8); PG8_WAIT_L(0); PG8_BAR; PG8_MMA(0, 0, At, B0); PG8_MMA(0, 1, At, B1); PG8_BAR; PG8_SCHED;
            PG8_LDA(At, 0, 1); PG8_STAGE(PG8_SB(0, 0), b2, voffB); PG8_STAGE(PG8_SB(0, 1), b2 + hstep, voffB); PG8_STAGE(PG8_SA(0, 0), a2, voffA);
            PG8_WAIT_V(8); PG8_WAIT_L(0); PG8_BAR; PG8_MMA(1, 0, At, B0); PG8_MMA(1, 1, At, B1); PG8_BAR; PG8_SCHED;
            PG8_LDB(B0, 1, 0); PG8_LDB(B1, 1, 1); PG8_SCHED; PG8_LDA(At, 1, 0); PG8_STAGE(PG8_SA(0, 1), a2 + hstep, voffA);
            PG8_WAIT_V(8); PG8_WAIT_L(0); PG8_BAR; PG8_MMA(0, 0, At, B0); PG8_MMA(0, 1, At, B1); PG8_BAR; PG8_SCHED;
            PG8_LDA(At, 1, 1); PG8_STAGE(PG8_SB(1, 0), b3, voffB); PG8_STAGE(PG8_SB(1, 1), b3 + hstep, voffB); PG8_STAGE(PG8_SA(1, 0), a3, voffA);
            PG8_WAIT_V(8); PG8_WAIT_L(0); PG8_BAR; PG8_MMA(1, 0, At, B0); PG8_MMA(1, 1, At, B1); PG8_BAR; PG8_SCHED;
            } else {
            PG8_LDB(B0, 0, 0); PG8_SCHED; PG8_LDA(At, 0, 0); PG8_STAGE(PG8_SA(1, 1), a1 + hstep, voffA);
            PG8_WAIT_L(8); PG8_BAR; PG8_WAIT_L(0); PG8_MMA(0, 0, At, B0); PG8_BAR; PG8_SCHED;
            PG8_LDB(B1, 0, 1); PG8_STAGE(PG8_SB(0, 0), b2, voffB);
            PG8_BAR; PG8_WAIT_L(0); PG8_MMA(0, 1, At, B1); PG8_BAR;
            PG8_LDA(At, 0, 1); PG8_STAGE(PG8_SA(0, 0), a2, voffA);
            PG8_BAR; PG8_WAIT_L(0); PG8_MMA(1, 0, At, B0); PG8_BAR; PG8_SCHED;
            PG8_STAGE(PG8_SB(0, 1), b2 + hstep, voffB);
            PG8_WAIT_V(6); PG8_BAR; PG8_MMA(1, 1, At, B1); PG8_BAR;
            PG8_LDB(B0, 1, 0); PG8_SCHED; PG8_LDA(At, 1, 0); PG8_STAGE(PG8_SA(0, 1), a2 + hstep, voffA);
            PG8_WAIT_L(8); PG8_BAR; PG8_WAIT_L(0); PG8_MMA(0, 0, At, B0); PG8_BAR; PG8_SCHED;
            PG8_LDB(B1, 1, 1); PG8_STAGE(PG8_SB(1, 0), b3, voffB);
            PG8_BAR; PG8_WAIT_L(0); PG8_MMA(0, 1, At, B1); PG8_BAR;
            PG8_LDA(At, 1, 1); PG8_STAGE(PG8_SA(1, 0), a3, voffA);
            PG8_BAR; PG8_WAIT_L(0); PG8_MMA(1, 0, At, B0); PG8_BAR; PG8_SCHED;
            PG8_STAGE(PG8_SB(1, 1), b3 + hstep, voffB);
            PG8_WAIT_V(6); PG8_BAR; PG8_MMA(1, 1, At, B1); PG8_BAR;
            }
        }
        if constexpr (ALIGN_EPI) { if (wr == 0) PG8_BAR; }
        if constexpr (!Epi::AFTER_DRAIN) { E(acc, cur, wr, wc, fr, fq); S.done(cur); }
        if (!has_next) break;
#pragma unroll
        for (int a = 0; a < 2; ++a)
#pragma unroll
            for (int b = 0; b < 2; ++b)
#pragma unroll
                for (int m = 0; m < 4; ++m)
#pragma unroll
                    for (int n = 0; n < 2; ++n) acc[a][b][m][n] = (f32x4){0.f, 0.f, 0.f, 0.f};
        cur = nxt; cA = nA; cB = nB; ++ui;
        if constexpr (ALIGN_EPI) { if (wr == 1) PG8_BAR; }
    }
    PG8_WAIT_V(0);
    if constexpr (!ALIGN_EPI) { if (wr == 0) PG8_BAR; }
    PG8_BAR;
    if constexpr (Epi::AFTER_DRAIN) { E.fused(acc, cur, wr, wc, fr, fq, lds, wid, lane); S.done(cur); }
#undef PG8_SA
#undef PG8_SB
#undef PG8_STAGE
#undef PG8_LDA
#undef PG8_LDB
#undef PG8_MMA
#undef PG8_WAIT_V
#undef PG8_WAIT_L
#undef PG8_BAR
#undef PG8_SCHED
}
}
#define GAS __attribute__((address_space(1)))
#define LAS __attribute__((address_space(3)))
typedef unsigned short bf16;
typedef unsigned v4u __attribute__((ext_vector_type(4)));
typedef float f32x4 __attribute__((ext_vector_type(4)));
typedef short bf16x8 __attribute__((ext_vector_type(8)));
typedef GAS unsigned gu32;
typedef GAS unsigned long long gu64;
#define RLX_AGENT __ATOMIC_RELAXED, __HIP_MEMORY_SCOPE_AGENT
#define LDS_WAIT() asm volatile("s_waitcnt lgkmcnt(0)" ::: "memory")
#define VM_WAIT() asm volatile("s_waitcnt vmcnt(0)" ::: "memory")
__device__ __forceinline__ unsigned long long rt() { return __builtin_amdgcn_s_memrealtime(); }
__device__ __forceinline__ unsigned f2bf(float f) { unsigned u = __builtin_bit_cast(unsigned, f); return (u + 0x7fffu + ((u >> 16) & 1u)) >> 16; }
__device__ __forceinline__ unsigned pk2(float lo, float hi) { return f2bf(lo) | (f2bf(hi) << 16); }

#define XB_TMO      128
#define XB_XCNT(j)  (256  + 64 * (j))
#define XB_XSUB(j)  (1280 + 64 * (j))
#define XB_XGEN(j)  (2304 + 64 * (j))
#define XB_TOP      3328
#define XB_TOPGEN   3392
#define XCD_BAR_WORDS 3456
#define XB_SPIN_CAP (1u << 22)

__device__ __forceinline__ unsigned xb_ld(unsigned* p)              { return __hip_atomic_load(p, __ATOMIC_RELAXED, __HIP_MEMORY_SCOPE_AGENT); }
__device__ __forceinline__ unsigned xb_add(unsigned* p, unsigned v) { return __hip_atomic_fetch_add(p, v, __ATOMIC_RELAXED, __HIP_MEMORY_SCOPE_AGENT); }
__device__ __forceinline__ unsigned xb_xcc_id() { return (unsigned)__builtin_amdgcn_s_getreg((3 << 11) | 20) & 0xFu; }
#define XB_SPIN(cond, bar) do { unsigned _sp = 0; while (cond) { __builtin_amdgcn_s_sleep(1); \
    if ((++_sp & 255u) == 0u) { if (xb_ld(&(bar)[XB_TMO])) break; if (_sp > XB_SPIN_CAP) { atomicAdd(&(bar)[XB_TMO], 1u); break; } } } } while (0)

struct XcdBarrier {
    unsigned* bar; unsigned x;
    volatile LAS unsigned* st;
};

__device__ __forceinline__ XcdBarrier xcd_barrier_post(unsigned* bar, volatile LAS unsigned* st) {
    XcdBarrier b; b.bar = bar; b.x = xb_xcc_id(); b.st = st;
    if (threadIdx.x == 0) (void)xb_add(&bar[XB_XCNT(b.x)], 1u);
    return b;
}
__device__ __forceinline__ void xcd_barrier_complete(unsigned* bar, unsigned x, unsigned& nloc, unsigned& nx) {
    const unsigned G = gridDim.x * gridDim.y * gridDim.z;
    unsigned sum, cnt, mine, sp = 0u;
    for (;;) {
        sum = 0u; cnt = 0u; mine = 0u;
#pragma unroll
        for (unsigned j = 0; j < 16; ++j) { const unsigned c = xb_ld(&bar[XB_XCNT(j)]); sum += c; cnt += (c > 0u) ? 1u : 0u; mine = (j == x) ? c : mine; }
        if (sum == G) break;
        __builtin_amdgcn_s_sleep(1);
        if ((++sp & 255u) == 0u) { if (xb_ld(&bar[XB_TMO])) break; if (sp > XB_SPIN_CAP) { atomicAdd(&bar[XB_TMO], 1u); break; } }
    }
    nloc = mine > 0u ? mine : 1u; nx = cnt > 0u ? cnt : 1u;
}

__device__ __forceinline__ void xcd_barrier(const XcdBarrier& b) {
    asm volatile("s_waitcnt vmcnt(0)" ::: "memory");
    __syncthreads();
    if (threadIdx.x == 0) {
        unsigned* bar = b.bar;
        __builtin_amdgcn_s_waitcnt(0);
        unsigned nloc = b.st[0], nx = b.st[1];
        if (nloc == 0u) { xcd_barrier_complete(bar, b.x, nloc, nx); b.st[0] = nloc; b.st[1] = nx; }
        const unsigned old = xb_add(&bar[XB_XSUB(b.x)], 1u);
        const unsigned gen = old / nloc;
        if (old + 1u == (gen + 1u) * nloc) {
            __builtin_amdgcn_fence(__ATOMIC_RELEASE, "agent");
            asm volatile("s_waitcnt vmcnt(0)" ::: "memory");
            const unsigned og = xb_add(&bar[XB_TOP], 1u);
            const unsigned tg = og / nx;
            if (og + 1u == (tg + 1u) * nx) xb_add(&bar[XB_TOPGEN], 1u);
            else XB_SPIN(xb_ld(&bar[XB_TOPGEN]) == tg, bar);
            __builtin_amdgcn_fence(__ATOMIC_ACQUIRE, "agent");
            xb_add(&bar[XB_XGEN(b.x)], 1u);
            asm volatile("s_waitcnt vmcnt(0)" ::: "memory");
        } else {
            XB_SPIN(xb_ld(&bar[XB_XGEN(b.x)]) == gen, bar);
            __builtin_amdgcn_fence(__ATOMIC_ACQUIRE, "agent");
            asm volatile("s_waitcnt vmcnt(0)" ::: "memory");
        }
    }
    __syncthreads();
}
constexpr int NWAVES = 8;
constexpr int BATCH = 16, SEQ = 2048, DM = 1024, MTOK = BATCH * SEQ;
constexpr int EVEN_IN = 3584, ODD_IN = 3072;
constexpr int E_RQ = 0, E_RK = 256, E_RV = 512, E_RG = 1024, E_SQ = 1536, E_SK = 2048, E_SV = 2560, E_SG = 3072;
constexpr int O_HQ = 0, O_HF = 512, O_HI = 1024, O_HG = 1536, O_LX = 2048, O_LG = 2560;
constexpr float EPS = 1e-6f;
constexpr size_t MiB = 1u << 20;
constexpr size_t WS_CTL = 0, CTL_ZERO_BYTES = 1 * MiB;
constexpr size_t WS_WIN0 = 2 * MiB, WS_WIN1 = 9 * MiB, WS_WIN2 = 15 * MiB, WS_WIN3 = 22 * MiB;
constexpr size_t WS_WOUT = 28 * MiB;
constexpr size_t WS_TAB = 36 * MiB;
constexpr size_t WS_LB = 36 * MiB + 768 * 1024;
constexpr size_t WS_XN = 40 * MiB;
constexpr size_t WS_MIX = 104 * MiB;
constexpr size_t WS_PROJ = 168 * MiB;
constexpr size_t WS_VT0 = 392 * MiB, WS_VT1 = 424 * MiB;
constexpr size_t WS_KST = 456 * MiB;
constexpr size_t WS_END = 488 * MiB;
constexpr int CW_BAR = 4096;
constexpr int RING_BYTES = 131072;
constexpr int LDS_BYTES = 147456;
constexpr int LDSCTL_OFF = LDS_BYTES - 512;
constexpr int XTRA_OFF = RING_BYTES;
__device__ __forceinline__ float bf2f(bf16 u) { return __uint_as_float((unsigned)u << 16); }
__device__ __forceinline__ float wave_sum(float v) {
#pragma unroll
    for (int o = 1; o < 64; o <<= 1) v += __shfl_xor(v, o);
    return v;
}
__device__ __forceinline__ float sigmoidf_(float x) { return 1.f / (1.f + __expf(-x)); }
__device__ __forceinline__ float siluf_(float x) { return x / (1.f + __expf(-x)); }
__device__ __forceinline__ float log_sigmoidf_(float z) { return fminf(z, 0.f) - log1pf(__expf(-fabsf(z))); }

struct Ctx {
    LAS unsigned char* lds;
    int tid, lane, wave, vcu, G;
    unsigned char* ws;
};
struct Params { const float* in[15]; float* out; unsigned char* ws; };
__device__ __forceinline__ const float* IN(int i) { return ((const __attribute__((address_space(4))) Params*)__builtin_amdgcn_kernarg_segment_ptr())->in[i]; }
__device__ __forceinline__ float* OUTP() { return ((const __attribute__((address_space(4))) Params*)__builtin_amdgcn_kernarg_segment_ptr())->out; }
#define C_XN   ((bf16*)(C.ws + WS_XN))
#define C_MIX  ((bf16*)(C.ws + WS_MIX))
#define C_PROJ ((bf16*)(C.ws + WS_PROJ))
#define C_VT0  ((bf16*)(C.ws + WS_VT0))
#define C_VT1  ((bf16*)(C.ws + WS_VT1))
#define C_KST  ((bf16*)(C.ws + WS_KST))
#define C_TABC ((const float*)(C.ws + WS_TAB))
#define C_TABS ((const float*)(C.ws + WS_TAB) + SEQ * 32)
#define C_LB   ((const float*)(C.ws + WS_LB))

__device__ __forceinline__ void p0_transpose_item(const float* W, int K, int N, bf16* WT, LAS float* scr, int item, int lane) {
    const int nblk = N / 32, kb = item / nblk, nb = item % nblk, k0 = 64 * kb, n0 = 32 * nb;
#pragma unroll 8
    for (int i = 0; i < 32; ++i) { const int kk = 2 * i + (lane >> 5); scr[kk * 33 + (lane & 31)] = W[(size_t)(k0 + kk) * N + n0 + (lane & 31)]; }
    LDS_WAIT(); asm volatile("" ::: "memory");
    const int c = lane & 7;
#pragma unroll
    for (int j = 0; j < 4; ++j) { const int n = (lane >> 3) + 8 * j; const LAS float* s = scr + (8 * c) * 33 + n;
        v4u o; o.x = pk2(s[0 * 33], s[1 * 33]); o.y = pk2(s[2 * 33], s[3 * 33]); o.z = pk2(s[4 * 33], s[5 * 33]); o.w = pk2(s[6 * 33], s[7 * 33]);
        *(GAS v4u*)(WT + (size_t)(n0 + n) * K + k0 + 8 * c) = o; }
    LDS_WAIT(); asm volatile("" ::: "memory");
}
__device__ __forceinline__ void rms_row_to_bf16(const float* xrow, const float* w, bf16* orow, int lane) {
    const GAS f32x4* xr = (const GAS f32x4*)xrow + lane; const GAS f32x4* wr = (const GAS f32x4*)w + lane;
    f32x4 v[4]; float s = 0.f;
#pragma unroll
    for (int j = 0; j < 4; ++j) { v[j] = xr[64 * j]; s += (v[j].x * v[j].x + v[j].y * v[j].y) + (v[j].z * v[j].z + v[j].w * v[j].w); }
    const float rstd = rsqrtf(wave_sum(s) * (1.f / DM) + EPS);
    GAS unsigned long long* o8 = (GAS unsigned long long*)orow + lane;
#pragma unroll
    for (int j = 0; j < 4; ++j) { const f32x4 g = wr[64 * j];
        o8[64 * j] = (unsigned long long)pk2(v[j].x * rstd * g.x, v[j].y * rstd * g.y) | ((unsigned long long)pk2(v[j].z * rstd * g.z, v[j].w * rstd * g.w) << 32); }
}
__device__ __forceinline__ void p0_prologue(Ctx& C) {
    LAS float* scr = (LAS float*)(C.lds + C.wave * 16384);
    const int gw = C.vcu * NWAVES + C.wave, NGW = C.G * NWAVES;
    constexpr int I_E = (DM / 64) * (EVEN_IN / 32), I_O = (DM / 64) * (ODD_IN / 32), I_W = (DM / 64) * (DM / 32);
    constexpr int NITEMS = 2 * I_E + 2 * I_O + 4 * I_W;
    for (int it = gw; it < NITEMS; it += NGW) {
        int r = it;
        if (r < 2 * I_E) { const int e = r / I_E; p0_transpose_item(IN(3) + (size_t)e * DM * EVEN_IN, DM, EVEN_IN, (bf16*)(C.ws + (e ? WS_WIN2 : WS_WIN0)), scr, r % I_E, C.lane); continue; } r -= 2 * I_E;
        if (r < 2 * I_O) { const int o = r / I_O; p0_transpose_item(IN(5) + (size_t)o * DM * ODD_IN, DM, ODD_IN, (bf16*)(C.ws + (o ? WS_WIN3 : WS_WIN1)), scr, r % I_O, C.lane); continue; } r -= 2 * I_O;
        { const int l = r / I_W; const float* src = (l & 1) ? IN(6) + (size_t)(l >> 1) * DM * DM : IN(4) + (size_t)(l >> 1) * DM * DM;
          p0_transpose_item(src, DM, DM, (bf16*)(C.ws + WS_WOUT + (size_t)l * 2 * MiB), scr, r % I_W, C.lane); }
    }
    for (int m = gw; m < MTOK; m += NGW) rms_row_to_bf16(IN(0) + (size_t)m * DM, IN(1), C_XN + (size_t)m * DM, C.lane);
    float* tc = (float*)(C.ws + WS_TAB); float* ts = tc + SEQ * 32;
    for (int e = C.vcu * 512 + C.tid; e < SEQ * 32; e += C.G * 512) {
        const int t = e >> 5, i = e & 31;
        const float inv = powf(10000.0f, -(float)i / 32.0f);
        const float ang = (float)t * inv;
        double r = (double)ang * 0.15915494309189533577; r -= floor(r);
        const float rev = (float)r;
        tc[e] = __builtin_amdgcn_cosf(rev); ts[e] = __builtin_amdgcn_sinf(rev);
    }
    float* lbp = (float*)(C.ws + WS_LB);
    if (C.vcu == 0) for (int c = C.tid; c < 512; c += 512) { const float l0 = IN(7)[c], l1 = IN(7)[512 + c]; lbp[c] = 0.f; lbp[512 + c] = 1.f / (1.f + expf(l0 - l1)); }
}

__device__ __forceinline__ void norm_rows_phase(Ctx& C, const bf16* Y, const float* xsrc, const float* wpost, const float* wpre_next) {
    const int gw = C.vcu * NWAVES + C.wave, NGW = C.G * NWAVES;
    for (int m = gw; m < MTOK; m += NGW) {
        const GAS unsigned long long* yr = (const GAS unsigned long long*)(Y + (size_t)m * DM) + C.lane;
        const GAS f32x4* xr = (const GAS f32x4*)(xsrc + (size_t)m * DM) + C.lane;
        GAS f32x4* xo = (GAS f32x4*)(OUTP() + (size_t)m * DM) + C.lane;
        f32x4 y[4], x[4]; float s = 0.f;
#pragma unroll
        for (int j = 0; j < 4; ++j) { const unsigned long long w = yr[64 * j]; x[j] = xr[64 * j];
            y[j].x = __uint_as_float(((unsigned)w) << 16); y[j].y = __uint_as_float(((unsigned)w) & 0xffff0000u);
            y[j].z = __uint_as_float(((unsigned)(w >> 32)) << 16); y[j].w = __uint_as_float(((unsigned)(w >> 32)) & 0xffff0000u);
            s += (y[j].x * y[j].x + y[j].y * y[j].y) + (y[j].z * y[j].z + y[j].w * y[j].w); }
        const float rstd = rsqrtf(wave_sum(s) * (1.f / DM) + EPS); float s2 = 0.f;
#pragma unroll
        for (int j = 0; j < 4; ++j) { const f32x4 g = ((const GAS f32x4*)wpost + C.lane)[64 * j];
            x[j].x += y[j].x * rstd * g.x; x[j].y += y[j].y * rstd * g.y; x[j].z += y[j].z * rstd * g.z; x[j].w += y[j].w * rstd * g.w;
            xo[64 * j] = x[j];
            s2 += (x[j].x * x[j].x + x[j].y * x[j].y) + (x[j].z * x[j].z + x[j].w * x[j].w); }
        if (wpre_next) {
            const float r2 = rsqrtf(wave_sum(s2) * (1.f / DM) + EPS);
            GAS unsigned long long* o8 = (GAS unsigned long long*)(C_XN + (size_t)m * DM) + C.lane;
#pragma unroll
            for (int j = 0; j < 4; ++j) { const f32x4 g = ((const GAS f32x4*)wpre_next + C.lane)[64 * j];
                o8[64 * j] = (unsigned long long)pk2(x[j].x * r2 * g.x, x[j].y * r2 * g.y) | ((unsigned long long)pk2(x[j].z * r2 * g.z, x[j].w * r2 * g.w) << 32); }
        }
    }
}

__device__ __forceinline__ void unpack8(const v4u w, float* f) {
    f[0] = __uint_as_float(w.x << 16); f[1] = __uint_as_float(w.x & 0xffff0000u); f[2] = __uint_as_float(w.y << 16); f[3] = __uint_as_float(w.y & 0xffff0000u);
    f[4] = __uint_as_float(w.z << 16); f[5] = __uint_as_float(w.z & 0xffff0000u); f[6] = __uint_as_float(w.w << 16); f[7] = __uint_as_float(w.w & 0xffff0000u);
}
__device__ __forceinline__ void naive_ret_token(Ctx& C, int b, int h, int t) {
    const int lane = C.lane; const size_t rs = EVEN_IN;
    const bf16* P = C_PROJ; const size_t m = (size_t)b * SEQ + t;
    float qa[32], qb[32];
    {
        float q[64];
#pragma unroll
        for (int c = 0; c < 8; ++c) unpack8(*(const GAS v4u*)(P + m * rs + E_RQ + h * 64 + 8 * c), q + 8 * c);
#pragma unroll
        for (int i = 0; i < 32; ++i) { const float cs = C_TABC[t * 32 + i], sn = C_TABS[t * 32 + i]; qa[i] = q[i] * cs - q[32 + i] * sn; qb[i] = q[i] * sn + q[32 + i] * cs; }
    }
    const float lg2 = log2f(1.0f - exp2f(-5.0f - (float)h));
    float o0 = 0.f, o1 = 0.f;
    for (int shi = t; shi >= 0; shi -= 64) {
        const int s = shi - lane; const bool valid = s >= 0; const int sc = valid ? s : 0;
        const size_t ms = (size_t)b * SEQ + sc;
        float k[64];
#pragma unroll
        for (int c = 0; c < 8; ++c) unpack8(*(const GAS v4u*)(P + ms * rs + E_RK + h * 64 + 8 * c), k + 8 * c);
        float acc = 0.f;
#pragma unroll
        for (int i = 0; i < 32; ++i) { const float cs = C_TABC[sc * 32 + i], sn = C_TABS[sc * 32 + i];
            acc += qa[i] * (k[i] * cs - k[32 + i] * sn) + qb[i] * (k[i] * sn + k[32 + i] * cs); }
        const float w = valid ? acc * 0.125f * exp2f((float)(t - s) * lg2) : 0.f;
#pragma unroll 8
        for (int j = 0; j < 64; ++j) { const float wj = __shfl(w, j); const int sj = shi - j; const size_t mj = (size_t)b * SEQ + (sj >= 0 ? sj : 0);
            o0 += wj * bf2f(P[mj * rs + E_RV + h * 128 + lane]); o1 += wj * bf2f(P[mj * rs + E_RV + h * 128 + 64 + lane]); }
    }
    const float rstd = rsqrtf(wave_sum(o0 * o0 + o1 * o1) * (1.f / 128.f) + EPS);
    const float g0 = bf2f(P[m * rs + E_RG + h * 128 + lane]), g1 = bf2f(P[m * rs + E_RG + h * 128 + 64 + lane]);
    C_MIX[m * DM + h * 128 + lane] = (bf16)f2bf(o0 * rstd * siluf_(g0)); C_MIX[m * DM + h * 128 + 64 + lane] = (bf16)f2bf(o1 * rstd * siluf_(g1));
}
template <bool EARLY> __device__ __forceinline__ void naive_sb_token(Ctx& C, int b, int hh, int t) {
    const int lane = C.lane; const size_t rs = EVEN_IN; const bf16* P = C_PROJ; const size_t m = (size_t)b * SEQ + t;
    float q[64];
#pragma unroll
    for (int c = 0; c < 8; ++c) unpack8(*(const GAS v4u*)(P + m * rs + E_SQ + hh * 64 + 8 * c), q + 8 * c);
    float R = 0.f, o = 0.f;
    for (int shi = t - 1; shi >= 0; shi -= 64) {
        const int s = shi - lane; const bool valid = s >= 0; const size_t ms = (size_t)b * SEQ + (valid ? s : 0);
        float acc = 0.f;
#pragma unroll
        for (int c = 0; c < 8; ++c) { float k[8]; unpack8(*(const GAS v4u*)(P + ms * rs + E_SK + hh * 64 + 8 * c), k);
#pragma unroll
            for (int j = 0; j < 8; ++j) acc += q[8 * c + j] * k[j]; }
        const float z = acc * 0.125f, lb = log_sigmoidf_(z), lom = valid ? lb - z : 0.f;
        float incl = lom;
#pragma unroll
        for (int off = 1; off < 64; off <<= 1) { const float tmp = __shfl_up(incl, off); if (lane >= off) incl += tmp; }
        const float w = valid ? __expf(lb + R + (incl - lom)) : 0.f;
        R += __shfl(incl, 63);
#pragma unroll 8
        for (int j = 0; j < 64; ++j) { const float wj = __shfl(w, j); const int sj = shi - j; const size_t mj = (size_t)b * SEQ + (sj >= 0 ? sj : 0);
            o += wj * bf2f(P[mj * rs + E_SV + hh * 64 + lane]); }
        if (EARLY && R < -100.f) break;
    }
    const float g = bf2f(P[m * rs + E_SG + hh * 64 + lane]);
    C_MIX[m * DM + 512 + hh * 64 + lane] = (bf16)f2bf(o * siluf_(g));
}
__device__ __forceinline__ void naive_even_mixer(Ctx& C) {
    constexpr int NRET = BATCH * 4 * 256, NSB = BATCH * 8 * 256;
    for (int u = C.vcu; u < NRET + NSB; u += C.G) {
        if (u < NRET) { const int bh = u >> 8, tb = (u + bh) & 255; naive_ret_token(C, bh >> 2, bh & 3, tb * 8 + C.wave); }
        else { const int v = u - NRET, bh = v >> 8, tb = (v + bh) & 255; naive_sb_token<false>(C, bh >> 3, bh & 7, tb * 8 + C.wave); }
    }
}
__device__ __forceinline__ void naive_hgrn_unit(Ctx& C, int b, int h, int vs, int o, float* OS) {
    const int tid = C.tid, lane = C.lane, k = tid >> 2, vq = tid & 3; const size_t rs = ODD_IN; const bf16* P = C_PROJ;
    LAS float* red = (LAS float*)C.lds;
    const float lb = C_LB[o * 512 + h * 128 + k];
    float st[8];
#pragma unroll
    for (int j = 0; j < 8; ++j) st[j] = 0.f;
    for (int t0 = 0; t0 < SEQ; t0 += 4) {
        float flv[4], qv[4]; v4u vvv[4];
#pragma unroll
        for (int u = 0; u < 4; ++u) { const size_t m = (size_t)b * SEQ + t0 + u; flv[u] = bf2f(P[m * rs + O_HF + h * 128 + k]); qv[u] = bf2f(P[m * rs + O_HQ + h * 128 + k]);
            vvv[u] = *(const GAS v4u*)(P + m * rs + O_HI + h * 128 + vs * 32 + vq * 8); }
#pragma unroll
        for (int u = 0; u < 4; ++u) {
            const int t = t0 + u; const size_t m = (size_t)b * SEQ + t;
            const float fl = flv[u], q = qv[u];
            const float sig = 1.f / (1.f + __expf(-fl)), f = lb + (1.f - lb) * sig, kk = (1.f - lb) / (1.f + __expf(fl));
            float v[8]; unpack8(vvv[u], v);
            float part[8];
#pragma unroll
            for (int j = 0; j < 8; ++j) { st[j] = f * st[j] + kk * v[j]; part[j] = q * st[j]; }
#pragma unroll
            for (int j = 0; j < 8; ++j) { part[j] += __shfl_xor(part[j], 4); part[j] += __shfl_xor(part[j], 8); part[j] += __shfl_xor(part[j], 16); part[j] += __shfl_xor(part[j], 32); }
            LAS float* rb = red + (t & 1) * 256;
            if (lane < 4) {
#pragma unroll
                for (int j = 0; j < 8; ++j) rb[C.wave * 32 + vq * 8 + j] = part[j];
            }
            __syncthreads();
            if (tid < 32) { float s = 0.f;
#pragma unroll
                for (int w = 0; w < 8; ++w) s += rb[w * 32 + tid];
                OS[m * 512 + h * 128 + vs * 32 + tid] = s; }
        }
    }
    __syncthreads();
}
__device__ __forceinline__ void naive_lru_unit(Ctx& C, int b, int n, int o) {
    const int lane = C.lane, wave = C.wave; const size_t rs = ODD_IN; const bf16* P = C_PROJ;
    LAS float* AU = (LAS float*)C.lds;
    LAS float* xb = (LAS float*)(C.lds + XTRA_OFF) + wave * 64;
    const int ch = n * 64 + lane;
    const float* cw = IN(8) + (size_t)o * 4 * 512; const float cb = IN(9)[o * 512 + ch];
    const float w0 = cw[0 * 512 + ch], w1 = cw[1 * 512 + ch], w2 = cw[2 * 512 + ch], w3 = cw[3 * 512 + ch];
    const float* Wa = IN(10) + ((size_t)o * 8 + n) * 4096; const float* Wx = IN(12) + ((size_t)o * 8 + n) * 4096;
    const float ba = IN(11)[o * 512 + ch], bx = IN(13)[o * 512 + ch], lam = IN(14)[o * 512 + ch];
    const float sp = log1pf(expf(-lam));
    float hst = 0.f;
    for (int c = 0; c < 8; ++c) {
        for (int tt = wave * 32; tt < wave * 32 + 32; ++tt) {
            const int t = c * 256 + tt; const size_t m = (size_t)b * SEQ + t;
            float xc = cb + w3 * bf2f(P[m * rs + O_LX + ch]);
            if (t >= 1) xc += w2 * bf2f(P[(m - 1) * rs + O_LX + ch]);
            if (t >= 2) xc += w1 * bf2f(P[(m - 2) * rs + O_LX + ch]);
            if (t >= 3) xc += w0 * bf2f(P[(m - 3) * rs + O_LX + ch]);
            xb[lane] = xc; LDS_WAIT(); asm volatile("" ::: "memory");
            float ra = ba, rx = bx;
            for (int i = 0; i < 64; ++i) { const float xi = xb[i]; ra += xi * Wa[i * 64 + lane]; rx += xi * Wx[i * 64 + lane]; }
            LDS_WAIT(); asm volatile("" ::: "memory");
            const float r = sigmoidf_(ra), ig = sigmoidf_(rx);
            const float la = -8.0f * r * sp, a = __expf(la);
            const float mult = (t == 0) ? 1.0f : sqrtf(-expm1f(2.0f * la));
            AU[(tt * 64 + lane) * 2] = a; AU[(tt * 64 + lane) * 2 + 1] = mult * ig * xc;
        }
        __syncthreads();
        if (wave == 0) {
            for (int tt = 0; tt < 256; ++tt) { const size_t m = (size_t)b * SEQ + c * 256 + tt;
                hst = AU[(tt * 64 + lane) * 2] * hst + AU[(tt * 64 + lane) * 2 + 1];
                const float g = bf2f(P[m * rs + O_LG + ch]);
                C_MIX[m * DM + 512 + ch] = (bf16)f2bf(hst * siluf_(g)); }
        }
        __syncthreads();
    }
}
__device__ __forceinline__ void naive_odd_mixer1(Ctx& C, int o) {
    float* OS = (float*)(C.ws + WS_XN);
    for (int u = C.vcu; u < 256 + 128; u += C.G) {
        if (u < 256) naive_hgrn_unit(C, u >> 4, (u >> 2) & 3, u & 3, o, OS);
        else naive_lru_unit(C, (u - 256) >> 3, (u - 256) & 7, o);
    }
}
__device__ __forceinline__ void naive_odd_mixer2(Ctx& C) {
    const float* OS = (const float*)(C.ws + WS_XN); const bf16* P = C_PROJ; const size_t rs = ODD_IN;
    const int gw = C.vcu * NWAVES + C.wave, NGW = C.G * NWAVES;
    for (int it = gw; it < MTOK * 4; it += NGW) { const size_t m = it >> 2; const int h = it & 3;
        const float o0 = OS[m * 512 + h * 128 + C.lane], o1 = OS[m * 512 + h * 128 + 64 + C.lane];
        const float rstd = rsqrtf(wave_sum(o0 * o0 + o1 * o1) * (1.f / 128.f) + EPS);
        const float g0 = bf2f(P[m * rs + O_HG + h * 128 + C.lane]), g1 = bf2f(P[m * rs + O_HG + h * 128 + 64 + C.lane]);
        C_MIX[m * DM + h * 128 + C.lane] = (bf16)f2bf(o0 * rstd * siluf_(g0)); C_MIX[m * DM + h * 128 + 64 + C.lane] = (bf16)f2bf(o1 * rstd * siluf_(g1)); }
}
__global__ void __launch_bounds__(NWAVES * 64, 2) mega_fwd(Params prm) {
    extern __shared__ __attribute__((aligned(16))) unsigned char lds_raw[];
    Ctx C0;
    Ctx& C = C0;
    C.lds = (LAS unsigned char*)lds_raw;
    volatile LAS unsigned* MISC = (volatile LAS unsigned*)(C.lds + LDSCTL_OFF);
    C.tid = threadIdx.x; C.lane = C.tid & 63; C.wave = __builtin_amdgcn_readfirstlane(C.tid >> 6);
    C.G = gridDim.x; { const int bx = blockIdx.x; C.vcu = (C.G % 8 == 0) ? (bx % 8) * (C.G / 8) + bx / 8 : bx; }
    C.ws = prm.ws;
    gu32* ctl = (gu32*)(prm.ws + WS_CTL);
    for (int u = C.tid; u < (LDS_BYTES - LDSCTL_OFF) / 4; u += NWAVES * 64) ((LAS unsigned*)(C.lds + LDSCTL_OFF))[u] = 0u;
    __syncthreads();
    XcdBarrier bar = xcd_barrier_post((unsigned*)(ctl + CW_BAR), MISC + 8);
#define GRID_BAR() xcd_barrier(bar)
#define FRESH() Ctx C = C0; asm volatile("" : "+v"(C.tid)); C.lane = C.tid & 63; C.wave = __builtin_amdgcn_readfirstlane(C.tid >> 6); asm volatile("" : "+s"(C.ws)); asm volatile("" : "+s"(C.vcu))

    { FRESH(); p0_prologue(C); }
    GRID_BAR();

    for (int L = 0; L < 4; ++L) {
        const bool even = (L & 1) == 0; const int li = L >> 1;
        { FRESH();
            const int N = even ? EVEN_IN : ODD_IN;
            const size_t woff = (L == 0) ? WS_WIN0 : (L == 1) ? WS_WIN1 : (L == 2) ? WS_WIN2 : WS_WIN3;
            pg8::Gemm g{C_XN, (const bf16*)(C.ws + woff), MTOK, N, DM}; pg8::StaticOrder S; S.init(MTOK, N, C.G, (int)blockIdx.x);
            pg8::EpiProj E{C_PROJ, N, C_VT0, even ? E_RV : O_HI, C_VT1, even ? E_SV : -100000, 1};
            pg8::gemm_phase<pg8::EpiProj, pg8::StaticOrder, true, true>(C.lds, g, S, E);
        }
        GRID_BAR();
        if (even) { { FRESH(); naive_even_mixer(C); } GRID_BAR(); }
        else { { FRESH(); naive_odd_mixer1(C, li); } GRID_BAR(); { FRESH(); naive_odd_mixer2(C); } GRID_BAR(); }
        { FRESH();
            pg8::Gemm g{C_MIX, (const bf16*)(C.ws + WS_WOUT + (size_t)L * 2 * MiB), MTOK, DM, DM}; pg8::StaticOrder S; S.init(MTOK, DM, C.G, (int)blockIdx.x);
            pg8::EpiProj E{C_PROJ, DM, nullptr, -100000, nullptr, -100000, 1};
            pg8::gemm_phase<pg8::EpiProj, pg8::StaticOrder, true, true>(C.lds, g, S, E);
        }
        GRID_BAR();
        { FRESH(); norm_rows_phase(C, C_PROJ, L == 0 ? IN(0) : OUTP(), IN(2) + (size_t)L * DM, L < 3 ? IN(1) + (size_t)(L + 1) * DM : nullptr); }
        if (L < 3) GRID_BAR();
    }
}

extern "C" void kernel_launch(void* const* d_in, const int* in_sizes, int n_in, void* d_out, int out_size, void* d_ws, size_t ws_size, hipStream_t stream) {
    static int grid = 0;
    if (grid == 0) {
        if (n_in != 15 || in_sizes[0] != MTOK * DM || out_size != MTOK * DM || ws_size < WS_END) { fprintf(stderr, "kernel_launch: unexpected shapes (n_in %d, in0 %d, out %d, ws %zu)\n", n_in, n_in > 0 ? in_sizes[0] : -1, out_size, ws_size); grid = -1; return; }
        int dev = 0, cus = 0, per_cu = 0;
        if (hipGetDevice(&dev) != hipSuccess || hipDeviceGetAttribute(&cus, hipDeviceAttributeMultiprocessorCount, dev) != hipSuccess) { grid = -1; return; }
        if (hipFuncSetAttribute((const void*)mega_fwd, hipFuncAttributeMaxDynamicSharedMemorySize, LDS_BYTES) != hipSuccess) { fprintf(stderr, "kernel_launch: hipFuncSetAttribute failed\n"); grid = -1; return; }
        if (hipOccupancyMaxActiveBlocksPerMultiprocessor(&per_cu, (const void*)mega_fwd, NWAVES * 64, LDS_BYTES) != hipSuccess || per_cu < 1) { fprintf(stderr, "kernel_launch: occupancy query reports %d blocks per CU\n", per_cu); (void)hipGetLastError(); per_cu = 1; }
        grid = cus;
    }
    if (grid < 0) return;
    if (hipMemsetAsync((char*)d_ws + WS_CTL, 0, CTL_ZERO_BYTES, stream) != hipSuccess) { fprintf(stderr, "kernel_launch: memset failed\n"); return; }
    Params a{};
    for (int i = 0; i < 15; ++i) a.in[i] = (const float*)d_in[i];
    a.out = (float*)d_out; a.ws = (unsigned char*)d_ws;
    hipLaunchKernelGGL(mega_fwd, dim3(grid), dim3(NWAVES * 64), LDS_BYTES, stream, a);
    const hipError_t le = hipPeekAtLastError();
    if (le != hipSuccess) fprintf(stderr, "kernel_launch: launch failed: %s\n", hipGetErrorName(le));
}
```

```cpp
#include <hip/hip_runtime.h>
#include <cstdio>
#include <cstdint>
#include <cmath>
namespace pg8 {
#define PG8_LAS __attribute__((address_space(3)))
typedef unsigned short bf16_t;
typedef short bf16x8 __attribute__((ext_vector_type(8)));
typedef float f32x4 __attribute__((ext_vector_type(4)));
typedef unsigned u32x4 __attribute__((ext_vector_type(4)));
constexpr int BM = 256, BK = 64, HALF = 128, HTB = HALF * BK * 2  , STAGE_BYTES = 8 * HTB, NXCD = 8, WGM = 8;

__host__ __device__ __forceinline__ int lds_byte(int r, int c) { const int st = (r >> 4) * 2 + (c >> 5), rr = r & 15, cc = c & 31, ob = rr * 64 + cc * 2; return st * 1024 + (ob ^ (((ob >> 9) & 1) << 5)); }
__host__ __device__ __forceinline__ void stage_rc(int b, int& R, int& C) { const int st = b / 1024, sb = b % 1024, swz = sb ^ (((sb >> 9) & 1) << 5); R = (st >> 1) * 16 + swz / 64; C = (st & 1) * 32 + (swz % 64) / 2; }
__host__ __device__ __forceinline__ int perm32(int rho) { const int n = rho >> 4, i = rho & 15; return 8 * (i >> 2) + 4 * n + (i & 3); }

struct Unit { int pm, pn; };
struct Gemm { const bf16_t* A; const bf16_t* Bt; int M, N, K; };

struct StaticOrder {
    int nM, nN, nwg, G, c;
    __host__ __device__ void init(int M, int N, int G_, int c_) { nM = M / BM; nN = N / BM; nwg = nM * nN; G = G_; c = c_; }
    __host__ __device__ bool next(int i, Unit& u) const {
        const long L = (long)i * G + c; if (L >= nwg) return false;
        int wgid = (int)L; { const int q = nwg / NXCD, r = nwg % NXCD, xcd = wgid % NXCD, off = wgid / NXCD; wgid = (xcd < r ? xcd * (q + 1) : r * (q + 1) + (xcd - r) * q) + off; }
        const int nig = WGM * nN, gid = wgid / nig, fm = gid * WGM, gsz = (nM - fm) < WGM ? (nM - fm) : WGM;
        u.pm = fm + ((wgid % nig) % gsz); u.pn = (wgid % nig) / gsz; return true;
    }
    __device__ __forceinline__ void a_ready(const Unit&) const {}
    __device__ __forceinline__ void done(const Unit&) const {}
};

__device__ __forceinline__ unsigned cvt_pk_bf16(float lo, float hi) { unsigned r; asm volatile("v_cvt_pk_bf16_f32 %0, %1, %2" : "=v"(r) : "v"(lo), "v"(hi)); return r; }
struct EpiProj {
    static constexpr bool PERM = true, AFTER_DRAIN = false;
    bf16_t* O; int ldc; bf16_t* T0; int lo0; bf16_t* T1; int lo1; int nat;
    __device__ __forceinline__ void operator()(const f32x4 (&acc)[2][2][4][2], const Unit& u, int wr, int wc, int fr, int fq) const {
        const int row0 = u.pm * BM + wr * 64 + fr; const int colt = u.pn * BM;
        const int col0 = colt + wc * 32 + 8 * fq;
        bf16_t* T = nullptr; int cc0 = 0;
        if (colt >= lo0 && colt < lo0 + 512) { T = T0; cc0 = colt - lo0; } else if (colt >= lo1 && colt < lo1 + 512) { T = T1; cc0 = colt - lo1; }
        if (T == nullptr || nat) {
#pragma unroll
            for (int ai = 0; ai < 2; ++ai)
#pragma unroll
                for (int m = 0; m < 4; ++m) { bf16_t* rowp = O + (size_t)(row0 + ai * HALF + m * 16) * ldc + col0;
#pragma unroll
                    for (int bj = 0; bj < 2; ++bj) { const f32x4 v0 = acc[ai][bj][m][0], v1 = acc[ai][bj][m][1];
                        u32x4 w; w.x = cvt_pk_bf16(v0[0], v0[1]); w.y = cvt_pk_bf16(v0[2], v0[3]); w.z = cvt_pk_bf16(v1[0], v1[1]); w.w = cvt_pk_bf16(v1[2], v1[3]);
                        *(u32x4*)(rowp + bj * HALF) = w; } }
        }
        if (T != nullptr) {
            const int b = (u.pm * BM) >> 11; const int s0 = ((u.pm * BM) & 2047) + wr * 64 + fr;
            bf16_t* tb = T + ((size_t)(b * 512 + cc0 + wc * 32 + 8 * fq)) * 2048 + s0;
#pragma unroll
            for (int ai = 0; ai < 2; ++ai)
#pragma unroll
                for (int m = 0; m < 4; ++m)
#pragma unroll
                    for (int bj = 0; bj < 2; ++bj)
#pragma unroll
                        for (int n = 0; n < 2; ++n) { const f32x4 v = acc[ai][bj][m][n];
                            const unsigned p01 = cvt_pk_bf16(v[0], v[1]), p23 = cvt_pk_bf16(v[2], v[3]);
                            bf16_t* q = tb + (size_t)(bj * HALF + 4 * n) * 2048 + ai * HALF + m * 16;
                            q[0] = (bf16_t)(p01 & 0xffffu); q[2048] = (bf16_t)(p01 >> 16); q[2 * 2048] = (bf16_t)(p23 & 0xffffu); q[3 * 2048] = (bf16_t)(p23 >> 16); }
        }
    }
};
template <class Epi, class Sched, bool ALIGN_EPI = false, bool SP2 = false>
__device__ __forceinline__ void gemm_phase(PG8_LAS unsigned char* lds, const Gemm g, const Sched& S, const Epi& E) {
    const int tid = threadIdx.x, wid = __builtin_amdgcn_readfirstlane(tid >> 6), lane = tid & 63, wr = wid >> 2, wc = wid & 3, fr = lane & 15, fq = lane >> 4;
    const int K = g.K, nt = K / BK;
    unsigned voffA[2], voffB[2];
#pragma unroll
    for (int i = 0; i < 2; ++i) { int R, C; stage_rc(tid * 16 + i * 8192, R, C); const int Rb = Epi::PERM ? ((R & ~31) + perm32(R & 31)) : R;
        voffA[i] = (unsigned)(R * K + C) * 2u; voffB[i] = (unsigned)(Rb * K + C) * 2u; }
    const size_t kstep = (size_t)(BK * 2);
    const size_t hstep = (size_t)HALF * K * 2;
    const size_t tstep = 2 * hstep;
    const unsigned ldsw = (unsigned)wid * 1024u;
    const int aoff = lds_byte(wr * 64 + fr, fq * 8), boff = lds_byte(wc * 32 + fr, fq * 8);
#define PG8_SA(b, h) (((b) * 2 + (h)) * HTB)
#define PG8_SB(b, h) ((4 + (b) * 2 + (h)) * HTB)
#define PG8_STAGE(bufoff, gbase, voff) do { _Pragma("unroll") for (int _i = 0; _i < 2; ++_i) \
        __builtin_amdgcn_global_load_lds((const unsigned*)((const char*)(gbase) + (voff)[_i]), (PG8_LAS unsigned*)(lds + (bufoff) + ldsw + _i * 8192), 16, 0, 0); } while (0)
#define PG8_LDA(dst, b, h) do { _Pragma("unroll") for (int m = 0; m < 4; ++m) _Pragma("unroll") for (int k = 0; k < 2; ++k) dst[m][k] = *(const PG8_LAS bf16x8*)(lds + PG8_SA(b, h) + aoff + m * 2048 + k * 1024); } while (0)
#define PG8_LDB(dst, b, h) do { _Pragma("unroll") for (int n = 0; n < 2; ++n) _Pragma("unroll") for (int k = 0; k < 2; ++k) dst[n][k] = *(const PG8_LAS bf16x8*)(lds + PG8_SB(b, h) + boff + n * 2048 + k * 1024); } while (0)
#define PG8_MMA(ai, bj, At, Bt) do { __builtin_amdgcn_s_setprio(1); _Pragma("unroll") for (int m = 0; m < 4; ++m) _Pragma("unroll") for (int n = 0; n < 2; ++n) _Pragma("unroll") for (int k = 0; k < 2; ++k) \
        acc[ai][bj][m][n] = __builtin_amdgcn_mfma_f32_16x16x32_bf16(Bt[n][k], At[m][k], acc[ai][bj][m][n], 0, 0, 0); __builtin_amdgcn_s_setprio(0); } while (0)
#define PG8_WAIT_V(n) asm volatile("s_waitcnt vmcnt(" #n ")" ::: "memory")
#define PG8_WAIT_L(n) asm volatile("s_waitcnt lgkmcnt(" #n ")" ::: "memory")
#define PG8_BAR __builtin_amdgcn_s_barrier()
#define PG8_SCHED __builtin_amdgcn_sched_barrier(0)
    Unit cur, nxt; int ui = 0;
    if (!S.next(0, cur)) return;
    f32x4 acc[2][2][4][2];
#pragma unroll
    for (int a = 0; a < 2; ++a)
#pragma unroll
        for (int b = 0; b < 2; ++b)
#pragma unroll
            for (int m = 0; m < 4; ++m)
#pragma unroll
                for (int n = 0; n < 2; ++n) acc[a][b][m][n] = (f32x4){0.f, 0.f, 0.f, 0.f};
    bf16x8 At[4][2], B0[2][2], B1[2][2];
    const char* cA = (const char*)g.A + (size_t)cur.pm * tstep; const char* cB = (const char*)g.Bt + (size_t)cur.pn * tstep;
    S.a_ready(cur);
    if constexpr (SP2) {
        PG8_STAGE(PG8_SB(0, 0), cB, voffB); PG8_STAGE(PG8_SB(0, 1), cB + hstep, voffB); PG8_STAGE(PG8_SA(0, 0), cA, voffA); PG8_STAGE(PG8_SA(0, 1), cA + hstep, voffA);
        if (wr == 1) PG8_BAR;
        PG8_WAIT_V(2); PG8_BAR;
        PG8_STAGE(PG8_SB(1, 0), cB + kstep, voffB); PG8_STAGE(PG8_SA(1, 0), cA + kstep, voffA); PG8_STAGE(PG8_SB(1, 1), cB + hstep + kstep, voffB);
        PG8_WAIT_V(6); PG8_BAR;
    } else {
        PG8_STAGE(PG8_SB(0, 0), cB, voffB); PG8_STAGE(PG8_SA(0, 0), cA, voffA); PG8_STAGE(PG8_SB(0, 1), cB + hstep, voffB); PG8_STAGE(PG8_SA(0, 1), cA + hstep, voffA);
        if (wr == 1) PG8_BAR;
        PG8_WAIT_V(4); PG8_BAR;
        PG8_STAGE(PG8_SB(1, 0), cB + kstep, voffB); PG8_STAGE(PG8_SA(1, 0), cA + kstep, voffA); PG8_STAGE(PG8_SB(1, 1), cB + hstep + kstep, voffB);
        PG8_WAIT_V(6); PG8_BAR;
    }
    for (;;) {
        const bool has_next = S.next(ui + 1, nxt);
        const char* nA = has_next ? (const char*)g.A + (size_t)nxt.pm * tstep : cA; const char* nB = has_next ? (const char*)g.Bt + (size_t)nxt.pn * tstep : cB;
        for (int t = 0; t < nt; t += 2) {
            const bool last = (t == nt - 2);
            const char* a1 = cA + (size_t)(t + 1) * kstep;
            const char* a2 = last ? nA : cA + (size_t)(t + 2) * kstep; const char* b2 = last ? nB : cB + (size_t)(t + 2) * kstep;
            const char* a3 = a2 + kstep; const char* b3 = b2 + kstep;
            if (last && has_next) S.a_ready(nxt);
            if constexpr (SP2) {
            PG8_LDB(B0, 0, 0); PG8_LDB(B1, 0, 1); PG8_SCHED; PG8_LDA(At, 0, 0); PG8_STAGE(PG8_SA(1, 1), a1 + hstep, voffA);
            PG8_WAIT_V(8); PG8_WAIT_L(0); PG8_BAR; PG8_MMA(0, 0, At, B0); PG8_MMA(0, 1, At, B1); PG8_BAR; PG8_SCHED;
            PG8_LDA(At, 0, 1); PG8_STAGE(PG8_SB(0, 0), b2, voffB); PG8_STAGE(PG8_SB(0, 1), b2 + hstep, voffB); PG8_STAGE(PG8_SA(0, 0), a2, voffA);
            PG8_WAIT_V(8); PG8_WAIT_L(0); PG8_BAR; PG8_MMA(1, 0, At, B0); PG8_MMA(1, 1, At, B1); PG8_BAR; PG8_SCHED;
            PG8_LDB(B0, 1, 0); PG8_LDB(B1, 1, 1); PG8_SCHED; PG8_LDA(At, 1, 0); PG8_STAGE(PG8_SA(0, 1), a2 + hstep, voffA);
            PG8_WAIT_V(8); PG8_WAIT_L(0); PG8_BAR; PG8_MMA(0, 0, At, B0); PG8_MMA(0, 1, At, B1); PG8_BAR; PG8_SCHED;
            PG8_LDA(At, 1, 1); PG8_STAGE(PG8_SB(1, 0), b3, voffB); PG8_STAGE(PG8_SB(1, 1), b3 + hstep, voffB); PG8_STAGE(PG8_SA(1, 0), a3, voffA);
            PG8_WAIT_V(8); PG8_WAIT_L(0); PG8_BAR; PG8_MMA(1, 0, At, B0); PG8_MMA(1, 1, At, B1); PG8_BAR; PG8_SCHED;
            } else {
            PG8_LDB(B0, 0, 0); PG8_SCHED; PG8_LDA(At, 0, 0); PG8_STAGE(PG8_SA(1, 1), a1 + hstep, voffA);
            PG8_WAIT_L(8); PG8_BAR; PG8_WAIT_L(0); PG8_MMA(0, 0, At, B0); PG8_BAR; PG8_SCHED;
            PG8_LDB(B1, 0, 1); PG8_STAGE(PG8_SB(0, 0), b2, voffB);
            PG8_BAR; PG8_WAIT_L(0); PG8_MMA(0, 1, At, B1); PG8_BAR;
            PG8_LDA(At, 0, 1); PG8_STAGE(PG8_SA(0, 0), a2, voffA);
            PG8_BAR; PG8_WAIT_L(0); PG8_MMA(1, 0, At, B0); PG8_BAR; PG8_SCHED;
            PG8_STAGE(PG8_SB(0, 1), b2 + hstep, voffB);
            PG8_WAIT_V(6); PG8_BAR; PG8_MMA(1, 1, At, B1); PG8_BAR;
            PG8_LDB(B0, 1, 0); PG8_SCHED; PG8_LDA(At, 1, 0); PG8_STAGE(PG8_SA(0, 1), a2 + hstep, voffA);
            PG8_WAIT_L(8); PG8_BAR; PG8_WAIT_L(0); PG8_MMA(0, 0, At, B0); PG8_BAR; PG8_SCHED;
            PG8_LDB(B1, 1, 1); PG8_STAGE(PG8_SB(1, 0), b3, voffB);
            PG8_BAR; PG8_WAIT_L(0); PG8_MMA(0, 1, At, B1); PG8_BAR;
            PG8_LDA(At, 1, 1); PG8_STAGE(PG8_SA(1, 0), a3, voffA);
            PG8_BAR; PG8_WAIT_L(0); PG8_MMA(1, 0, At, B0); PG8_BAR; PG8_SCHED;
            PG8_STAGE(PG8_SB(1, 1), b3 + hstep, voffB);
            PG8_WAIT_V(6); PG8_BAR; PG8_MMA(1, 1, At, B1); PG8_BAR;
            }
        }
        if constexpr (ALIGN_EPI) { if (wr == 0) PG8_BAR; }
        if constexpr (!Epi::AFTER_DRAIN) { E(acc, cur, wr, wc, fr, fq); S.done(cur); }
        if (!has_next) break;
#pragma unroll
        for (int a = 0; a < 2; ++a)
#pragma unroll
            for (int b = 0; b < 2; ++b)
#pragma unroll
                for (int m = 0; m < 4; ++m)
#pragma unroll
                    for (int n = 0; n < 2; ++n) acc[a][b][m][n] = (f32x4){0.f, 0.f, 0.f, 0.f};
        cur = nxt; cA = nA; cB = nB; ++ui;
        if constexpr (ALIGN_EPI) { if (wr == 1) PG8_BAR; }
    }
    PG8_WAIT_V(0);
    if constexpr (!ALIGN_EPI) { if (wr == 0) PG8_BAR; }
    PG8_BAR;
    if constexpr (Epi::AFTER_DRAIN) { E.fused(acc, cur, wr, wc, fr, fq, lds, wid, lane); S.done(cur); }
#undef PG8_SA
#undef PG8_SB
#undef PG8_STAGE
#undef PG8_LDA
#undef PG8_LDB
#undef PG8_MMA
#undef PG8_WAIT_V
#undef PG8_WAIT_L
#undef PG8_BAR
#undef PG8_SCHED
}
}
#define GAS __attribute__((address_space(1)))
#define LAS __attribute__((address_space(3)))
typedef unsigned short bf16;
typedef unsigned v4u __attribute__((ext_vector_type(4)));
typedef float f32x4 __attribute__((ext_vector_type(4)));
typedef short bf16x8 __attribute__((ext_vector_type(8)));
typedef GAS unsigned gu32;
typedef GAS unsigned long long gu64;
#define RLX_AGENT __ATOMIC_RELAXED, __HIP_MEMORY_SCOPE_AGENT
#define LDS_WAIT() asm volatile("s_waitcnt lgkmcnt(0)" ::: "memory")
#define VM_WAIT() asm volatile("s_waitcnt vmcnt(0)" ::: "memory")
__device__ __forceinline__ unsigned long long rt() { return __builtin_amdgcn_s_memrealtime(); }
__device__ __forceinline__ unsigned f2bf(float f) { unsigned u = __builtin_bit_cast(unsigned, f); return (u + 0x7fffu + ((u >> 16) & 1u)) >> 16; }
__device__ __forceinline__ unsigned pk2(float lo, float hi) { return f2bf(lo) | (f2bf(hi) << 16); }

#define XB_TMO      128
#define XB_XCNT(j)  (256  + 64 * (j))
#define XB_XSUB(j)  (1280 + 64 * (j))
#define XB_XGEN(j)  (2304 + 64 * (j))
#define XB_TOP      3328
#define XB_TOPGEN   3392
#define XCD_BAR_WORDS 3456
#define XB_SPIN_CAP (1u << 22)

__device__ __forceinline__ unsigned xb_ld(unsigned* p)              { return __hip_atomic_load(p, __ATOMIC_RELAXED, __HIP_MEMORY_SCOPE_AGENT); }
__device__ __forceinline__ unsigned xb_add(unsigned* p, unsigned v) { return __hip_atomic_fetch_add(p, v, __ATOMIC_RELAXED, __HIP_MEMORY_SCOPE_AGENT); }
__device__ __forceinline__ unsigned xb_xcc_id() { return (unsigned)__builtin_amdgcn_s_getreg((3 << 11) | 20) & 0xFu; }
#define XB_SPIN(cond, bar) do { unsigned _sp = 0; while (cond) { __builtin_amdgcn_s_sleep(1); \
    if ((++_sp & 255u) == 0u) { if (xb_ld(&(bar)[XB_TMO])) break; if (_sp > XB_SPIN_CAP) { atomicAdd(&(bar)[XB_TMO], 1u); break; } } } } while (0)

struct XcdBarrier {
    unsigned* bar; unsigned x;
    volatile LAS unsigned* st;
};

__device__ __forceinline__ XcdBarrier xcd_barrier_post(unsigned* bar, volatile LAS unsigned* st) {
    XcdBarrier b; b.bar = bar; b.x = xb_xcc_id(); b.st = st;
    if (threadIdx.x == 0) (void)xb_add(&bar[XB_XCNT(b.x)], 1u);
    return b;
}
__device__ __forceinline__ void xcd_barrier_complete(unsigned* bar, unsigned x, unsigned& nloc, unsigned& nx) {
    const unsigned G = gridDim.x * gridDim.y * gridDim.z;
    unsigned sum, cnt, mine, sp = 0u;
    for (;;) {
        sum = 0u; cnt = 0u; mine = 0u;
#pragma unroll
        for (unsigned j = 0; j < 16; ++j) { const unsigned c = xb_ld(&bar[XB_XCNT(j)]); sum += c; cnt += (c > 0u) ? 1u : 0u; mine = (j == x) ? c : mine; }
        if (sum == G) break;
        __builtin_amdgcn_s_sleep(1);
        if ((++sp & 255u) == 0u) { if (xb_ld(&bar[XB_TMO])) break; if (sp > XB_SPIN_CAP) { atomicAdd(&bar[XB_TMO], 1u); break; } }
    }
    nloc = mine > 0u ? mine : 1u; nx = cnt > 0u ? cnt : 1u;
}

__device__ __forceinline__ void xcd_barrier(const XcdBarrier& b) {
    asm volatile("s_waitcnt vmcnt(0)" ::: "memory");
    __syncthreads();
    if (threadIdx.x == 0) {
        unsigned* bar = b.bar;
        __builtin_amdgcn_s_waitcnt(0);
        unsigned nloc = b.st[0], nx = b.st[1];
        if (nloc == 0u) { xcd_barrier_complete(bar, b.x, nloc, nx); b.st[0] = nloc; b.st[1] = nx; }
        const unsigned old = xb_add(&bar[XB_XSUB(b.x)], 1u);
        const unsigned gen = old / nloc;
        if (old + 1u == (gen + 1u) * nloc) {
            __builtin_amdgcn_fence(__ATOMIC_RELEASE, "agent");
            asm volatile("s_waitcnt vmcnt(0)" ::: "memory");
            const unsigned og = xb_add(&bar[XB_TOP], 1u);
            const unsigned tg = og / nx;
            if (og + 1u == (tg + 1u) * nx) xb_add(&bar[XB_TOPGEN], 1u);
            else XB_SPIN(xb_ld(&bar[XB_TOPGEN]) == tg, bar);
            __builtin_amdgcn_fence(__ATOMIC_ACQUIRE, "agent");
            xb_add(&bar[XB_XGEN(b.x)], 1u);
            asm volatile("s_waitcnt vmcnt(0)" ::: "memory");
        } else {
            XB_SPIN(xb_ld(&bar[XB_XGEN(b.x)]) == gen, bar);
            __builtin_amdgcn_fence(__ATOMIC_ACQUIRE, "agent");
            asm volatile("s_waitcnt vmcnt(0)" ::: "memory");
        }
    }
    __syncthreads();
}
constexpr int NWAVES = 8;
constexpr int BATCH = 16, SEQ = 2048, DM = 1024, MTOK = BATCH * SEQ;
constexpr int EVEN_IN = 3584, ODD_IN = 3072;
constexpr int E_RQ = 0, E_RK = 256, E_RV = 512, E_RG = 1024, E_SQ = 1536, E_SK = 2048, E_SV = 2560, E_SG = 3072;
constexpr int O_HQ = 0, O_HF = 512, O_HI = 1024, O_HG = 1536, O_LX = 2048, O_LG = 2560;
constexpr float EPS = 1e-6f;
constexpr size_t MiB = 1u << 20;
constexpr size_t WS_CTL = 0, CTL_ZERO_BYTES = 1 * MiB;
constexpr size_t WS_WIN0 = 2 * MiB, WS_WIN1 = 9 * MiB, WS_WIN2 = 15 * MiB, WS_WIN3 = 22 * MiB;
constexpr size_t WS_WOUT = 28 * MiB;
constexpr size_t WS_TAB = 36 * MiB;
constexpr size_t WS_LB = 36 * MiB + 768 * 1024;
constexpr size_t WS_XN = 40 * MiB;
constexpr size_t WS_MIX = 104 * MiB;
constexpr size_t WS_PROJ = 168 * MiB;
constexpr size_t WS_VT0 = 392 * MiB, WS_VT1 = 424 * MiB;
constexpr size_t WS_KST = 456 * MiB;
constexpr size_t WS_END = 488 * MiB;
constexpr int CW_BAR = 4096;
constexpr int RING_BYTES = 131072;
constexpr int LDS_BYTES = 147456;
constexpr int LDSCTL_OFF = LDS_BYTES - 512;
constexpr int XTRA_OFF = RING_BYTES;
__device__ __forceinline__ float bf2f(bf16 u) { return __uint_as_float((unsigned)u << 16); }
__device__ __forceinline__ float wave_sum(float v) {
#pragma unroll
    for (int o = 1; o < 64; o <<= 1) v += __shfl_xor(v, o);
    return v;
}
__device__ __forceinline__ float sigmoidf_(float x) { return 1.f / (1.f + __expf(-x)); }
__device__ __forceinline__ float siluf_(float x) { return x / (1.f + __expf(-x)); }
__device__ __forceinline__ float log_sigmoidf_(float z) { return fminf(z, 0.f) - log1pf(__expf(-fabsf(z))); }

struct Ctx {
    LAS unsigned char* lds;
    int tid, lane, wave, vcu, G;
    unsigned char* ws;
};
struct Params { const float* in[15]; float* out; unsigned char* ws; };
__device__ __forceinline__ const float* IN(int i) { return ((const __attribute__((address_space(4))) Params*)__builtin_amdgcn_kernarg_segment_ptr())->in[i]; }
__device__ __forceinline__ float* OUTP() { return ((const __attribute__((address_space(4))) Params*)__builtin_amdgcn_kernarg_segment_ptr())->out; }
#define C_XN   ((bf16*)(C.ws + WS_XN))
#define C_MIX  ((bf16*)(C.ws + WS_MIX))
#define C_PROJ ((bf16*)(C.ws + WS_PROJ))
#define C_VT0  ((bf16*)(C.ws + WS_VT0))
#define C_VT1  ((bf16*)(C.ws + WS_VT1))
#define C_KST  ((bf16*)(C.ws + WS_KST))
#define C_TABC ((const float*)(C.ws + WS_TAB))
#define C_TABS ((const float*)(C.ws + WS_TAB) + SEQ * 32)
#define C_LB   ((const float*)(C.ws + WS_LB))

__device__ __forceinline__ void p0_transpose_item(const float* W, int K, int N, bf16* WT, LAS float* scr, int item, int lane) {
    const int nblk = N / 32, kb = item / nblk, nb = item % nblk, k0 = 64 * kb, n0 = 32 * nb;
#pragma unroll 8
    for (int i = 0; i < 32; ++i) { const int kk = 2 * i + (lane >> 5); scr[kk * 33 + (lane & 31)] = W[(size_t)(k0 + kk) * N + n0 + (lane & 31)]; }
    LDS_WAIT(); asm volatile("" ::: "memory");
    const int c = lane & 7;
#pragma unroll
    for (int j = 0; j < 4; ++j) { const int n = (lane >> 3) + 8 * j; const LAS float* s = scr + (8 * c) * 33 + n;
        v4u o; o.x = pk2(s[0 * 33], s[1 * 33]); o.y = pk2(s[2 * 33], s[3 * 33]); o.z = pk2(s[4 * 33], s[5 * 33]); o.w = pk2(s[6 * 33], s[7 * 33]);
        *(GAS v4u*)(WT + (size_t)(n0 + n) * K + k0 + 8 * c) = o; }
    LDS_WAIT(); asm volatile("" ::: "memory");
}
__device__ __forceinline__ void rms_row_to_bf16(const float* xrow, const float* w, bf16* orow, int lane) {
    const GAS f32x4* xr = (const GAS f32x4*)xrow + lane; const GAS f32x4* wr = (const GAS f32x4*)w + lane;
    f32x4 v[4]; float s = 0.f;
#pragma unroll
    for (int j = 0; j < 4; ++j) { v[j] = xr[64 * j]; s += (v[j].x * v[j].x + v[j].y * v[j].y) + (v[j].z * v[j].z + v[j].w * v[j].w); }
    const float rstd = rsqrtf(wave_sum(s) * (1.f / DM) + EPS);
    GAS unsigned long long* o8 = (GAS unsigned long long*)orow + lane;
#pragma unroll
    for (int j = 0; j < 4; ++j) { const f32x4 g = wr[64 * j];
        o8[64 * j] = (unsigned long long)pk2(v[j].x * rstd * g.x, v[j].y * rstd * g.y) | ((unsigned long long)pk2(v[j].z * rstd * g.z, v[j].w * rstd * g.w) << 32); }
}
__device__ __forceinline__ void p0_prologue(Ctx& C) {
    LAS float* scr = (LAS float*)(C.lds + C.wave * 16384);
    const int gw = C.vcu * NWAVES + C.wave, NGW = C.G * NWAVES;
    constexpr int I_E = (DM / 64) * (EVEN_IN / 32), I_O = (DM / 64) * (ODD_IN / 32), I_W = (DM / 64) * (DM / 32);
    constexpr int NITEMS = 2 * I_E + 2 * I_O + 4 * I_W;
    for (int it = gw; it < NITEMS; it += NGW) {
        int r = it;
        if (r < 2 * I_E) { const int e = r / I_E; p0_transpose_item(IN(3) + (size_t)e * DM * EVEN_IN, DM, EVEN_IN, (bf16*)(C.ws + (e ? WS_WIN2 : WS_WIN0)), scr, r % I_E, C.lane); continue; } r -= 2 * I_E;
        if (r < 2 * I_O) { const int o = r / I_O; p0_transpose_item(IN(5) + (size_t)o * DM * ODD_IN, DM, ODD_IN, (bf16*)(C.ws + (o ? WS_WIN3 : WS_WIN1)), scr, r % I_O, C.lane); continue; } r -= 2 * I_O;
        { const int l = r / I_W; const float* src = (l & 1) ? IN(6) + (size_t)(l >> 1) * DM * DM : IN(4) + (size_t)(l >> 1) * DM * DM;
          p0_transpose_item(src, DM, DM, (bf16*)(C.ws + WS_WOUT + (size_t)l * 2 * MiB), scr, r % I_W, C.lane); }
    }
    for (int m = gw; m < MTOK; m += NGW) rms_row_to_bf16(IN(0) + (size_t)m * DM, IN(1), C_XN + (size_t)m * DM, C.lane);
    float* tc = (float*)(C.ws + WS_TAB); float* ts = tc + SEQ * 32;
    for (int e = C.vcu * 512 + C.tid; e < SEQ * 32; e += C.G * 512) {
        const int t = e >> 5, i = e & 31;
        const float inv = powf(10000.0f, -(float)i / 32.0f);
        const float ang = (float)t * inv;
        double r = (double)ang * 0.15915494309189533577; r -= floor(r);
        const float rev = (float)r;
        tc[e] = __builtin_amdgcn_cosf(rev); ts[e] = __builtin_amdgcn_sinf(rev);
    }
    float* lbp = (float*)(C.ws + WS_LB);
    if (C.vcu == 0) for (int c = C.tid; c < 512; c += 512) { const float l0 = IN(7)[c], l1 = IN(7)[512 + c]; lbp[c] = 0.f; lbp[512 + c] = 1.f / (1.f + expf(l0 - l1)); }
}

__device__ __forceinline__ void norm_rows_phase(Ctx& C, const bf16* Y, const float* xsrc, const float* wpost, const float* wpre_next) {
    const int gw = C.vcu * NWAVES + C.wave, NGW = C.G * NWAVES;
    for (int m = gw; m < MTOK; m += NGW) {
        const GAS unsigned long long* yr = (const GAS unsigned long long*)(Y + (size_t)m * DM) + C.lane;
        const GAS f32x4* xr = (const GAS f32x4*)(xsrc + (size_t)m * DM) + C.lane;
        GAS f32x4* xo = (GAS f32x4*)(OUTP() + (size_t)m * DM) + C.lane;
        f32x4 y[4], x[4]; float s = 0.f;
#pragma unroll
        for (int j = 0; j < 4; ++j) { const unsigned long long w = yr[64 * j]; x[j] = xr[64 * j];
            y[j].x = __uint_as_float(((unsigned)w) << 16); y[j].y = __uint_as_float(((unsigned)w) & 0xffff0000u);
            y[j].z = __uint_as_float(((unsigned)(w >> 32)) << 16); y[j].w = __uint_as_float(((unsigned)(w >> 32)) & 0xffff0000u);
            s += (y[j].x * y[j].x + y[j].y * y[j].y) + (y[j].z * y[j].z + y[j].w * y[j].w); }
        const float rstd = rsqrtf(wave_sum(s) * (1.f / DM) + EPS); float s2 = 0.f;
#pragma unroll
        for (int j = 0; j < 4; ++j) { const f32x4 g = ((const GAS f32x4*)wpost + C.lane)[64 * j];
            x[j].x += y[j].x * rstd * g.x; x[j].y += y[j].y * rstd * g.y; x[j].z += y[j].z * rstd * g.z; x[j].w += y[j].w * rstd * g.w;
            xo[64 * j] = x[j];
            s2 += (x[j].x * x[j].x + x[j].y * x[j].y) + (x[j].z * x[j].z + x[j].w * x[j].w); }
        if (wpre_next) {
            const float r2 = rsqrtf(wave_sum(s2) * (1.f / DM) + EPS);
            GAS unsigned long long* o8 = (GAS unsigned long long*)(C_XN + (size_t)m * DM) + C.lane;
#pragma unroll
            for (int j = 0; j < 4; ++j) { const f32x4 g = ((const GAS f32x4*)wpre_next + C.lane)[64 * j];
                o8[64 * j] = (unsigned long long)pk2(x[j].x * r2 * g.x, x[j].y * r2 * g.y) | ((unsigned long long)pk2(x[j].z * r2 * g.z, x[j].w * r2 * g.w) << 32); }
        }
    }
}

__device__ __forceinline__ void unpack8(const v4u w, float* f) {
    f[0] = __uint_as_float(w.x << 16); f[1] = __uint_as_float(w.x & 0xffff0000u); f[2] = __uint_as_float(w.y << 16); f[3] = __uint_as_float(w.y & 0xffff0000u);
    f[4] = __uint_as_float(w.z << 16); f[5] = __uint_as_float(w.z & 0xffff0000u); f[6] = __uint_as_float(w.w << 16); f[7] = __uint_as_float(w.w & 0xffff0000u);
}
__device__ __forceinline__ void naive_ret_token(Ctx& C, int b, int h, int t) {
    const int lane = C.lane; const size_t rs = EVEN_IN;
    const bf16* P = C_PROJ; const size_t m = (size_t)b * SEQ + t;
    float qa[32], qb[32];
    {
        float q[64];
#pragma unroll
        for (int c = 0; c < 8; ++c) unpack8(*(const GAS v4u*)(P + m * rs + E_RQ + h * 64 + 8 * c), q + 8 * c);
#pragma unroll
        for (int i = 0; i < 32; ++i) { const float cs = C_TABC[t * 32 + i], sn = C_TABS[t * 32 + i]; qa[i] = q[i] * cs - q[32 + i] * sn; qb[i] = q[i] * sn + q[32 + i] * cs; }
    }
    const float lg2 = log2f(1.0f - exp2f(-5.0f - (float)h));
    float o0 = 0.f, o1 = 0.f;
    for (int shi = t; shi >= 0; shi -= 64) {
        const int s = shi - lane; const bool valid = s >= 0; const int sc = valid ? s : 0;
        const size_t ms = (size_t)b * SEQ + sc;
        float k[64];
#pragma unroll
        for (int c = 0; c < 8; ++c) unpack8(*(const GAS v4u*)(P + ms * rs + E_RK + h * 64 + 8 * c), k + 8 * c);
        float acc = 0.f;
#pragma unroll
        for (int i = 0; i < 32; ++i) { const float cs = C_TABC[sc * 32 + i], sn = C_TABS[sc * 32 + i];
            acc += qa[i] * (k[i] * cs - k[32 + i] * sn) + qb[i] * (k[i] * sn + k[32 + i] * cs); }
        const float w = valid ? acc * 0.125f * exp2f((float)(t - s) * lg2) : 0.f;
#pragma unroll 8
        for (int j = 0; j < 64; ++j) { const float wj = __shfl(w, j); const int sj = shi - j; const size_t mj = (size_t)b * SEQ + (sj >= 0 ? sj : 0);
            o0 += wj * bf2f(P[mj * rs + E_RV + h * 128 + lane]); o1 += wj * bf2f(P[mj * rs + E_RV + h * 128 + 64 + lane]); }
    }
    const float rstd = rsqrtf(wave_sum(o0 * o0 + o1 * o1) * (1.f / 128.f) + EPS);
    const float g0 = bf2f(P[m * rs + E_RG + h * 128 + lane]), g1 = bf2f(P[m * rs + E_RG + h * 128 + 64 + lane]);
    C_MIX[m * DM + h * 128 + lane] = (bf16)f2bf(o0 * rstd * siluf_(g0)); C_MIX[m * DM + h * 128 + 64 + lane] = (bf16)f2bf(o1 * rstd * siluf_(g1));
}
template <bool EARLY> __device__ __forceinline__ void naive_sb_token(Ctx& C, int b, int hh, int t) {
    const int lane = C.lane; const size_t rs = EVEN_IN; const bf16* P = C_PROJ; const size_t m = (size_t)b * SEQ + t;
    float q[64];
#pragma unroll
    for (int c = 0; c < 8; ++c) unpack8(*(const GAS v4u*)(P + m * rs + E_SQ + hh * 64 + 8 * c), q + 8 * c);
    float R = 0.f, o = 0.f;
    for (int shi = t - 1; shi >= 0; shi -= 64) {
        const int s = shi - lane; const bool valid = s >= 0; const size_t ms = (size_t)b * SEQ + (valid ? s : 0);
        float acc = 0.f;
#pragma unroll
        for (int c = 0; c < 8; ++c) { float k[8]; unpack8(*(const GAS v4u*)(P + ms * rs + E_SK + hh * 64 + 8 * c), k);
#pragma unroll
            for (int j = 0; j < 8; ++j) acc += q[8 * c + j] * k[j]; }
        const float z = acc * 0.125f, lb = log_sigmoidf_(z), lom = valid ? lb - z : 0.f;
        float incl = lom;
#pragma unroll
        for (int off = 1; off < 64; off <<= 1) { const float tmp = __shfl_up(incl, off); if (lane >= off) incl += tmp; }
        const float w = valid ? __expf(lb + R + (incl - lom)) : 0.f;
        R += __shfl(incl, 63);
#pragma unroll 8
        for (int j = 0; j < 64; ++j) { const float wj = __shfl(w, j); const int sj = shi - j; const size_t mj = (size_t)b * SEQ + (sj >= 0 ? sj : 0);
            o += wj * bf2f(P[mj * rs + E_SV + hh * 64 + lane]); }
        if (EARLY && R < -100.f) break;
    }
    const float g = bf2f(P[m * rs + E_SG + hh * 64 + lane]);
    C_MIX[m * DM + 512 + hh * 64 + lane] = (bf16)f2bf(o * siluf_(g));
}
__device__ __forceinline__ void naive_even_mixer(Ctx& C) {
    constexpr int NRET = BATCH * 4 * 256, NSB = BATCH * 8 * 256;
    for (int u = C.vcu; u < NRET + NSB; u += C.G) {
        if (u < NRET) { const int bh = u >> 8, tb = (u + bh) & 255; naive_ret_token(C, bh >> 2, bh & 3, tb * 8 + C.wave); }
        else { const int v = u - NRET, bh = v >> 8, tb = (v + bh) & 255; naive_sb_token<false>(C, bh >> 3, bh & 7, tb * 8 + C.wave); }
    }
}
__device__ __forceinline__ void naive_hgrn_unit(Ctx& C, int b, int h, int vs, int o, float* OS) {
    const int tid = C.tid, lane = C.lane, k = tid >> 2, vq = tid & 3; const size_t rs = ODD_IN; const bf16* P = C_PROJ;
    LAS float* red = (LAS float*)C.lds;
    const float lb = C_LB[o * 512 + h * 128 + k];
    float st[8];
#pragma unroll
    for (int j = 0; j < 8; ++j) st[j] = 0.f;
    for (int t0 = 0; t0 < SEQ; t0 += 4) {
        float flv[4], qv[4]; v4u vvv[4];
#pragma unroll
        for (int u = 0; u < 4; ++u) { const size_t m = (size_t)b * SEQ + t0 + u; flv[u] = bf2f(P[m * rs + O_HF + h * 128 + k]); qv[u] = bf2f(P[m * rs + O_HQ + h * 128 + k]);
            vvv[u] = *(const GAS v4u*)(P + m * rs + O_HI + h * 128 + vs * 32 + vq * 8); }
#pragma unroll
        for (int u = 0; u < 4; ++u) {
            const int t = t0 + u; const size_t m = (size_t)b * SEQ + t;
            const float fl = flv[u], q = qv[u];
            const float sig = 1.f / (1.f + __expf(-fl)), f = lb + (1.f - lb) * sig, kk = (1.f - lb) / (1.f + __expf(fl));
            float v[8]; unpack8(vvv[u], v);
            float part[8];
#pragma unroll
            for (int j = 0; j < 8; ++j) { st[j] = f * st[j] + kk * v[j]; part[j] = q * st[j]; }
#pragma unroll
            for (int j = 0; j < 8; ++j) { part[j] += __shfl_xor(part[j], 4); part[j] += __shfl_xor(part[j], 8); part[j] += __shfl_xor(part[j], 16); part[j] += __shfl_xor(part[j], 32); }
            LAS float* rb = red + (t & 1) * 256;
            if (lane < 4) {
#pragma unroll
                for (int j = 0; j < 8; ++j) rb[C.wave * 32 + vq * 8 + j] = part[j];
            }
            __syncthreads();
            if (tid < 32) { float s = 0.f;
#pragma unroll
                for (int w = 0; w < 8; ++w) s += rb[w * 32 + tid];
                OS[m * 512 + h * 128 + vs * 32 + tid] = s; }
        }
    }
    __syncthreads();
}
__device__ __forceinline__ void naive_lru_unit(Ctx& C, int b, int n, int o) {
    const int lane = C.lane, wave = C.wave; const size_t rs = ODD_IN; const bf16* P = C_PROJ;
    LAS float* AU = (LAS float*)C.lds;
    LAS float* xb = (LAS float*)(C.lds + XTRA_OFF) + wave * 64;
    const int ch = n * 64 + lane;
    const float* cw = IN(8) + (size_t)o * 4 * 512; const float cb = IN(9)[o * 512 + ch];
    const float w0 = cw[0 * 512 + ch], w1 = cw[1 * 512 + ch], w2 = cw[2 * 512 + ch], w3 = cw[3 * 512 + ch];
    const float* Wa = IN(10) + ((size_t)o * 8 + n) * 4096; const float* Wx = IN(12) + ((size_t)o * 8 + n) * 4096;
    const float ba = IN(11)[o * 512 + ch], bx = IN(13)[o * 512 + ch], lam = IN(14)[o * 512 + ch];
    const float sp = log1pf(expf(-lam));
    float hst = 0.f;
    for (int c = 0; c < 8; ++c) {
        for (int tt = wave * 32; tt < wave * 32 + 32; ++tt) {
            const int t = c * 256 + tt; const size_t m = (size_t)b * SEQ + t;
            float xc = cb + w3 * bf2f(P[m * rs + O_LX + ch]);
            if (t >= 1) xc += w2 * bf2f(P[(m - 1) * rs + O_LX + ch]);
            if (t >= 2) xc += w1 * bf2f(P[(m - 2) * rs + O_LX + ch]);
            if (t >= 3) xc += w0 * bf2f(P[(m - 3) * rs + O_LX + ch]);
            xb[lane] = xc; LDS_WAIT(); asm volatile("" ::: "memory");
            float ra = ba, rx = bx;
            for (int i = 0; i < 64; ++i) { const float xi = xb[i]; ra += xi * Wa[i * 64 + lane]; rx += xi * Wx[i * 64 + lane]; }
            LDS_WAIT(); asm volatile("" ::: "memory");
            const float r = sigmoidf_(ra), ig = sigmoidf_(rx);
            const float la = -8.0f * r * sp, a = __expf(la);
            const float mult = (t == 0) ? 1.0f : sqrtf(-expm1f(2.0f * la));
            AU[(tt * 64 + lane) * 2] = a; AU[(tt * 64 + lane) * 2 + 1] = mult * ig * xc;
        }
        __syncthreads();
        if (wave == 0) {
            for (int tt = 0; tt < 256; ++tt) { const size_t m = (size_t)b * SEQ + c * 256 + tt;
                hst = AU[(tt * 64 + lane) * 2] * hst + AU[(tt * 64 + lane) * 2 + 1];
                const float g = bf2f(P[m * rs + O_LG + ch]);
                C_MIX[m * DM + 512 + ch] = (bf16)f2bf(hst * siluf_(g)); }
        }
        __syncthreads();
    }
}
__device__ __forceinline__ void naive_odd_mixer1(Ctx& C, int o) {
    float* OS = (float*)(C.ws + WS_XN);
    for (int u = C.vcu; u < 256 + 128; u += C.G) {
        if (u < 256) naive_hgrn_unit(C, u >> 4, (u >> 2) & 3, u & 3, o, OS);
        else naive_lru_unit(C, (u - 256) >> 3, (u - 256) & 7, o);
    }
}
__device__ __forceinline__ void naive_odd_mixer2(Ctx& C) {
    const float* OS = (const float*)(C.ws + WS_XN); const bf16* P = C_PROJ; const size_t rs = ODD_IN;
    const int gw = C.vcu * NWAVES + C.wave, NGW = C.G * NWAVES;
    for (int it = gw; it < MTOK * 4; it += NGW) { const size_t m = it >> 2; const int h = it & 3;
        const float o0 = OS[m * 512 + h * 128 + C.lane], o1 = OS[m * 512 + h * 128 + 64 + C.lane];
        const float rstd = rsqrtf(wave_sum(o0 * o0 + o1 * o1) * (1.f / 128.f) + EPS);
        const float g0 = bf2f(P[m * rs + O_HG + h * 128 + C.lane]), g1 = bf2f(P[m * rs + O_HG + h * 128 + 64 + C.lane]);
        C_MIX[m * DM + h * 128 + C.lane] = (bf16)f2bf(o0 * rstd * siluf_(g0)); C_MIX[m * DM + h * 128 + 64 + C.lane] = (bf16)f2bf(o1 * rstd * siluf_(g1)); }
}
typedef float f32x16 __attribute__((ext_vector_type(16)));
typedef short s16x4 __attribute__((ext_vector_type(4)));
typedef __bf16 bf16x2_t __attribute__((ext_vector_type(2)));
typedef float f32x2_t __attribute__((ext_vector_type(2)));
typedef unsigned u32x2 __attribute__((ext_vector_type(2)));
#define MFMA32(a, b, c) __builtin_amdgcn_mfma_f32_32x32x16_bf16((a), (b), (c), 0, 0, 0)
#define MFMA16(a, b, c) __builtin_amdgcn_mfma_f32_16x16x32_bf16((a), (b), (c), 0, 0, 0)
__device__ __forceinline__ unsigned pkbf(float lo, float hi) { const f32x2_t v = {lo, hi}; return __builtin_bit_cast(unsigned, __builtin_convertvector(v, bf16x2_t)); }
__device__ __forceinline__ bf16x8 pack8(float a0, float a1, float a2, float a3, float a4, float a5, float a6, float a7) {
    v4u p; p.x = pkbf(a0, a1); p.y = pkbf(a2, a3); p.z = pkbf(a4, a5); p.w = pkbf(a6, a7); return __builtin_bit_cast(bf16x8, p); }
__device__ __forceinline__ bf16x8 cat4(s16x4 lo, s16x4 hi) { return __builtin_shufflevector(lo, hi, 0, 1, 2, 3, 4, 5, 6, 7); }
__device__ __forceinline__ int crow32(int i, int h) { return (i & 3) + 8 * (i >> 2) + 4 * h; }
__device__ __forceinline__ float fast_log_sigmoid(float z) { return fminf(z, 0.f) - __logf(1.f + __expf(-fabsf(z))); }

__device__ __forceinline__ void sb_wave_unit(Ctx& C, int b, int hh, int qblk) {
    const int lane = C.lane, r = lane & 31, h = lane >> 5;
    const bf16* P = C_PROJ; const size_t rs = EVEN_IN;
    const int t0 = qblk * 32; const size_t m0 = (size_t)b * SEQ + t0;
    bf16x8 qf[4];
#pragma unroll
    for (int ks = 0; ks < 4; ++ks) qf[ks] = *(const GAS bf16x8*)(P + (m0 + r) * rs + E_SQ + hh * 64 + 16 * ks + 8 * h);
    bf16x8 tri[2];
#pragma unroll
    for (int st = 0; st < 2; ++st)
#pragma unroll
        for (int j = 0; j < 8; ++j) { const int k = 16 * st + 8 * (j >> 2) + 4 * h + (j & 3); tri[st][j] = (k > r) ? (short)0x3F80 : (short)0; }
    f32x16 o0, o1;
#pragma unroll
    for (int i = 0; i < 16; ++i) { o0[i] = 0.f; o1[i] = 0.f; }
    float R = 0.f;
    const bf16* vt = C_VT1 + ((size_t)(b * 512 + hh * 64 + r)) * 2048;
    for (int s0 = t0; s0 >= 0; s0 -= 32) {
        const bf16* kp = P + ((size_t)b * SEQ + s0 + r) * rs + E_SK + hh * 64 + 8 * h;
        bf16x8 kf[4];
#pragma unroll
        for (int ks = 0; ks < 4; ++ks) kf[ks] = *(const GAS bf16x8*)(kp + 16 * ks);
        s16x4 va[2][2][2];
#pragma unroll
        for (int mt = 0; mt < 2; ++mt)
#pragma unroll
            for (int st = 0; st < 2; ++st)
#pragma unroll
                for (int hf = 0; hf < 2; ++hf) va[mt][st][hf] = *(const GAS s16x4*)(vt + (size_t)mt * 32 * 2048 + s0 + 16 * st + 8 * hf + 4 * h);
        f32x16 x;
#pragma unroll
        for (int i = 0; i < 16; ++i) x[i] = 0.f;
#pragma unroll
        for (int ks = 0; ks < 4; ++ks) x = MFMA32(kf[ks], qf[ks], x);
        const bool diag = (s0 == t0);
        float lom[16], lbv[16];
#pragma unroll
        for (int i = 0; i < 16; ++i) { const float z = x[i] * 0.125f, lb = fast_log_sigmoid(z); const bool valid = !diag || (crow32(i, h) < r);
            lom[i] = valid ? lb - z : 0.f; lbv[i] = valid ? lb : -1e30f; }
        const bf16x8 lf0 = pack8(lom[0], lom[1], lom[2], lom[3], lom[4], lom[5], lom[6], lom[7]);
        const bf16x8 lf1 = pack8(lom[8], lom[9], lom[10], lom[11], lom[12], lom[13], lom[14], lom[15]);
        f32x16 y;
#pragma unroll
        for (int i = 0; i < 16; ++i) y[i] = 0.f;
        y = MFMA32(tri[0], lf0, y); y = MFMA32(tri[1], lf1, y);
        const float tot = __shfl(y[0] + lom[0], r);
        float w[16];
#pragma unroll
        for (int i = 0; i < 16; ++i) w[i] = __expf(lbv[i] + y[i] + R);
        R += tot;
        const bf16x8 wf0 = pack8(w[0], w[1], w[2], w[3], w[4], w[5], w[6], w[7]);
        const bf16x8 wf1 = pack8(w[8], w[9], w[10], w[11], w[12], w[13], w[14], w[15]);
        o0 = MFMA32(cat4(va[0][0][0], va[0][0][1]), wf0, o0); o0 = MFMA32(cat4(va[0][1][0], va[0][1][1]), wf1, o0);
        o1 = MFMA32(cat4(va[1][0][0], va[1][0][1]), wf0, o1); o1 = MFMA32(cat4(va[1][1][0], va[1][1][1]), wf1, o1);
        if (__all(R < -100.f)) break;
    }
    const bf16* gp = P + (m0 + r) * rs + E_SG + hh * 64 + 4 * h;
    bf16* op = C_MIX + (m0 + r) * DM + 512 + hh * 64 + 4 * h;
#pragma unroll
    for (int mt = 0; mt < 2; ++mt)
#pragma unroll
        for (int q4 = 0; q4 < 4; ++q4) {
            const u32x2 gv = *(const GAS u32x2*)(gp + 32 * mt + 8 * q4);
            const float g0 = __uint_as_float(gv.x << 16), g1 = __uint_as_float(gv.x & 0xffff0000u), g2 = __uint_as_float(gv.y << 16), g3 = __uint_as_float(gv.y & 0xffff0000u);
            const float a0 = mt ? o1[4 * q4 + 0] : o0[4 * q4 + 0], a1 = mt ? o1[4 * q4 + 1] : o0[4 * q4 + 1], a2 = mt ? o1[4 * q4 + 2] : o0[4 * q4 + 2], a3 = mt ? o1[4 * q4 + 3] : o0[4 * q4 + 3];
            u32x2 ov; ov.x = pkbf(a0 * siluf_(g0), a1 * siluf_(g1)); ov.y = pkbf(a2 * siluf_(g2), a3 * siluf_(g3));
            *(GAS u32x2*)(op + 32 * mt + 8 * q4) = ov;
        }
}

constexpr int RT_Q = 0, RT_K = 18432, RT_KT = 36864, RT_V = 54272, RT_S = 89088;
__device__ __forceinline__ void ret_unit(Ctx& C, int b, int h) {
    const int tid = C.tid, lane = C.lane, w = C.wave, fr = lane & 15, g = lane >> 4;
    LAS unsigned char* L = C.lds;
    const bf16* P = C_PROJ; const size_t rs = EVEN_IN;
    const float lg2 = log2f(1.0f - exp2f(-5.0f - (float)h));
    const float gC = exp2f(128.0f * lg2);
    f32x4 st[4];
#pragma unroll
    for (int nt = 0; nt < 4; ++nt) st[nt] = (f32x4){0.f, 0.f, 0.f, 0.f};
    for (int i = tid; i < 18432 / 4; i += 512) ((LAS unsigned*)(L + RT_S))[i] = 0u;
    for (int c = 0; c < 16; ++c) {
        {
            const int tt = tid >> 2, part = tid & 3, t = 128 * c + tt; const size_t m = (size_t)b * SEQ + t;
            float qa[8], qb[8], ka[8], kb[8], cs[8], sn[8];
            unpack8(*(const GAS v4u*)(P + m * rs + E_RQ + h * 64 + 8 * part), qa); unpack8(*(const GAS v4u*)(P + m * rs + E_RQ + h * 64 + 32 + 8 * part), qb);
            unpack8(*(const GAS v4u*)(P + m * rs + E_RK + h * 64 + 8 * part), ka); unpack8(*(const GAS v4u*)(P + m * rs + E_RK + h * 64 + 32 + 8 * part), kb);
            { const f32x4 c0 = *(const GAS f32x4*)(C_TABC + t * 32 + 8 * part), c1 = *(const GAS f32x4*)(C_TABC + t * 32 + 8 * part + 4);
              const f32x4 s0 = *(const GAS f32x4*)(C_TABS + t * 32 + 8 * part), s1 = *(const GAS f32x4*)(C_TABS + t * 32 + 8 * part + 4);
              cs[0] = c0.x; cs[1] = c0.y; cs[2] = c0.z; cs[3] = c0.w; cs[4] = c1.x; cs[5] = c1.y; cs[6] = c1.z; cs[7] = c1.w;
              sn[0] = s0.x; sn[1] = s0.y; sn[2] = s0.z; sn[3] = s0.w; sn[4] = s1.x; sn[5] = s1.y; sn[6] = s1.z; sn[7] = s1.w; }
            const float fq = exp2f((float)tt * lg2), fk = 0.125f * exp2f(-(float)tt * lg2);
            float q1[8], q2[8], k1[8], k2[8];
#pragma unroll
            for (int j = 0; j < 8; ++j) { q1[j] = (qa[j] * cs[j] - qb[j] * sn[j]) * fq; q2[j] = (qa[j] * sn[j] + qb[j] * cs[j]) * fq;
                                          k1[j] = (ka[j] * cs[j] - kb[j] * sn[j]) * fk; k2[j] = (ka[j] * sn[j] + kb[j] * cs[j]) * fk; }
            *(LAS bf16x8*)(L + RT_Q + tt * 144 + 16 * part) = pack8(q1[0], q1[1], q1[2], q1[3], q1[4], q1[5], q1[6], q1[7]);
            *(LAS bf16x8*)(L + RT_Q + tt * 144 + 64 + 16 * part) = pack8(q2[0], q2[1], q2[2], q2[3], q2[4], q2[5], q2[6], q2[7]);
            *(LAS bf16x8*)(L + RT_K + tt * 144 + 16 * part) = pack8(k1[0], k1[1], k1[2], k1[3], k1[4], k1[5], k1[6], k1[7]);
            *(LAS bf16x8*)(L + RT_K + tt * 144 + 64 + 16 * part) = pack8(k2[0], k2[1], k2[2], k2[3], k2[4], k2[5], k2[6], k2[7]);
#pragma unroll
            for (int j = 0; j < 8; ++j) { *(LAS bf16*)(L + RT_KT + (8 * part + j) * 272 + tt * 2) = (bf16)f2bf(k1[j]); *(LAS bf16*)(L + RT_KT + (32 + 8 * part + j) * 272 + tt * 2) = (bf16)f2bf(k2[j]); }
            const int dv = tid >> 2, seg = tid & 3;
            const bf16* vsrc = C_VT0 + ((size_t)(b * 512 + h * 128 + dv)) * 2048 + 128 * c + seg * 32;
#pragma unroll
            for (int i = 0; i < 4; ++i) *(LAS v4u*)(L + RT_V + dv * 272 + (seg * 32 + 8 * i) * 2) = *(const GAS v4u*)(vsrc + 8 * i);
        }
        __syncthreads();
        bf16x8 qf[2];
#pragma unroll
        for (int ks = 0; ks < 2; ++ks) qf[ks] = *(const LAS bf16x8*)(L + RT_Q + (16 * w + fr) * 144 + (32 * ks + 8 * g) * 2);
        f32x4 o[8];
#pragma unroll
        for (int mt = 0; mt < 8; ++mt) o[mt] = (f32x4){0.f, 0.f, 0.f, 0.f};
#pragma unroll
        for (int kp = 0; kp < 4; ++kp) {
            if (kp <= (w >> 1)) {
                f32x4 s0 = (f32x4){0.f, 0.f, 0.f, 0.f}, s1 = (f32x4){0.f, 0.f, 0.f, 0.f};
#pragma unroll
                for (int ks = 0; ks < 2; ++ks) {
                    const bf16x8 a0 = *(const LAS bf16x8*)(L + RT_K + (32 * kp + fr) * 144 + (32 * ks + 8 * g) * 2);
                    const bf16x8 a1 = *(const LAS bf16x8*)(L + RT_K + (32 * kp + 16 + fr) * 144 + (32 * ks + 8 * g) * 2);
                    s0 = MFMA16(a0, qf[ks], s0); s1 = MFMA16(a1, qf[ks], s1);
                }
                const int tq = 16 * w + fr;
#pragma unroll
                for (int r = 0; r < 4; ++r) { if (32 * kp + 4 * g + r > tq) s0[r] = 0.f; if (32 * kp + 16 + 4 * g + r > tq) s1[r] = 0.f; }
                const bf16x8 pf = pack8(s0[0], s0[1], s0[2], s0[3], s1[0], s1[1], s1[2], s1[3]);
#pragma unroll
                for (int mt = 0; mt < 8; ++mt) {
                    const s16x4 lo = *(const LAS s16x4*)(L + RT_V + (16 * mt + fr) * 272 + (32 * kp + 4 * g) * 2);
                    const s16x4 hi = *(const LAS s16x4*)(L + RT_V + (16 * mt + fr) * 272 + (32 * kp + 16 + 4 * g) * 2);
                    o[mt] = MFMA16(cat4(lo, hi), pf, o[mt]);
                }
            }
        }
#pragma unroll
        for (int mt = 0; mt < 8; ++mt)
#pragma unroll
            for (int ks = 0; ks < 2; ++ks) o[mt] = MFMA16(*(const LAS bf16x8*)(L + RT_S + (16 * mt + fr) * 144 + (32 * ks + 8 * g) * 2), qf[ks], o[mt]);
#pragma unroll
        for (int ks = 0; ks < 4; ++ks) {
            const bf16x8 av = *(const LAS bf16x8*)(L + RT_V + (16 * w + fr) * 272 + (32 * ks + 8 * g) * 2);
#pragma unroll
            for (int nt = 0; nt < 4; ++nt) st[nt] = MFMA16(av, *(const LAS bf16x8*)(L + RT_KT + (16 * nt + fr) * 272 + (32 * ks + 8 * g) * 2), st[nt]);
        }
#pragma unroll
        for (int nt = 0; nt < 4; ++nt) st[nt] = st[nt] * gC;
        __syncthreads();
#pragma unroll
        for (int nt = 0; nt < 4; ++nt)
#pragma unroll
            for (int r = 0; r < 4; ++r) *(LAS bf16*)(L + RT_S + (16 * w + 4 * g + r) * 144 + (16 * nt + fr) * 2) = (bf16)f2bf(st[nt][r]);
        float ss = 0.f;
#pragma unroll
        for (int mt = 0; mt < 8; ++mt) ss += (o[mt][0] * o[mt][0] + o[mt][1] * o[mt][1]) + (o[mt][2] * o[mt][2] + o[mt][3] * o[mt][3]);
        ss += __shfl_xor(ss, 16); ss += __shfl_xor(ss, 32);
        const float rstd = rsqrtf(ss * (1.f / 128.f) + EPS);
        const size_t m = (size_t)b * SEQ + 128 * c + 16 * w + fr;
#pragma unroll
        for (int mt = 0; mt < 8; ++mt) {
            const u32x2 gv = *(const GAS u32x2*)(P + m * rs + E_RG + h * 128 + 16 * mt + 4 * g);
            const float g0 = __uint_as_float(gv.x << 16), g1 = __uint_as_float(gv.x & 0xffff0000u), g2 = __uint_as_float(gv.y << 16), g3 = __uint_as_float(gv.y & 0xffff0000u);
            u32x2 ov; ov.x = pkbf(o[mt][0] * rstd * siluf_(g0), o[mt][1] * rstd * siluf_(g1)); ov.y = pkbf(o[mt][2] * rstd * siluf_(g2), o[mt][3] * rstd * siluf_(g3));
            *(GAS u32x2*)(C_MIX + m * DM + h * 128 + 16 * mt + 4 * g) = ov;
        }
    }
    __syncthreads();
}
constexpr int CW_CTR = 64;
__device__ __forceinline__ void opt_even_mixer(Ctx& C, int li) {
    if (blockIdx.x < 64) ret_unit(C, (int)blockIdx.x >> 2, (int)blockIdx.x & 3);
    unsigned* ctr = (unsigned*)(C.ws + WS_CTL) + CW_CTR + 64 * li;
    for (;;) {
        unsigned u = 0; if (C.lane == 0) u = __hip_atomic_fetch_add(ctr, 1u, __ATOMIC_RELAXED, __HIP_MEMORY_SCOPE_AGENT);
        u = __builtin_amdgcn_readfirstlane(u);
        if (u >= (unsigned)(BATCH * 8 * 64)) break;
        const int qblk = 63 - (int)(u >> 7), bh = (int)(u & 127);
        sb_wave_unit(C, bh >> 3, bh & 7, qblk);
    }
}

constexpr size_t WS_GD = 37 * MiB;
constexpr int H1_QR = 0, H1_KR = 17408, H1_KD = 34816, H1_QX = 52224, H1_TOT = 65280;
__device__ __forceinline__ void hg1_unit(Ctx& C, int u, int o) {
    const int sc = u & 31, bh = u >> 5, b = bh >> 2, h = bh & 3;
    const int lane = C.lane, w = C.wave, fr = lane & 15, g = lane >> 4;
    const int i = w >> 1, k = 64 * (w & 1) + lane;
    LAS unsigned char* L = C.lds; bf16* P = C_PROJ; const size_t rs = ODD_IN;
    const float lb = C_LB[o * 512 + h * 128 + k];
    const size_t m0 = (size_t)b * SEQ + 64 * sc + 16 * i;
    float q[16], kk[16], c[16]; float run = 0.f;
#pragma unroll
    for (int j = 0; j < 16; ++j) {
        const float fl = bf2f(P[(m0 + j) * rs + O_HF + h * 128 + k]); q[j] = bf2f(P[(m0 + j) * rs + O_HQ + h * 128 + k]);
        const float sig = 1.f / (1.f + __expf(-fl)), f = lb + (1.f - lb) * sig;
        run += __logf(f); c[j] = run; kk[j] = (1.f - lb) / (1.f + __expf(fl));
    }
    ((LAS float*)(L + H1_TOT))[i * 128 + k] = run;
    __syncthreads();
    const float t0 = ((LAS float*)(L + H1_TOT))[k], t1 = ((LAS float*)(L + H1_TOT))[128 + k], t2 = ((LAS float*)(L + H1_TOT))[256 + k], t3 = ((LAS float*)(L + H1_TOT))[384 + k];
    const float Bi = (i > 0 ? t0 : 0.f) + (i > 1 ? t1 : 0.f) + (i > 2 ? t2 : 0.f), B4 = (t0 + t1) + (t2 + t3), Bn = Bi + run;
    const float eBi = __expf(Bi), eEnd = __expf(B4 - Bn), eD = __expf(-run);
    const float fx0 = (i == 2) ? __expf(t1) : ((i == 3) ? __expf(t2) : 0.f), fx1 = (i == 3) ? __expf(t1 + t2) : 0.f;
    float ksv[16];
#pragma unroll
    for (int j = 0; j < 16; ++j) {
        const float qr = q[j] * __expf(c[j]), kr = kk[j] * __expf(run - c[j]);
        const int row = 16 * i + j;
        *(LAS bf16*)(L + H1_QR + row * 272 + k * 2) = (bf16)f2bf(qr);
        *(LAS bf16*)(L + H1_KR + row * 272 + k * 2) = (bf16)f2bf(kr);
        *(LAS bf16*)(L + H1_KD + row * 272 + k * 2) = (bf16)f2bf(kr * eD);
        if (i == 2) *(LAS bf16*)(L + H1_QX + j * 272 + k * 2) = (bf16)f2bf(qr * fx0);
        if (i == 3) { *(LAS bf16*)(L + H1_QX + (16 + j) * 272 + k * 2) = (bf16)f2bf(qr * fx0);
                      *(LAS bf16*)(L + H1_QX + (32 + j) * 272 + k * 2) = (bf16)f2bf(qr * fx1); }
        P[(m0 + j) * rs + O_HQ + h * 128 + k] = (bf16)f2bf(qr * eBi);
        ksv[j] = kr * eEnd;
    }
    {
        bf16* kd = C_KST + ((size_t)u * 128 + k) * 64 + 16 * i;
        v4u p0, p1; p0.x = pkbf(ksv[0], ksv[1]); p0.y = pkbf(ksv[2], ksv[3]); p0.z = pkbf(ksv[4], ksv[5]); p0.w = pkbf(ksv[6], ksv[7]);
        p1.x = pkbf(ksv[8], ksv[9]); p1.y = pkbf(ksv[10], ksv[11]); p1.z = pkbf(ksv[12], ksv[13]); p1.w = pkbf(ksv[14], ksv[15]);
        *(GAS v4u*)kd = p0; *(GAS v4u*)(kd + 8) = p1;
        if (i == 0) ((float*)(C.ws + WS_GD))[(size_t)u * 128 + k] = __expf(B4);
    }
    __syncthreads();
    const int ti = w & 3, vh = w >> 2;
    f32x4 at[4];
#pragma unroll
    for (int sj = 0; sj < 4; ++sj) {
        at[sj] = (f32x4){0.f, 0.f, 0.f, 0.f};
        if (sj <= ti) {
            const int kbase = (sj == ti) ? H1_KD : H1_KR;
            const int gap = ti - sj;
            const int qbase = (gap <= 1) ? (H1_QR + 16 * ti * 272) : ((ti == 2) ? H1_QX : ((sj == 1) ? (H1_QX + 16 * 272) : (H1_QX + 32 * 272)));
#pragma unroll
            for (int ks = 0; ks < 4; ++ks) {
                const bf16x8 a = *(const LAS bf16x8*)(L + kbase + (16 * sj + fr) * 272 + (32 * ks + 8 * g) * 2);
                const bf16x8 bq = *(const LAS bf16x8*)(L + qbase + fr * 272 + (32 * ks + 8 * g) * 2);
                at[sj] = MFMA16(a, bq, at[sj]);
            }
            if (sj == ti) {
#pragma unroll
                for (int r = 0; r < 4; ++r) if (4 * g + r > fr) at[sj][r] = 0.f;
            }
        }
    }
    f32x4 oo[4];
#pragma unroll
    for (int mt = 0; mt < 4; ++mt) oo[mt] = (f32x4){0.f, 0.f, 0.f, 0.f};
    const bf16* vtb = C_VT0 + ((size_t)(b * 512 + h * 128 + 64 * vh + fr)) * 2048 + 64 * sc + 4 * g;
#pragma unroll
    for (int kp = 0; kp < 2; ++kp) {
        if (2 * kp <= ti) {
            const bf16x8 pf = kp == 0 ? pack8(at[0][0], at[0][1], at[0][2], at[0][3], at[1][0], at[1][1], at[1][2], at[1][3]) : pack8(at[2][0], at[2][1], at[2][2], at[2][3], at[3][0], at[3][1], at[3][2], at[3][3]);
#pragma unroll
            for (int mt = 0; mt < 4; ++mt) {
                const s16x4 lo = *(const GAS s16x4*)(vtb + (size_t)mt * 16 * 2048 + 32 * kp), hi = *(const GAS s16x4*)(vtb + (size_t)mt * 16 * 2048 + 32 * kp + 16);
                oo[mt] = MFMA16(cat4(lo, hi), pf, oo[mt]);
            }
        }
    }
    bf16* op = C_MIX + ((size_t)b * SEQ + 64 * sc + 16 * ti + fr) * DM + h * 128 + 64 * vh + 4 * g;
#pragma unroll
    for (int mt = 0; mt < 4; ++mt) { u32x2 ov; ov.x = pkbf(oo[mt][0], oo[mt][1]); ov.y = pkbf(oo[mt][2], oo[mt][3]); *(GAS u32x2*)(op + 16 * mt) = ov; }
    __syncthreads();
}

constexpr int H2_ST = 0, H2_SS = 34816;
__device__ __forceinline__ void hg2_unit(Ctx& C, int bh) {
    const int b = bh >> 2, h = bh & 3;
    const int tid = C.tid, lane = C.lane, w = C.wave, fr = lane & 15, g = lane >> 4, ti = w & 3, vh = w >> 2;
    LAS unsigned char* L = C.lds; const bf16* P = C_PROJ; const size_t rs = ODD_IN;
    f32x4 st[8];
#pragma unroll
    for (int nt = 0; nt < 8; ++nt) st[nt] = (f32x4){0.f, 0.f, 0.f, 0.f};
    for (int i = tid; i < 34816 / 4; i += 512) ((LAS unsigned*)(L + H2_ST))[i] = 0u;
    __syncthreads();
    for (int sc = 0; sc < 32; ++sc) {
        const int u = bh * 32 + sc; const size_t m = (size_t)b * SEQ + 64 * sc + 16 * ti + fr;
        bf16x8 qf[4], ka[2], vb[8][2];
#pragma unroll
        for (int ks = 0; ks < 4; ++ks) qf[ks] = *(const GAS bf16x8*)(P + m * rs + O_HQ + h * 128 + 32 * ks + 8 * g);
#pragma unroll
        for (int ks = 0; ks < 2; ++ks) ka[ks] = *(const GAS bf16x8*)(C_KST + ((size_t)u * 128 + 16 * w + fr) * 64 + 32 * ks + 8 * g);
#pragma unroll
        for (int nt = 0; nt < 8; ++nt)
#pragma unroll
            for (int ks = 0; ks < 2; ++ks) vb[nt][ks] = *(const GAS bf16x8*)(C_VT0 + ((size_t)(b * 512 + h * 128 + 16 * nt + fr)) * 2048 + 64 * sc + 32 * ks + 8 * g);
        const f32x4 gd = *(const GAS f32x4*)((const float*)(C.ws + WS_GD) + (size_t)u * 128 + 16 * w + 4 * g);
        f32x4 o[4];
#pragma unroll
        for (int mt = 0; mt < 4; ++mt) {
            o[mt] = (f32x4){0.f, 0.f, 0.f, 0.f};
#pragma unroll
            for (int ks = 0; ks < 4; ++ks) o[mt] = MFMA16(*(const LAS bf16x8*)(L + H2_ST + (64 * vh + 16 * mt + fr) * 272 + (32 * ks + 8 * g) * 2), qf[ks], o[mt]);
        }
        bf16* op = C_MIX + m * DM + h * 128 + 64 * vh + 4 * g;
        float ss = 0.f;
#pragma unroll
        for (int mt = 0; mt < 4; ++mt) { const u32x2 iv = *(const GAS u32x2*)(op + 16 * mt);
            o[mt][0] += __uint_as_float(iv.x << 16); o[mt][1] += __uint_as_float(iv.x & 0xffff0000u); o[mt][2] += __uint_as_float(iv.y << 16); o[mt][3] += __uint_as_float(iv.y & 0xffff0000u);
            ss += (o[mt][0] * o[mt][0] + o[mt][1] * o[mt][1]) + (o[mt][2] * o[mt][2] + o[mt][3] * o[mt][3]); }
        ss += __shfl_xor(ss, 16); ss += __shfl_xor(ss, 32);
        if (g == 0) ((LAS float*)(L + H2_SS))[vh * 64 + 16 * ti + fr] = ss;
        __syncthreads();
#pragma unroll
        for (int nt = 0; nt < 8; ++nt) { st[nt] = st[nt] * gd;
#pragma unroll
            for (int ks = 0; ks < 2; ++ks) st[nt] = MFMA16(ka[ks], vb[nt][ks], st[nt]); }
#pragma unroll
        for (int nt = 0; nt < 8; ++nt) { u32x2 sv; sv.x = pkbf(st[nt][0], st[nt][1]); sv.y = pkbf(st[nt][2], st[nt][3]); *(LAS u32x2*)(L + H2_ST + (16 * nt + fr) * 272 + (16 * w + 4 * g) * 2) = sv; }
        const float tot = ((LAS float*)(L + H2_SS))[16 * ti + fr] + ((LAS float*)(L + H2_SS))[64 + 16 * ti + fr];
        const float rstd = rsqrtf(tot * (1.f / 128.f) + EPS);
#pragma unroll
        for (int mt = 0; mt < 4; ++mt) {
            const u32x2 gv = *(const GAS u32x2*)(P + m * rs + O_HG + h * 128 + 64 * vh + 16 * mt + 4 * g);
            const float g0 = __uint_as_float(gv.x << 16), g1 = __uint_as_float(gv.x & 0xffff0000u), g2 = __uint_as_float(gv.y << 16), g3 = __uint_as_float(gv.y & 0xffff0000u);
            u32x2 ov; ov.x = pkbf(o[mt][0] * rstd * siluf_(g0), o[mt][1] * rstd * siluf_(g1)); ov.y = pkbf(o[mt][2] * rstd * siluf_(g2), o[mt][3] * rstd * siluf_(g3));
            *(GAS u32x2*)(op + 16 * mt) = ov;
        }
        __syncthreads();
    }
}

constexpr int LR_WA = 0, LR_WX = 9216, LR_PW = 18432, LR_PWSZ = 14848, LR_XC = 0, LR_XCF = 2304, LR_AU = 6400, LR_CAR = 18432 + 8 * 14848;
__device__ __forceinline__ void lru_unit(Ctx& C, int b, int n, int o) {
    const int tid = C.tid, lane = C.lane, w = C.wave, fr = lane & 15, g = lane >> 4;
    LAS unsigned char* L = C.lds; const bf16* P = C_PROJ; const size_t rs = ODD_IN;
    {
        const float* Wa = IN(10) + ((size_t)o * 8 + n) * 4096; const float* Wx = IN(12) + ((size_t)o * 8 + n) * 4096;
        for (int e = tid; e < 4096; e += 512) { const int i = e >> 6, j = e & 63;
            *(LAS bf16*)(L + LR_WA + j * 144 + i * 2) = (bf16)f2bf(Wa[e]); *(LAS bf16*)(L + LR_WX + j * 144 + i * 2) = (bf16)f2bf(Wx[e]); }
    }
    const int ch = n * 64 + lane;
    const float* cw = IN(8) + (size_t)o * 4 * 512; const float cb = IN(9)[o * 512 + ch];
    const float w0 = cw[ch], w1 = cw[512 + ch], w2 = cw[1024 + ch], w3 = cw[1536 + ch];
    float ba[4], bx[4], sp8[4];
#pragma unroll
    for (int nt = 0; nt < 4; ++nt) { const int cj = o * 512 + n * 64 + 16 * nt + fr; ba[nt] = IN(11)[cj]; bx[nt] = IN(13)[cj]; sp8[nt] = 8.0f * log1pf(expf(-IN(14)[cj])); }
    LAS unsigned char* PW = L + LR_PW + w * LR_PWSZ;
    __syncthreads();
    float hin = 0.f;
    const size_t mb = (size_t)b * SEQ;
    for (int pass = 0; pass < 2; ++pass) {
        float hs = hin, aprod = 1.f;
        const int tw = 256 * w;
        float xm1 = tw >= 1 ? bf2f(P[(mb + tw - 1) * rs + O_LX + ch]) : 0.f, xm2 = tw >= 2 ? bf2f(P[(mb + tw - 2) * rs + O_LX + ch]) : 0.f, xm3 = tw >= 3 ? bf2f(P[(mb + tw - 3) * rs + O_LX + ch]) : 0.f;
        for (int tile = 0; tile < 16; ++tile) {
            const int t0 = tw + 16 * tile;
            float xv[16];
#pragma unroll
            for (int p = 0; p < 16; ++p) xv[p] = bf2f(P[(mb + t0 + p) * rs + O_LX + ch]);
#pragma unroll
            for (int p = 0; p < 16; ++p) { const float xc = cb + w3 * xv[p] + w2 * xm1 + w1 * xm2 + w0 * xm3; xm3 = xm2; xm2 = xm1; xm1 = xv[p];
                *(LAS bf16*)(PW + LR_XC + p * 144 + lane * 2) = (bf16)f2bf(xc); ((LAS float*)(PW + LR_XCF))[p * 64 + lane] = xc; }
            asm volatile("s_waitcnt lgkmcnt(0)" ::: "memory");
            f32x4 ra[4], rx[4];
#pragma unroll
            for (int nt = 0; nt < 4; ++nt) { ra[nt] = (f32x4){0.f, 0.f, 0.f, 0.f}; rx[nt] = (f32x4){0.f, 0.f, 0.f, 0.f}; }
#pragma unroll
            for (int ks = 0; ks < 2; ++ks) {
                const bf16x8 a = *(const LAS bf16x8*)(PW + LR_XC + fr * 144 + (32 * ks + 8 * g) * 2);
#pragma unroll
                for (int nt = 0; nt < 4; ++nt) {
                    ra[nt] = MFMA16(a, *(const LAS bf16x8*)(L + LR_WA + (16 * nt + fr) * 144 + (32 * ks + 8 * g) * 2), ra[nt]);
                    rx[nt] = MFMA16(a, *(const LAS bf16x8*)(L + LR_WX + (16 * nt + fr) * 144 + (32 * ks + 8 * g) * 2), rx[nt]);
                }
            }
#pragma unroll
            for (int nt = 0; nt < 4; ++nt)
#pragma unroll
                for (int r = 0; r < 4; ++r) {
                    const int p = 4 * g + r, j = 16 * nt + fr;
                    const float rr = sigmoidf_(ra[nt][r] + ba[nt]), ig = sigmoidf_(rx[nt][r] + bx[nt]);
                    const float la = -rr * sp8[nt], a = __expf(la);
                    const float mult = (t0 + p == 0) ? 1.0f : sqrtf(fmaxf(1.0f - a * a, 0.f));
                    const float xcv = ((const LAS float*)(PW + LR_XCF))[p * 64 + j];
                    f32x2_t au; au.x = a; au.y = mult * ig * xcv;
                    *(LAS f32x2_t*)(PW + LR_AU + (p * 64 + j) * 8) = au;
                }
            asm volatile("s_waitcnt lgkmcnt(0)" ::: "memory");
            if (pass == 0) {
#pragma unroll
                for (int p = 0; p < 16; ++p) { const f32x2_t au = *(const LAS f32x2_t*)(PW + LR_AU + (p * 64 + lane) * 8); hs = au.x * hs + au.y; aprod *= au.x; }
            } else {
                float gv[16];
#pragma unroll
                for (int p = 0; p < 16; ++p) gv[p] = bf2f(P[(mb + t0 + p) * rs + O_LG + ch]);
#pragma unroll
                for (int p = 0; p < 16; ++p) { const f32x2_t au = *(const LAS f32x2_t*)(PW + LR_AU + (p * 64 + lane) * 8); hs = au.x * hs + au.y;
                    C_MIX[(mb + t0 + p) * DM + 512 + ch] = (bf16)f2bf(hs * siluf_(gv[p])); }
            }
            asm volatile("s_waitcnt lgkmcnt(0)" ::: "memory");
        }
        if (pass == 0) {
            f32x2_t cr; cr.x = aprod; cr.y = hs;
            *(LAS f32x2_t*)(L + LR_CAR + (w * 64 + lane) * 8) = cr;
            __syncthreads();
            hin = 0.f;
            for (int ww = 0; ww < w; ++ww) { const f32x2_t cc = *(const LAS f32x2_t*)(L + LR_CAR + (ww * 64 + lane) * 8); hin = cc.x * hin + cc.y; }
        }
    }
    __syncthreads();
}
__device__ __forceinline__ void opt_odd_mixer1(Ctx& C, int o) {
    const int per = (2048 + C.G - 1) / C.G;
    for (int kk = 0; kk < per; ++kk) { const int u = C.vcu * per + kk; if (u < 2048) hg1_unit(C, u, o); }
}
__device__ __forceinline__ void opt_odd_mixer2(Ctx& C, int o) {
    const int bx = (int)blockIdx.x;
    if (bx < 64) hg2_unit(C, bx);
    else if (bx < 192) lru_unit(C, (bx - 64) >> 3, (bx - 64) & 7, o);
}
__global__ void __launch_bounds__(NWAVES * 64, 2) mega_fwd(Params prm) {
    extern __shared__ __attribute__((aligned(16))) unsigned char lds_raw[];
    Ctx C0;
    Ctx& C = C0;
    C.lds = (LAS unsigned char*)lds_raw;
    volatile LAS unsigned* MISC = (volatile LAS unsigned*)(C.lds + LDSCTL_OFF);
    C.tid = threadIdx.x; C.lane = C.tid & 63; C.wave = __builtin_amdgcn_readfirstlane(C.tid >> 6);
    C.G = gridDim.x; { const int bx = blockIdx.x; C.vcu = (C.G % 8 == 0) ? (bx % 8) * (C.G / 8) + bx / 8 : bx; }
    C.ws = prm.ws;
    gu32* ctl = (gu32*)(prm.ws + WS_CTL);
    for (int u = C.tid; u < (LDS_BYTES - LDSCTL_OFF) / 4; u += NWAVES * 64) ((LAS unsigned*)(C.lds + LDSCTL_OFF))[u] = 0u;
    __syncthreads();
    XcdBarrier bar = xcd_barrier_post((unsigned*)(ctl + CW_BAR), MISC + 8);
#define GRID_BAR() xcd_barrier(bar)
#define FRESH() Ctx C = C0; asm volatile("" : "+v"(C.tid)); C.lane = C.tid & 63; C.wave = __builtin_amdgcn_readfirstlane(C.tid >> 6); asm volatile("" : "+s"(C.ws)); asm volatile("" : "+s"(C.vcu))

    { FRESH(); p0_prologue(C); }
    GRID_BAR();

    for (int L = 0; L < 4; ++L) {
        const bool even = (L & 1) == 0; const int li = L >> 1;
        { FRESH();
            const int N = even ? EVEN_IN : ODD_IN;
            const size_t woff = (L == 0) ? WS_WIN0 : (L == 1) ? WS_WIN1 : (L == 2) ? WS_WIN2 : WS_WIN3;
            pg8::Gemm g{C_XN, (const bf16*)(C.ws + woff), MTOK, N, DM}; pg8::StaticOrder S; S.init(MTOK, N, C.G, (int)blockIdx.x);
            pg8::EpiProj E{C_PROJ, N, C_VT0, even ? E_RV : O_HI, C_VT1, even ? E_SV : -100000, 1};
            pg8::gemm_phase<pg8::EpiProj, pg8::StaticOrder, true, true>(C.lds, g, S, E);
        }
        GRID_BAR();
        if (even) { { FRESH(); opt_even_mixer(C, li); } GRID_BAR(); }
        else { { FRESH(); opt_odd_mixer1(C, li); } GRID_BAR(); { FRESH(); opt_odd_mixer2(C, li); } GRID_BAR(); }
        { FRESH();
            pg8::Gemm g{C_MIX, (const bf16*)(C.ws + WS_WOUT + (size_t)L * 2 * MiB), MTOK, DM, DM}; pg8::StaticOrder S; S.init(MTOK, DM, C.G, (int)blockIdx.x);
            pg8::EpiProj E{C_PROJ, DM, nullptr, -100000, nullptr, -100000, 1};
            pg8::gemm_phase<pg8::EpiProj, pg8::StaticOrder, true, true>(C.lds, g, S, E);
        }
        GRID_BAR();
        { FRESH(); norm_rows_phase(C, C_PROJ, L == 0 ? IN(0) : OUTP(), IN(2) + (size_t)L * DM, L < 3 ? IN(1) + (size_t)(L + 1) * DM : nullptr); }
        if (L < 3) GRID_BAR();
    }
}

extern "C" void kernel_launch(void* const* d_in, const int* in_sizes, int n_in, void* d_out, int out_size, void* d_ws, size_t ws_size, hipStream_t stream) {
    static int grid = 0;
    if (grid == 0) {
        if (n_in != 15 || in_sizes[0] != MTOK * DM || out_size != MTOK * DM || ws_size < WS_END) { fprintf(stderr, "kernel_launch: unexpected shapes (n_in %d, in0 %d, out %d, ws %zu)\n", n_in, n_in > 0 ? in_sizes[0] : -1, out_size, ws_size); grid = -1; return; }
        int dev = 0, cus = 0, per_cu = 0;
        if (hipGetDevice(&dev) != hipSuccess || hipDeviceGetAttribute(&cus, hipDeviceAttributeMultiprocessorCount, dev) != hipSuccess) { grid = -1; return; }
        if (hipFuncSetAttribute((const void*)mega_fwd, hipFuncAttributeMaxDynamicSharedMemorySize, LDS_BYTES) != hipSuccess) { fprintf(stderr, "kernel_launch: hipFuncSetAttribute failed\n"); grid = -1; return; }
        if (hipOccupancyMaxActiveBlocksPerMultiprocessor(&per_cu, (const void*)mega_fwd, NWAVES * 64, LDS_BYTES) != hipSuccess || per_cu < 1) { fprintf(stderr, "kernel_launch: occupancy query reports %d blocks per CU\n", per_cu); (void)hipGetLastError(); per_cu = 1; }
        grid = cus;
    }
    if (grid < 0) return;
    if (hipMemsetAsync((char*)d_ws + WS_CTL, 0, CTL_ZERO_BYTES, stream) != hipSuccess) { fprintf(stderr, "kernel_launch: memset failed\n"); return; }
    Params a{};
    for (int i = 0; i < 15; ++i) a.in[i] = (const float*)d_in[i];
    a.out = (float*)d_out; a.ws = (unsigned char*)d_ws;
    hipLaunchKernelGGL(mega_fwd, dim3(grid), dim3(NWAVES * 64), LDS_BYTES, stream, a);
    const hipError_t le = hipPeekAtLastError();
    if (le != hipSuccess) fprintf(stderr, "kernel_launch: launch failed: %s\n", hipGetErrorName(le));
}
```

```cpp
#include <hip/hip_runtime.h>
#include <cstdio>
#include <cstdint>
#include <cmath>
namespace pg8 {
#define PG8_LAS __attribute__((address_space(3)))
typedef unsigned short bf16_t;
typedef short bf16x8 __attribute__((ext_vector_type(8)));
typedef float f32x4 __attribute__((ext_vector_type(4)));
typedef unsigned u32x4 __attribute__((ext_vector_type(4)));
constexpr int BM = 256, BK = 64, HALF = 128, HTB = HALF * BK * 2  , STAGE_BYTES = 8 * HTB, NXCD = 8, WGM = 8;

__host__ __device__ __forceinline__ int lds_byte(int r, int c) { const int st = (r >> 4) * 2 + (c >> 5), rr = r & 15, cc = c & 31, ob = rr * 64 + cc * 2; return st * 1024 + (ob ^ (((ob >> 9) & 1) << 5)); }
__host__ __device__ __forceinline__ void stage_rc(int b, int& R, int& C) { const int st = b / 1024, sb = b % 1024, swz = sb ^ (((sb >> 9) & 1) << 5); R = (st >> 1) * 16 + swz / 64; C = (st & 1) * 32 + (swz % 64) / 2; }
__host__ __device__ __forceinline__ int perm32(int rho) { const int n = rho >> 4, i = rho & 15; return 8 * (i >> 2) + 4 * n + (i & 3); }

struct Unit { int pm, pn; };
struct Gemm { const bf16_t* A; const bf16_t* Bt; int M, N, K; };

struct StaticOrder {
    int nM, nN, nwg, G, c;
    __host__ __device__ void init(int M, int N, int G_, int c_) { nM = M / BM; nN = N / BM; nwg = nM * nN; G = G_; c = c_; }
    __host__ __device__ bool next(int i, Unit& u) const {
        const long L = (long)i * G + c; if (L >= nwg) return false;
        int wgid = (int)L; { const int q = nwg / NXCD, r = nwg % NXCD, xcd = wgid % NXCD, off = wgid / NXCD; wgid = (xcd < r ? xcd * (q + 1) : r * (q + 1) + (xcd - r) * q) + off; }
        const int nig = WGM * nN, gid = wgid / nig, fm = gid * WGM, gsz = (nM - fm) < WGM ? (nM - fm) : WGM;
        u.pm = fm + ((wgid % nig) % gsz); u.pn = (wgid % nig) / gsz; return true;
    }
    __device__ __forceinline__ void a_ready(const Unit&) const {}
    __device__ __forceinline__ void done(const Unit&) const {}
};

__device__ __forceinline__ unsigned cvt_pk_bf16(float lo, float hi) { unsigned r; asm volatile("v_cvt_pk_bf16_f32 %0, %1, %2" : "=v"(r) : "v"(lo), "v"(hi)); return r; }
struct EpiProj {
    static constexpr bool PERM = true, AFTER_DRAIN = false;
    bf16_t* O; int ldc; bf16_t* T0; int lo0; bf16_t* T1; int lo1; int nat;
    __device__ __forceinline__ void operator()(const f32x4 (&acc)[2][2][4][2], const Unit& u, int wr, int wc, int fr, int fq) const {
        const int row0 = u.pm * BM + wr * 64 + fr; const int colt = u.pn * BM;
        const int col0 = colt + wc * 32 + 8 * fq;
        bf16_t* T = nullptr; int cc0 = 0;
        if (colt >= lo0 && colt < lo0 + 512) { T = T0; cc0 = colt - lo0; } else if (colt >= lo1 && colt < lo1 + 512) { T = T1; cc0 = colt - lo1; }
        if (T == nullptr || nat) {
#pragma unroll
            for (int ai = 0; ai < 2; ++ai)
#pragma unroll
                for (int m = 0; m < 4; ++m) { bf16_t* rowp = O + (size_t)(row0 + ai * HALF + m * 16) * ldc + col0;
#pragma unroll
                    for (int bj = 0; bj < 2; ++bj) { const f32x4 v0 = acc[ai][bj][m][0], v1 = acc[ai][bj][m][1];
                        u32x4 w; w.x = cvt_pk_bf16(v0[0], v0[1]); w.y = cvt_pk_bf16(v0[2], v0[3]); w.z = cvt_pk_bf16(v1[0], v1[1]); w.w = cvt_pk_bf16(v1[2], v1[3]);
                        *(u32x4*)(rowp + bj * HALF) = w; } }
        }
        if (T != nullptr) {
            const int b = (u.pm * BM) >> 11; const int s0 = ((u.pm * BM) & 2047) + wr * 64 + fr;
            bf16_t* tb = T + ((size_t)(b * 512 + cc0 + wc * 32 + 8 * fq)) * 2048 + s0;
#pragma unroll
            for (int ai = 0; ai < 2; ++ai)
#pragma unroll
                for (int m = 0; m < 4; ++m)
#pragma unroll
                    for (int bj = 0; bj < 2; ++bj)
#pragma unroll
                        for (int n = 0; n < 2; ++n) { const f32x4 v = acc[ai][bj][m][n];
                            const unsigned p01 = cvt_pk_bf16(v[0], v[1]), p23 = cvt_pk_bf16(v[2], v[3]);
                            bf16_t* q = tb + (size_t)(bj * HALF + 4 * n) * 2048 + ai * HALF + m * 16;
                            q[0] = (bf16_t)(p01 & 0xffffu); q[2048] = (bf16_t)(p01 >> 16); q[2 * 2048] = (bf16_t)(p23 & 0xffffu); q[3 * 2048] = (bf16_t)(p23 >> 16); }
        }
    }
};
template <class Epi, class Sched, bool ALIGN_EPI = false, bool SP2 = false>
__device__ __forceinline__ void gemm_phase(PG8_LAS unsigned char* lds, const Gemm g, const Sched& S, const Epi& E) {
    int tid_ = threadIdx.x; asm volatile("" : "+v"(tid_));
    const int tid = tid_, wid = __builtin_amdgcn_readfirstlane(tid >> 6), lane = tid & 63, wr = wid >> 2, wc = wid & 3, fr = lane & 15, fq = lane >> 4;
    const int K = g.K, nt = K / BK;
    unsigned voffA[2], voffB[2];
#pragma unroll
    for (int i = 0; i < 2; ++i) { int R, C; stage_rc(tid * 16 + i * 8192, R, C); const int Rb = Epi::PERM ? ((R & ~31) + perm32(R & 31)) : R;
        voffA[i] = (unsigned)(R * K + C) * 2u; voffB[i] = (unsigned)(Rb * K + C) * 2u; }
    const size_t kstep = (size_t)(BK * 2);
    const size_t hstep = (size_t)HALF * K * 2;
    const size_t tstep = 2 * hstep;
    const unsigned ldsw = (unsigned)wid * 1024u;
    const int aoff = lds_byte(wr * 64 + fr, fq * 8), boff = lds_byte(wc * 32 + fr, fq * 8);
#define PG8_SA(b, h) (((b) * 2 + (h)) * HTB)
#define PG8_SB(b, h) ((4 + (b) * 2 + (h)) * HTB)
#define PG8_STAGE(bufoff, gbase, voff) do { _Pragma("unroll") for (int _i = 0; _i < 2; ++_i) \
        __builtin_amdgcn_global_load_lds((const unsigned*)((const char*)(gbase) + (voff)[_i]), (PG8_LAS unsigned*)(lds + (bufoff) + ldsw + _i * 8192), 16, 0, 0); } while (0)
#define PG8_LDA(dst, b, h) do { _Pragma("unroll") for (int m = 0; m < 4; ++m) _Pragma("unroll") for (int k = 0; k < 2; ++k) dst[m][k] = *(const PG8_LAS bf16x8*)(lds + PG8_SA(b, h) + aoff + m * 2048 + k * 1024); } while (0)
#define PG8_LDB(dst, b, h) do { _Pragma("unroll") for (int n = 0; n < 2; ++n) _Pragma("unroll") for (int k = 0; k < 2; ++k) dst[n][k] = *(const PG8_LAS bf16x8*)(lds + PG8_SB(b, h) + boff + n * 2048 + k * 1024); } while (0)
#define PG8_MMA(ai, bj, At, Bt) do { __builtin_amdgcn_s_setprio(1); _Pragma("unroll") for (int m = 0; m < 4; ++m) _Pragma("unroll") for (int n = 0; n < 2; ++n) _Pragma("unroll") for (int k = 0; k < 2; ++k) \
        acc[ai][bj][m][n] = __builtin_amdgcn_mfma_f32_16x16x32_bf16(Bt[n][k], At[m][k], acc[ai][bj][m][n], 0, 0, 0); __builtin_amdgcn_s_setprio(0); } while (0)
#define PG8_WAIT_V(n) asm volatile("s_waitcnt vmcnt(" #n ")" ::: "memory")
#define PG8_WAIT_L(n) asm volatile("s_waitcnt lgkmcnt(" #n ")" ::: "memory")
#define PG8_BAR __builtin_amdgcn_s_barrier()
#define PG8_SCHED __builtin_amdgcn_sched_barrier(0)
    Unit cur, nxt; int ui = 0;
    if (!S.next(0, cur)) return;
    f32x4 acc[2][2][4][2];
#pragma unroll
    for (int a = 0; a < 2; ++a)
#pragma unroll
        for (int b = 0; b < 2; ++b)
#pragma unroll
            for (int m = 0; m < 4; ++m)
#pragma unroll
                for (int n = 0; n < 2; ++n) acc[a][b][m][n] = (f32x4){0.f, 0.f, 0.f, 0.f};
    bf16x8 At[4][2], B0[2][2], B1[2][2];
    const char* cA = (const char*)g.A + (size_t)cur.pm * tstep; const char* cB = (const char*)g.Bt + (size_t)cur.pn * tstep;
    S.a_ready(cur);
    if constexpr (SP2) {
        PG8_STAGE(PG8_SB(0, 0), cB, voffB); PG8_STAGE(PG8_SB(0, 1), cB + hstep, voffB); PG8_STAGE(PG8_SA(0, 0), cA, voffA); PG8_STAGE(PG8_SA(0, 1), cA + hstep, voffA);
        if (wr == 1) PG8_BAR;
        PG8_WAIT_V(2); PG8_BAR;
        PG8_STAGE(PG8_SB(1, 0), cB + kstep, voffB); PG8_STAGE(PG8_SA(1, 0), cA + kstep, voffA); PG8_STAGE(PG8_SB(1, 1), cB + hstep + kstep, voffB);
        PG8_WAIT_V(6); PG8_BAR;
    } else {
        PG8_STAGE(PG8_SB(0, 0), cB, voffB); PG8_STAGE(PG8_SA(0, 0), cA, voffA); PG8_STAGE(PG8_SB(0, 1), cB + hstep, voffB); PG8_STAGE(PG8_SA(0, 1), cA + hstep, voffA);
        if (wr == 1) PG8_BAR;
        PG8_WAIT_V(4); PG8_BAR;
        PG8_STAGE(PG8_SB(1, 0), cB + kstep, voffB); PG8_STAGE(PG8_SA(1, 0), cA + kstep, voffA); PG8_STAGE(PG8_SB(1, 1), cB + hstep + kstep, voffB);
        PG8_WAIT_V(6); PG8_BAR;
    }
    for (;;) {
        const bool has_next = S.next(ui + 1, nxt);
        const char* nA = has_next ? (const char*)g.A + (size_t)nxt.pm * tstep : cA; const char* nB = has_next ? (const char*)g.Bt + (size_t)nxt.pn * tstep : cB;
        for (int t = 0; t < nt; t += 2) {
            const bool last = (t == nt - 2);
            const char* a1 = cA + (size_t)(t + 1) * kstep;
            const char* a2 = last ? nA : cA + (size_t)(t + 2) * kstep; const char* b2 = last ? nB : cB + (size_t)(t + 2) * kstep;
            const char* a3 = a2 + kstep; const char* b3 = b2 + kstep;
            if (last && has_next) S.a_ready(nxt);
            if constexpr (SP2) {
            PG8_LDB(B0, 0, 0); PG8_LDB(B1, 0, 1); PG8_SCHED; PG8_LDA(At, 0, 0); PG8_STAGE(PG8_SA(1, 1), a1 + hstep, voffA);
            PG8_WAIT_V(8); PG8_WAIT_L(0); PG8_BAR; PG8_MMA(0, 0, At, B0); PG8_MMA(0, 1, At, B1); PG8_BAR; PG8_SCHED;
            PG8_LDA(At, 0, 1); PG8_STAGE(PG8_SB(0, 0), b2, voffB); PG8_STAGE(PG8_SB(0, 1), b2 + hstep, voffB); PG8_STAGE(PG8_SA(0, 0), a2, voffA);
            PG8_WAIT_V(8); PG8_WAIT_L(0); PG8_BAR; PG8_MMA(1, 0, At, B0); PG8_MMA(1, 1, At, B1); PG8_BAR; PG8_SCHED;
            PG8_LDB(B0, 1, 0); PG8_LDB(B1, 1, 1); PG8_SCHED; PG8_LDA(At, 1, 0); PG8_STAGE(PG8_SA(0, 1), a2 + hstep, voffA);
            PG8_WAIT_V(8); PG8_WAIT_L(0); PG8_BAR; PG8_MMA(0, 0, At, B0); PG8_MMA(0, 1, At, B1); PG8_BAR; PG8_SCHED;
            PG8_LDA(At, 1, 1); PG8_STAGE(PG8_SB(1, 0), b3, voffB); PG8_STAGE(PG8_SB(1, 1), b3 + hstep, voffB); PG8_STAGE(PG8_SA(1, 0), a3, voffA);
            PG8_WAIT_V(8); PG8_WAIT_L(0); PG8_BAR; PG8_MMA(1, 0, At, B0); PG8_MMA(1, 1, At, B1); PG8_BAR; PG8_SCHED;
            } else {
            PG8_LDB(B0, 0, 0); PG8_SCHED; PG8_LDA(At, 0, 0); PG8_STAGE(PG8_SA(1, 1), a1 + hstep, voffA);
            PG8_WAIT_L(8); PG8_BAR; PG8_WAIT_L(0); PG8_MMA(0, 0, At, B0); PG8_BAR; PG8_SCHED;
            PG8_LDB(B1, 0, 1); PG8_STAGE(PG8_SB(0, 0), b2, voffB);
            PG8_BAR; PG8_WAIT_L(0); PG8_MMA(0, 1, At, B1); PG8_BAR;
            PG8_LDA(At, 0, 1); PG8_STAGE(PG8_SA(0, 0), a2, voffA);
            PG8_BAR; PG8_WAIT_L(0); PG8_MMA(1, 0, At, B0); PG8_BAR; PG8_SCHED;
            PG8_STAGE(PG8_SB(0, 1), b2 + hstep, voffB);
            PG8_WAIT_V(6); PG8_BAR; PG8_MMA(1, 1, At, B1); PG8_BAR;
            PG8_LDB(B0, 1, 0); PG8_SCHED; PG8_LDA(At, 1, 0); PG8_STAGE(PG8_SA(0, 1), a2 + hstep, voffA);
            PG8_WAIT_L(8); PG8_BAR; PG8_WAIT_L(0); PG8_MMA(0, 0, At, B0); PG8_BAR; PG8_SCHED;
            PG8_LDB(B1, 1, 1); PG8_STAGE(PG8_SB(1, 0), b3, voffB);
            PG8_BAR; PG8_WAIT_L(0); PG8_MMA(0, 1, At, B1); PG8_BAR;
            PG8_LDA(At, 1, 1); PG8_STAGE(PG8_SA(1, 0), a3, voffA);
            PG8_BAR; PG8_WAIT_L(0); PG8_MMA(1, 0, At, B0); PG8_BAR; PG8_SCHED;
            PG8_STAGE(PG8_SB(1, 1), b3 + hstep, voffB);
            PG8_WAIT_V(6); PG8_BAR; PG8_MMA(1, 1, At, B1); PG8_BAR;
            }
        }
        if constexpr (ALIGN_EPI) { if (wr == 0) PG8_BAR; }
        if constexpr (!Epi::AFTER_DRAIN) { E(acc, cur, wr, wc, fr, fq); S.done(cur); }
        if (!has_next) break;
#pragma unroll
        for (int a = 0; a < 2; ++a)
#pragma unroll
            for (int b = 0; b < 2; ++b)
#pragma unroll
                for (int m = 0; m < 4; ++m)
#pragma unroll
                    for (int n = 0; n < 2; ++n) acc[a][b][m][n] = (f32x4){0.f, 0.f, 0.f, 0.f};
        cur = nxt; cA = nA; cB = nB; ++ui;
        if constexpr (ALIGN_EPI) { if (wr == 1) PG8_BAR; }
    }
    PG8_WAIT_V(0);
    if constexpr (!ALIGN_EPI) { if (wr == 0) PG8_BAR; }
    PG8_BAR;
    if constexpr (Epi::AFTER_DRAIN) { E.fused(acc, cur, wr, wc, fr, fq, lds, wid, lane); S.done(cur); }
#undef PG8_SA
#undef PG8_SB
#undef PG8_STAGE
#undef PG8_LDA
#undef PG8_LDB
#undef PG8_MMA
#undef PG8_WAIT_V
#undef PG8_WAIT_L
#undef PG8_BAR
#undef PG8_SCHED
}
}
#define GAS __attribute__((address_space(1)))
#define LAS __attribute__((address_space(3)))
typedef unsigned short bf16;
typedef unsigned v4u __attribute__((ext_vector_type(4)));
typedef float f32x4 __attribute__((ext_vector_type(4)));
typedef short bf16x8 __attribute__((ext_vector_type(8)));
typedef GAS unsigned gu32;
typedef GAS unsigned long long gu64;
#define RLX_AGENT __ATOMIC_RELAXED, __HIP_MEMORY_SCOPE_AGENT
#define LDS_WAIT() asm volatile("s_waitcnt lgkmcnt(0)" ::: "memory")
#define VM_WAIT() asm volatile("s_waitcnt vmcnt(0)" ::: "memory")
__device__ __forceinline__ unsigned long long rt() { return __builtin_amdgcn_s_memrealtime(); }
__device__ __forceinline__ unsigned f2bf(float f) { unsigned u = __builtin_bit_cast(unsigned, f); return (u + 0x7fffu + ((u >> 16) & 1u)) >> 16; }
__device__ __forceinline__ unsigned pk2(float lo, float hi) { return f2bf(lo) | (f2bf(hi) << 16); }

#define XB_TMO      128
#define XB_XCNT(j)  (256  + 64 * (j))
#define XB_XSUB(j)  (1280 + 64 * (j))
#define XB_XGEN(j)  (2304 + 64 * (j))
#define XB_TOP      3328
#define XB_TOPGEN   3392
#define XCD_BAR_WORDS 3456
#define XB_SPIN_CAP (1u << 22)

__device__ __forceinline__ unsigned xb_ld(unsigned* p)              { return __hip_atomic_load(p, __ATOMIC_RELAXED, __HIP_MEMORY_SCOPE_AGENT); }
__device__ __forceinline__ unsigned xb_add(unsigned* p, unsigned v) { return __hip_atomic_fetch_add(p, v, __ATOMIC_RELAXED, __HIP_MEMORY_SCOPE_AGENT); }
__device__ __forceinline__ unsigned xb_xcc_id() { return (unsigned)__builtin_amdgcn_s_getreg((3 << 11) | 20) & 0xFu; }
#define XB_SPIN(cond, bar) do { unsigned _sp = 0; while (cond) { __builtin_amdgcn_s_sleep(1); \
    if ((++_sp & 255u) == 0u) { if (xb_ld(&(bar)[XB_TMO])) break; if (_sp > XB_SPIN_CAP) { atomicAdd(&(bar)[XB_TMO], 1u); break; } } } } while (0)

struct XcdBarrier {
    unsigned* bar; unsigned x;
    volatile LAS unsigned* st;
};

__device__ __forceinline__ XcdBarrier xcd_barrier_post(unsigned* bar, volatile LAS unsigned* st) {
    XcdBarrier b; b.bar = bar; b.x = xb_xcc_id(); b.st = st;
    if (threadIdx.x == 0) (void)xb_add(&bar[XB_XCNT(b.x)], 1u);
    return b;
}
__device__ __forceinline__ void xcd_barrier_complete(unsigned* bar, unsigned x, unsigned& nloc, unsigned& nx) {
    const unsigned G = gridDim.x * gridDim.y * gridDim.z;
    unsigned sum, cnt, mine, sp = 0u;
    for (;;) {
        sum = 0u; cnt = 0u; mine = 0u;
#pragma unroll
        for (unsigned j = 0; j < 16; ++j) { const unsigned c = xb_ld(&bar[XB_XCNT(j)]); sum += c; cnt += (c > 0u) ? 1u : 0u; mine = (j == x) ? c : mine; }
        if (sum == G) break;
        __builtin_amdgcn_s_sleep(1);
        if ((++sp & 255u) == 0u) { if (xb_ld(&bar[XB_TMO])) break; if (sp > XB_SPIN_CAP) { atomicAdd(&bar[XB_TMO], 1u); break; } }
    }
    nloc = mine > 0u ? mine : 1u; nx = cnt > 0u ? cnt : 1u;
}

__device__ __forceinline__ void xcd_barrier(const XcdBarrier& b) {
    asm volatile("s_waitcnt vmcnt(0)" ::: "memory");
    __syncthreads();
    if (threadIdx.x == 0) {
        unsigned* bar = b.bar;
        __builtin_amdgcn_s_waitcnt(0);
        unsigned nloc = b.st[0], nx = b.st[1];
        if (nloc == 0u) { xcd_barrier_complete(bar, b.x, nloc, nx); b.st[0] = nloc; b.st[1] = nx; }
        const unsigned old = xb_add(&bar[XB_XSUB(b.x)], 1u);
        const unsigned gen = old / nloc;
        if (old + 1u == (gen + 1u) * nloc) {
            __builtin_amdgcn_fence(__ATOMIC_RELEASE, "agent");
            asm volatile("s_waitcnt vmcnt(0)" ::: "memory");
            const unsigned og = xb_add(&bar[XB_TOP], 1u);
            const unsigned tg = og / nx;
            if (og + 1u == (tg + 1u) * nx) xb_add(&bar[XB_TOPGEN], 1u);
            else XB_SPIN(xb_ld(&bar[XB_TOPGEN]) == tg, bar);
            __builtin_amdgcn_fence(__ATOMIC_ACQUIRE, "agent");
            xb_add(&bar[XB_XGEN(b.x)], 1u);
            asm volatile("s_waitcnt vmcnt(0)" ::: "memory");
        } else {
            XB_SPIN(xb_ld(&bar[XB_XGEN(b.x)]) == gen, bar);
            __builtin_amdgcn_fence(__ATOMIC_ACQUIRE, "agent");
            asm volatile("s_waitcnt vmcnt(0)" ::: "memory");
        }
    }
    __syncthreads();
}
constexpr int NWAVES = 8;
constexpr int BATCH = 16, SEQ = 2048, DM = 1024, MTOK = BATCH * SEQ;
constexpr int EVEN_IN = 3584, ODD_IN = 3072;
constexpr int E_RQ = 0, E_RK = 256, E_RV = 512, E_RG = 1024, E_SQ = 1536, E_SK = 2048, E_SV = 2560, E_SG = 3072;
constexpr int O_HQ = 0, O_HF = 512, O_HI = 1024, O_HG = 1536, O_LX = 2048, O_LG = 2560;
constexpr float EPS = 1e-6f;
constexpr size_t MiB = 1u << 20;
constexpr size_t WS_CTL = 0, CTL_ZERO_BYTES = 1 * MiB;
constexpr size_t WS_WIN0 = 2 * MiB, WS_WIN1 = 9 * MiB, WS_WIN2 = 15 * MiB, WS_WIN3 = 22 * MiB;
constexpr size_t WS_WOUT = 28 * MiB;
constexpr size_t WS_TAB = 36 * MiB;
constexpr size_t WS_LB = 36 * MiB + 768 * 1024;
constexpr size_t WS_XN = 40 * MiB;
constexpr size_t WS_MIX = 104 * MiB;
constexpr size_t WS_PROJ = 168 * MiB;
constexpr size_t WS_VT0 = 392 * MiB, WS_VT1 = 424 * MiB;
constexpr size_t WS_KST = 456 * MiB;
constexpr size_t WS_END = 488 * MiB;
constexpr int CW_BAR = 4096;
constexpr int RING_BYTES = 131072;
constexpr int LDS_BYTES = 147456;
constexpr int LDSCTL_OFF = LDS_BYTES - 512;
constexpr int XTRA_OFF = RING_BYTES;
__device__ __forceinline__ float bf2f(bf16 u) { return __uint_as_float((unsigned)u << 16); }
__device__ __forceinline__ float wave_sum(float v) {
#pragma unroll
    for (int o = 1; o < 64; o <<= 1) v += __shfl_xor(v, o);
    return v;
}
__device__ __forceinline__ float sigmoidf_(float x) { return 1.f / (1.f + __expf(-x)); }
__device__ __forceinline__ float siluf_(float x) { return x / (1.f + __expf(-x)); }
__device__ __forceinline__ float log_sigmoidf_(float z) { return fminf(z, 0.f) - log1pf(__expf(-fabsf(z))); }

struct Ctx {
    LAS unsigned char* lds;
    int tid, lane, wave, vcu, G;
    GAS unsigned char* ws;
};
struct Params { const float* in[15]; float* out; unsigned char* ws; };
__device__ __forceinline__ const float* IN(int i) { return (const float*)(const GAS float*)(((const __attribute__((address_space(4))) Params*)__builtin_amdgcn_kernarg_segment_ptr())->in[i]); }
__device__ __forceinline__ float* OUTP() { return (float*)(GAS float*)(((const __attribute__((address_space(4))) Params*)__builtin_amdgcn_kernarg_segment_ptr())->out); }
#define C_XN   ((bf16*)(C.ws + WS_XN))
#define C_MIX  ((bf16*)(C.ws + WS_MIX))
#define C_OI   ((bf16*)(C.ws + WS_XN + 32 * MiB))
#define C_PROJ ((bf16*)(C.ws + WS_PROJ))
#define C_VT0  ((bf16*)(C.ws + WS_VT0))
#define C_VT1  ((bf16*)(C.ws + WS_VT1))
#define C_KST  ((bf16*)(C.ws + WS_KST))
#define C_TABC ((const float*)(C.ws + WS_TAB))
#define C_TABS ((const float*)(C.ws + WS_TAB) + SEQ * 32)
#define C_LB   ((const float*)(C.ws + WS_LB))

__device__ __forceinline__ void p0_transpose_item(const float* W, int K, int N, bf16* WT, LAS float* scr, int item, int lane) {
    const int nblk = N / 32, kb = item / nblk, nb = item % nblk, k0 = 64 * kb, n0 = 32 * nb;
#pragma unroll 8
    for (int i = 0; i < 32; ++i) { const int kk = 2 * i + (lane >> 5); scr[kk * 33 + (lane & 31)] = W[(size_t)(k0 + kk) * N + n0 + (lane & 31)]; }
    LDS_WAIT(); asm volatile("" ::: "memory");
    const int c = lane & 7;
#pragma unroll
    for (int j = 0; j < 4; ++j) { const int n = (lane >> 3) + 8 * j; const LAS float* s = scr + (8 * c) * 33 + n;
        v4u o; o.x = pk2(s[0 * 33], s[1 * 33]); o.y = pk2(s[2 * 33], s[3 * 33]); o.z = pk2(s[4 * 33], s[5 * 33]); o.w = pk2(s[6 * 33], s[7 * 33]);
        *(GAS v4u*)(WT + (size_t)(n0 + n) * K + k0 + 8 * c) = o; }
    LDS_WAIT(); asm volatile("" ::: "memory");
}
__device__ __forceinline__ void rms_row_to_bf16(const float* xrow, const float* w, bf16* orow, int lane) {
    const GAS f32x4* xr = (const GAS f32x4*)xrow + lane; const GAS f32x4* wr = (const GAS f32x4*)w + lane;
    f32x4 v[4]; float s = 0.f;
#pragma unroll
    for (int j = 0; j < 4; ++j) { v[j] = xr[64 * j]; s += (v[j].x * v[j].x + v[j].y * v[j].y) + (v[j].z * v[j].z + v[j].w * v[j].w); }
    const float rstd = rsqrtf(wave_sum(s) * (1.f / DM) + EPS);
    GAS unsigned long long* o8 = (GAS unsigned long long*)orow + lane;
#pragma unroll
    for (int j = 0; j < 4; ++j) { const f32x4 g = wr[64 * j];
        o8[64 * j] = (unsigned long long)pk2(v[j].x * rstd * g.x, v[j].y * rstd * g.y) | ((unsigned long long)pk2(v[j].z * rstd * g.z, v[j].w * rstd * g.w) << 32); }
}
__device__ __forceinline__ void p0_prologue(Ctx& C) {
    LAS float* scr = (LAS float*)(C.lds + C.wave * 16384);
    const int gw = C.vcu * NWAVES + C.wave, NGW = C.G * NWAVES;
    constexpr int I_E = (DM / 64) * (EVEN_IN / 32), I_O = (DM / 64) * (ODD_IN / 32), I_W = (DM / 64) * (DM / 32);
    constexpr int NITEMS = 2 * I_E + 2 * I_O + 4 * I_W;
    for (int it = gw; it < NITEMS; it += NGW) {
        int r = it;
        if (r < 2 * I_E) { const int e = r / I_E; p0_transpose_item(IN(3) + (size_t)e * DM * EVEN_IN, DM, EVEN_IN, (bf16*)(C.ws + (e ? WS_WIN2 : WS_WIN0)), scr, r % I_E, C.lane); continue; } r -= 2 * I_E;
        if (r < 2 * I_O) { const int o = r / I_O; p0_transpose_item(IN(5) + (size_t)o * DM * ODD_IN, DM, ODD_IN, (bf16*)(C.ws + (o ? WS_WIN3 : WS_WIN1)), scr, r % I_O, C.lane); continue; } r -= 2 * I_O;
        { const int l = r / I_W; const float* src = (l & 1) ? IN(6) + (size_t)(l >> 1) * DM * DM : IN(4) + (size_t)(l >> 1) * DM * DM;
          p0_transpose_item(src, DM, DM, (bf16*)(C.ws + WS_WOUT + (size_t)l * 2 * MiB), scr, r % I_W, C.lane); }
    }
    for (int m = gw; m < MTOK; m += NGW) rms_row_to_bf16(IN(0) + (size_t)m * DM, IN(1), C_XN + (size_t)m * DM, C.lane);
    float* tc = (float*)(C.ws + WS_TAB); float* ts = tc + SEQ * 32;
    for (int e = C.vcu * 512 + C.tid; e < SEQ * 32; e += C.G * 512) {
        const int t = e >> 5, i = e & 31;
        const float inv = powf(10000.0f, -(float)i / 32.0f);
        const float ang = (float)t * inv;
        double r = (double)ang * 0.15915494309189533577; r -= floor(r);
        const float rev = (float)r;
        tc[e] = __builtin_amdgcn_cosf(rev); ts[e] = __builtin_amdgcn_sinf(rev);
    }
    float* lbp = (float*)(C.ws + WS_LB);
    if (C.vcu == 0) for (int c = C.tid; c < 512; c += 512) { const float l0 = IN(7)[c], l1 = IN(7)[512 + c]; lbp[c] = 0.f; lbp[512 + c] = 1.f / (1.f + expf(l0 - l1)); }
}

__device__ __forceinline__ void norm_rows_phase(Ctx& C, const bf16* Y, const float* xsrc, const float* wpost, const float* wpre_next) {
    const int gw = C.vcu * NWAVES + C.wave, NGW = C.G * NWAVES;
    for (int m = gw; m < MTOK; m += NGW) {
        const GAS unsigned long long* yr = (const GAS unsigned long long*)(Y + (size_t)m * DM) + C.lane;
        const GAS f32x4* xr = (const GAS f32x4*)(xsrc + (size_t)m * DM) + C.lane;
        GAS f32x4* xo = (GAS f32x4*)(OUTP() + (size_t)m * DM) + C.lane;
        f32x4 y[4], x[4]; float s = 0.f;
#pragma unroll
        for (int j = 0; j < 4; ++j) { const unsigned long long w = yr[64 * j]; x[j] = xr[64 * j];
            y[j].x = __uint_as_float(((unsigned)w) << 16); y[j].y = __uint_as_float(((unsigned)w) & 0xffff0000u);
            y[j].z = __uint_as_float(((unsigned)(w >> 32)) << 16); y[j].w = __uint_as_float(((unsigned)(w >> 32)) & 0xffff0000u);
            s += (y[j].x * y[j].x + y[j].y * y[j].y) + (y[j].z * y[j].z + y[j].w * y[j].w); }
        const float rstd = rsqrtf(wave_sum(s) * (1.f / DM) + EPS); float s2 = 0.f;
#pragma unroll
        for (int j = 0; j < 4; ++j) { const f32x4 g = ((const GAS f32x4*)wpost + C.lane)[64 * j];
            x[j].x += y[j].x * rstd * g.x; x[j].y += y[j].y * rstd * g.y; x[j].z += y[j].z * rstd * g.z; x[j].w += y[j].w * rstd * g.w;
            xo[64 * j] = x[j];
            s2 += (x[j].x * x[j].x + x[j].y * x[j].y) + (x[j].z * x[j].z + x[j].w * x[j].w); }
        if (wpre_next) {
            const float r2 = rsqrtf(wave_sum(s2) * (1.f / DM) + EPS);
            GAS unsigned long long* o8 = (GAS unsigned long long*)(C_XN + (size_t)m * DM) + C.lane;
#pragma unroll
            for (int j = 0; j < 4; ++j) { const f32x4 g = ((const GAS f32x4*)wpre_next + C.lane)[64 * j];
                o8[64 * j] = (unsigned long long)pk2(x[j].x * r2 * g.x, x[j].y * r2 * g.y) | ((unsigned long long)pk2(x[j].z * r2 * g.z, x[j].w * r2 * g.w) << 32); }
        }
    }
}

__device__ __forceinline__ void unpack8(const v4u w, float* f) {
    f[0] = __uint_as_float(w.x << 16); f[1] = __uint_as_float(w.x & 0xffff0000u); f[2] = __uint_as_float(w.y << 16); f[3] = __uint_as_float(w.y & 0xffff0000u);
    f[4] = __uint_as_float(w.z << 16); f[5] = __uint_as_float(w.z & 0xffff0000u); f[6] = __uint_as_float(w.w << 16); f[7] = __uint_as_float(w.w & 0xffff0000u);
}
__device__ __forceinline__ void naive_ret_token(Ctx& C, int b, int h, int t) {
    const int lane = C.lane; const size_t rs = EVEN_IN;
    const bf16* P = C_PROJ; const size_t m = (size_t)b * SEQ + t;
    float qa[32], qb[32];
    {
        float q[64];
#pragma unroll
        for (int c = 0; c < 8; ++c) unpack8(*(const GAS v4u*)(P + m * rs + E_RQ + h * 64 + 8 * c), q + 8 * c);
#pragma unroll
        for (int i = 0; i < 32; ++i) { const float cs = C_TABC[t * 32 + i], sn = C_TABS[t * 32 + i]; qa[i] = q[i] * cs - q[32 + i] * sn; qb[i] = q[i] * sn + q[32 + i] * cs; }
    }
    const float lg2 = log2f(1.0f - exp2f(-5.0f - (float)h));
    float o0 = 0.f, o1 = 0.f;
    for (int shi = t; shi >= 0; shi -= 64) {
        const int s = shi - lane; const bool valid = s >= 0; const int sc = valid ? s : 0;
        const size_t ms = (size_t)b * SEQ + sc;
        float k[64];
#pragma unroll
        for (int c = 0; c < 8; ++c) unpack8(*(const GAS v4u*)(P + ms * rs + E_RK + h * 64 + 8 * c), k + 8 * c);
        float acc = 0.f;
#pragma unroll
        for (int i = 0; i < 32; ++i) { const float cs = C_TABC[sc * 32 + i], sn = C_TABS[sc * 32 + i];
            acc += qa[i] * (k[i] * cs - k[32 + i] * sn) + qb[i] * (k[i] * sn + k[32 + i] * cs); }
        const float w = valid ? acc * 0.125f * exp2f((float)(t - s) * lg2) : 0.f;
#pragma unroll 8
        for (int j = 0; j < 64; ++j) { const float wj = __shfl(w, j); const int sj = shi - j; const size_t mj = (size_t)b * SEQ + (sj >= 0 ? sj : 0);
            o0 += wj * bf2f(P[mj * rs + E_RV + h * 128 + lane]); o1 += wj * bf2f(P[mj * rs + E_RV + h * 128 + 64 + lane]); }
    }
    const float rstd = rsqrtf(wave_sum(o0 * o0 + o1 * o1) * (1.f / 128.f) + EPS);
    const float g0 = bf2f(P[m * rs + E_RG + h * 128 + lane]), g1 = bf2f(P[m * rs + E_RG + h * 128 + 64 + lane]);
    C_MIX[m * DM + h * 128 + lane] = (bf16)f2bf(o0 * rstd * siluf_(g0)); C_MIX[m * DM + h * 128 + 64 + lane] = (bf16)f2bf(o1 * rstd * siluf_(g1));
}
template <bool EARLY> __device__ __forceinline__ void naive_sb_token(Ctx& C, int b, int hh, int t) {
    const int lane = C.lane; const size_t rs = EVEN_IN; const bf16* P = C_PROJ; const size_t m = (size_t)b * SEQ + t;
    float q[64];
#pragma unroll
    for (int c = 0; c < 8; ++c) unpack8(*(const GAS v4u*)(P + m * rs + E_SQ + hh * 64 + 8 * c), q + 8 * c);
    float R = 0.f, o = 0.f;
    for (int shi = t - 1; shi >= 0; shi -= 64) {
        const int s = shi - lane; const bool valid = s >= 0; const size_t ms = (size_t)b * SEQ + (valid ? s : 0);
        float acc = 0.f;
#pragma unroll
        for (int c = 0; c < 8; ++c) { float k[8]; unpack8(*(const GAS v4u*)(P + ms * rs + E_SK + hh * 64 + 8 * c), k);
#pragma unroll
            for (int j = 0; j < 8; ++j) acc += q[8 * c + j] * k[j]; }
        const float z = acc * 0.125f, lb = log_sigmoidf_(z), lom = valid ? lb - z : 0.f;
        float incl = lom;
#pragma unroll
        for (int off = 1; off < 64; off <<= 1) { const float tmp = __shfl_up(incl, off); if (lane >= off) incl += tmp; }
        const float w = valid ? __expf(lb + R + (incl - lom)) : 0.f;
        R += __shfl(incl, 63);
#pragma unroll 8
        for (int j = 0; j < 64; ++j) { const float wj = __shfl(w, j); const int sj = shi - j; const size_t mj = (size_t)b * SEQ + (sj >= 0 ? sj : 0);
            o += wj * bf2f(P[mj * rs + E_SV + hh * 64 + lane]); }
        if (EARLY && R < -100.f) break;
    }
    const float g = bf2f(P[m * rs + E_SG + hh * 64 + lane]);
    C_MIX[m * DM + 512 + hh * 64 + lane] = (bf16)f2bf(o * siluf_(g));
}
__device__ __forceinline__ void naive_even_mixer(Ctx& C) {
    constexpr int NRET = BATCH * 4 * 256, NSB = BATCH * 8 * 256;
    for (int u = C.vcu; u < NRET + NSB; u += C.G) {
        if (u < NRET) { const int bh = u >> 8, tb = (u + bh) & 255; naive_ret_token(C, bh >> 2, bh & 3, tb * 8 + C.wave); }
        else { const int v = u - NRET, bh = v >> 8, tb = (v + bh) & 255; naive_sb_token<false>(C, bh >> 3, bh & 7, tb * 8 + C.wave); }
    }
}
__device__ __forceinline__ void naive_hgrn_unit(Ctx& C, int b, int h, int vs, int o, float* OS) {
    const int tid = C.tid, lane = C.lane, k = tid >> 2, vq = tid & 3; const size_t rs = ODD_IN; const bf16* P = C_PROJ;
    LAS float* red = (LAS float*)C.lds;
    const float lb = C_LB[o * 512 + h * 128 + k];
    float st[8];
#pragma unroll
    for (int j = 0; j < 8; ++j) st[j] = 0.f;
    for (int t0 = 0; t0 < SEQ; t0 += 4) {
        float flv[4], qv[4]; v4u vvv[4];
#pragma unroll
        for (int u = 0; u < 4; ++u) { const size_t m = (size_t)b * SEQ + t0 + u; flv[u] = bf2f(P[m * rs + O_HF + h * 128 + k]); qv[u] = bf2f(P[m * rs + O_HQ + h * 128 + k]);
            vvv[u] = *(const GAS v4u*)(P + m * rs + O_HI + h * 128 + vs * 32 + vq * 8); }
#pragma unroll
        for (int u = 0; u < 4; ++u) {
            const int t = t0 + u; const size_t m = (size_t)b * SEQ + t;
            const float fl = flv[u], q = qv[u];
            const float sig = 1.f / (1.f + __expf(-fl)), f = lb + (1.f - lb) * sig, kk = (1.f - lb) / (1.f + __expf(fl));
            float v[8]; unpack8(vvv[u], v);
            float part[8];
#pragma unroll
            for (int j = 0; j < 8; ++j) { st[j] = f * st[j] + kk * v[j]; part[j] = q * st[j]; }
#pragma unroll
            for (int j = 0; j < 8; ++j) { part[j] += __shfl_xor(part[j], 4); part[j] += __shfl_xor(part[j], 8); part[j] += __shfl_xor(part[j], 16); part[j] += __shfl_xor(part[j], 32); }
            LAS float* rb = red + (t & 1) * 256;
            if (lane < 4) {
#pragma unroll
                for (int j = 0; j < 8; ++j) rb[C.wave * 32 + vq * 8 + j] = part[j];
            }
            __syncthreads();
            if (tid < 32) { float s = 0.f;
#pragma unroll
                for (int w = 0; w < 8; ++w) s += rb[w * 32 + tid];
                OS[m * 512 + h * 128 + vs * 32 + tid] = s; }
        }
    }
    __syncthreads();
}
__device__ __forceinline__ void naive_lru_unit(Ctx& C, int b, int n, int o) {
    const int lane = C.lane, wave = C.wave; const size_t rs = ODD_IN; const bf16* P = C_PROJ;
    LAS float* AU = (LAS float*)C.lds;
    LAS float* xb = (LAS float*)(C.lds + XTRA_OFF) + wave * 64;
    const int ch = n * 64 + lane;
    const float* cw = IN(8) + (size_t)o * 4 * 512; const float cb = IN(9)[o * 512 + ch];
    const float w0 = cw[0 * 512 + ch], w1 = cw[1 * 512 + ch], w2 = cw[2 * 512 + ch], w3 = cw[3 * 512 + ch];
    const float* Wa = IN(10) + ((size_t)o * 8 + n) * 4096; const float* Wx = IN(12) + ((size_t)o * 8 + n) * 4096;
    const float ba = IN(11)[o * 512 + ch], bx = IN(13)[o * 512 + ch], lam = IN(14)[o * 512 + ch];
    const float sp = log1pf(expf(-lam));
    float hst = 0.f;
    for (int c = 0; c < 8; ++c) {
        for (int tt = wave * 32; tt < wave * 32 + 32; ++tt) {
            const int t = c * 256 + tt; const size_t m = (size_t)b * SEQ + t;
            float xc = cb + w3 * bf2f(P[m * rs + O_LX + ch]);
            if (t >= 1) xc += w2 * bf2f(P[(m - 1) * rs + O_LX + ch]);
            if (t >= 2) xc += w1 * bf2f(P[(m - 2) * rs + O_LX + ch]);
            if (t >= 3) xc += w0 * bf2f(P[(m - 3) * rs + O_LX + ch]);
            xb[lane] = xc; LDS_WAIT(); asm volatile("" ::: "memory");
            float ra = ba, rx = bx;
            for (int i = 0; i < 64; ++i) { const float xi = xb[i]; ra += xi * Wa[i * 64 + lane]; rx += xi * Wx[i * 64 + lane]; }
            LDS_WAIT(); asm volatile("" ::: "memory");
            const float r = sigmoidf_(ra), ig = sigmoidf_(rx);
            const float la = -8.0f * r * sp, a = __expf(la);
            const float mult = (t == 0) ? 1.0f : sqrtf(-expm1f(2.0f * la));
            AU[(tt * 64 + lane) * 2] = a; AU[(tt * 64 + lane) * 2 + 1] = mult * ig * xc;
        }
        __syncthreads();
        if (wave == 0) {
            for (int tt = 0; tt < 256; ++tt) { const size_t m = (size_t)b * SEQ + c * 256 + tt;
                hst = AU[(tt * 64 + lane) * 2] * hst + AU[(tt * 64 + lane) * 2 + 1];
                const float g = bf2f(P[m * rs + O_LG + ch]);
                C_MIX[m * DM + 512 + ch] = (bf16)f2bf(hst * siluf_(g)); }
        }
        __syncthreads();
    }
}
__device__ __forceinline__ void naive_odd_mixer1(Ctx& C, int o) {
    float* OS = (float*)(C.ws + WS_XN);
    for (int u = C.vcu; u < 256 + 128; u += C.G) {
        if (u < 256) naive_hgrn_unit(C, u >> 4, (u >> 2) & 3, u & 3, o, OS);
        else naive_lru_unit(C, (u - 256) >> 3, (u - 256) & 7, o);
    }
}
__device__ __forceinline__ void naive_odd_mixer2(Ctx& C) {
    const float* OS = (const float*)(C.ws + WS_XN); const bf16* P = C_PROJ; const size_t rs = ODD_IN;
    const int gw = C.vcu * NWAVES + C.wave, NGW = C.G * NWAVES;
    for (int it = gw; it < MTOK * 4; it += NGW) { const size_t m = it >> 2; const int h = it & 3;
        const float o0 = OS[m * 512 + h * 128 + C.lane], o1 = OS[m * 512 + h * 128 + 64 + C.lane];
        const float rstd = rsqrtf(wave_sum(o0 * o0 + o1 * o1) * (1.f / 128.f) + EPS);
        const float g0 = bf2f(P[m * rs + O_HG + h * 128 + C.lane]), g1 = bf2f(P[m * rs + O_HG + h * 128 + 64 + C.lane]);
        C_MIX[m * DM + h * 128 + C.lane] = (bf16)f2bf(o0 * rstd * siluf_(g0)); C_MIX[m * DM + h * 128 + 64 + C.lane] = (bf16)f2bf(o1 * rstd * siluf_(g1)); }
}
#ifndef REP_RET
#define REP_RET 1
#endif
#ifndef REP_HG1
#define REP_HG1 1
#endif
#ifndef REP_HG2
#define REP_HG2 1
#endif
#ifndef REP_LRU
#define REP_LRU 1
#endif
typedef float f32x16 __attribute__((ext_vector_type(16)));
typedef short s16x4 __attribute__((ext_vector_type(4)));
typedef __bf16 bf16x2_t __attribute__((ext_vector_type(2)));
typedef float f32x2_t __attribute__((ext_vector_type(2)));
typedef unsigned u32x2 __attribute__((ext_vector_type(2)));
#define MFMA32(a, b, c) __builtin_amdgcn_mfma_f32_32x32x16_bf16((a), (b), (c), 0, 0, 0)
#define MFMA16(a, b, c) __builtin_amdgcn_mfma_f32_16x16x32_bf16((a), (b), (c), 0, 0, 0)
__device__ __forceinline__ unsigned pkbf(float lo, float hi) { const f32x2_t v = {lo, hi}; return __builtin_bit_cast(unsigned, __builtin_convertvector(v, bf16x2_t)); }
__device__ __forceinline__ bf16x8 pack8(float a0, float a1, float a2, float a3, float a4, float a5, float a6, float a7) {
    v4u p; p.x = pkbf(a0, a1); p.y = pkbf(a2, a3); p.z = pkbf(a4, a5); p.w = pkbf(a6, a7); return __builtin_bit_cast(bf16x8, p); }
__device__ __forceinline__ bf16x8 cat4(s16x4 lo, s16x4 hi) { return __builtin_shufflevector(lo, hi, 0, 1, 2, 3, 4, 5, 6, 7); }
__device__ __forceinline__ int crow32(int i, int h) { return (i & 3) + 8 * (i >> 2) + 4 * h; }
__device__ __forceinline__ float fast_log_sigmoid(float z) { return fminf(z, 0.f) - __logf(1.f + __expf(-fabsf(z))); }

__device__ __forceinline__ void sb_wave_unit(Ctx& C, int b, int hh, int qblk) {
    const int lane = C.lane, r = lane & 31, h = lane >> 5;
    const bf16* P = C_PROJ; const size_t rs = EVEN_IN;
    const int t0 = qblk * 32; const size_t m0 = (size_t)b * SEQ + t0;
    bf16x8 qf[4];
#pragma unroll
    for (int ks = 0; ks < 4; ++ks) qf[ks] = *(const GAS bf16x8*)(P + (m0 + r) * rs + E_SQ + hh * 64 + 16 * ks + 8 * h);
    bf16x8 tri[2];
#pragma unroll
    for (int st = 0; st < 2; ++st)
#pragma unroll
        for (int j = 0; j < 8; ++j) { const int k = 16 * st + 8 * (j >> 2) + 4 * h + (j & 3); tri[st][j] = (k > r) ? (short)0x3F80 : (short)0; }
    f32x16 o0, o1;
#pragma unroll
    for (int i = 0; i < 16; ++i) { o0[i] = 0.f; o1[i] = 0.f; }
    float R = 0.f;
    const bf16* vt = C_VT1 + ((size_t)(b * 512 + hh * 64 + r)) * 2048;
    for (int s0 = t0; s0 >= 0; s0 -= 32) {
        const bf16* kp = P + ((size_t)b * SEQ + s0 + r) * rs + E_SK + hh * 64 + 8 * h;
        bf16x8 kf[4];
#pragma unroll
        for (int ks = 0; ks < 4; ++ks) kf[ks] = *(const GAS bf16x8*)(kp + 16 * ks);
        s16x4 va[2][2][2];
#pragma unroll
        for (int mt = 0; mt < 2; ++mt)
#pragma unroll
            for (int st = 0; st < 2; ++st)
#pragma unroll
                for (int hf = 0; hf < 2; ++hf) va[mt][st][hf] = *(const GAS s16x4*)(vt + (size_t)mt * 32 * 2048 + s0 + 16 * st + 8 * hf + 4 * h);
        f32x16 x;
#pragma unroll
        for (int i = 0; i < 16; ++i) x[i] = 0.f;
#pragma unroll
        for (int ks = 0; ks < 4; ++ks) x = MFMA32(kf[ks], qf[ks], x);
        const bool diag = (s0 == t0);
        float lom[16], lbv[16];
#pragma unroll
        for (int i = 0; i < 16; ++i) { const float z = x[i] * 0.125f, lb = fast_log_sigmoid(z); const bool valid = !diag || (crow32(i, h) < r);
            lom[i] = valid ? lb - z : 0.f; lbv[i] = valid ? lb : -1e30f; }
        const bf16x8 lf0 = pack8(lom[0], lom[1], lom[2], lom[3], lom[4], lom[5], lom[6], lom[7]);
        const bf16x8 lf1 = pack8(lom[8], lom[9], lom[10], lom[11], lom[12], lom[13], lom[14], lom[15]);
        f32x16 y;
#pragma unroll
        for (int i = 0; i < 16; ++i) y[i] = 0.f;
        y = MFMA32(tri[0], lf0, y); y = MFMA32(tri[1], lf1, y);
        const float tot = __shfl(y[0] + lom[0], r);
        float w[16];
#pragma unroll
        for (int i = 0; i < 16; ++i) w[i] = __expf(lbv[i] + y[i] + R);
        R += tot;
        const bf16x8 wf0 = pack8(w[0], w[1], w[2], w[3], w[4], w[5], w[6], w[7]);
        const bf16x8 wf1 = pack8(w[8], w[9], w[10], w[11], w[12], w[13], w[14], w[15]);
        o0 = MFMA32(cat4(va[0][0][0], va[0][0][1]), wf0, o0); o0 = MFMA32(cat4(va[0][1][0], va[0][1][1]), wf1, o0);
        o1 = MFMA32(cat4(va[1][0][0], va[1][0][1]), wf0, o1); o1 = MFMA32(cat4(va[1][1][0], va[1][1][1]), wf1, o1);
        if (__all(R < -100.f)) break;
    }
    const bf16* gp = P + (m0 + r) * rs + E_SG + hh * 64 + 4 * h;
    bf16* op = C_MIX + (m0 + r) * DM + 512 + hh * 64 + 4 * h;
#pragma unroll
    for (int mt = 0; mt < 2; ++mt)
#pragma unroll
        for (int q4 = 0; q4 < 4; ++q4) {
            const u32x2 gv = *(const GAS u32x2*)(gp + 32 * mt + 8 * q4);
            const float g0 = __uint_as_float(gv.x << 16), g1 = __uint_as_float(gv.x & 0xffff0000u), g2 = __uint_as_float(gv.y << 16), g3 = __uint_as_float(gv.y & 0xffff0000u);
            const float a0 = mt ? o1[4 * q4 + 0] : o0[4 * q4 + 0], a1 = mt ? o1[4 * q4 + 1] : o0[4 * q4 + 1], a2 = mt ? o1[4 * q4 + 2] : o0[4 * q4 + 2], a3 = mt ? o1[4 * q4 + 3] : o0[4 * q4 + 3];
            u32x2 ov; ov.x = pkbf(a0 * siluf_(g0), a1 * siluf_(g1)); ov.y = pkbf(a2 * siluf_(g2), a3 * siluf_(g3));
            *(GAS u32x2*)(op + 32 * mt + 8 * q4) = ov;
        }
}

constexpr int RT_Q = 0, RT_K = 18432, RT_KT = 36864, RT_V = 54272, RT_S = 89088;
__device__ __forceinline__ void ret_unit(Ctx& C, int b, int h) {
    const int tid = C.tid, lane = C.lane, w = C.wave, fr = lane & 15, g = lane >> 4;
    LAS unsigned char* L = C.lds;
    const bf16* P = C_PROJ; const size_t rs = EVEN_IN;
    const float lg2 = log2f(1.0f - exp2f(-5.0f - (float)h));
    const float gC = exp2f(128.0f * lg2);
    f32x4 st[4];
#pragma unroll
    for (int nt = 0; nt < 4; ++nt) st[nt] = (f32x4){0.f, 0.f, 0.f, 0.f};
    for (int i = tid; i < 18432 / 4; i += 512) ((LAS unsigned*)(L + RT_S))[i] = 0u;
    for (int c = 0; c < 16; ++c) {
        {
            const int tt = tid >> 2, part = tid & 3, t = 128 * c + tt; const size_t m = (size_t)b * SEQ + t;
            float qa[8], qb[8], ka[8], kb[8], cs[8], sn[8];
            unpack8(*(const GAS v4u*)(P + m * rs + E_RQ + h * 64 + 8 * part), qa); unpack8(*(const GAS v4u*)(P + m * rs + E_RQ + h * 64 + 32 + 8 * part), qb);
            unpack8(*(const GAS v4u*)(P + m * rs + E_RK + h * 64 + 8 * part), ka); unpack8(*(const GAS v4u*)(P + m * rs + E_RK + h * 64 + 32 + 8 * part), kb);
            { const f32x4 c0 = *(const GAS f32x4*)(C_TABC + t * 32 + 8 * part), c1 = *(const GAS f32x4*)(C_TABC + t * 32 + 8 * part + 4);
              const f32x4 s0 = *(const GAS f32x4*)(C_TABS + t * 32 + 8 * part), s1 = *(const GAS f32x4*)(C_TABS + t * 32 + 8 * part + 4);
              cs[0] = c0.x; cs[1] = c0.y; cs[2] = c0.z; cs[3] = c0.w; cs[4] = c1.x; cs[5] = c1.y; cs[6] = c1.z; cs[7] = c1.w;
              sn[0] = s0.x; sn[1] = s0.y; sn[2] = s0.z; sn[3] = s0.w; sn[4] = s1.x; sn[5] = s1.y; sn[6] = s1.z; sn[7] = s1.w; }
            const float fq = exp2f((float)tt * lg2), fk = 0.125f * exp2f(-(float)tt * lg2);
            float q1[8], q2[8], k1[8], k2[8];
#pragma unroll
            for (int j = 0; j < 8; ++j) { q1[j] = (qa[j] * cs[j] - qb[j] * sn[j]) * fq; q2[j] = (qa[j] * sn[j] + qb[j] * cs[j]) * fq;
                                          k1[j] = (ka[j] * cs[j] - kb[j] * sn[j]) * fk; k2[j] = (ka[j] * sn[j] + kb[j] * cs[j]) * fk; }
            *(LAS bf16x8*)(L + RT_Q + tt * 144 + 16 * part) = pack8(q1[0], q1[1], q1[2], q1[3], q1[4], q1[5], q1[6], q1[7]);
            *(LAS bf16x8*)(L + RT_Q + tt * 144 + 64 + 16 * part) = pack8(q2[0], q2[1], q2[2], q2[3], q2[4], q2[5], q2[6], q2[7]);
            *(LAS bf16x8*)(L + RT_K + tt * 144 + 16 * part) = pack8(k1[0], k1[1], k1[2], k1[3], k1[4], k1[5], k1[6], k1[7]);
            *(LAS bf16x8*)(L + RT_K + tt * 144 + 64 + 16 * part) = pack8(k2[0], k2[1], k2[2], k2[3], k2[4], k2[5], k2[6], k2[7]);
#pragma unroll
            for (int j = 0; j < 8; ++j) { *(LAS bf16*)(L + RT_KT + (8 * part + j) * 272 + tt * 2) = (bf16)f2bf(k1[j]); *(LAS bf16*)(L + RT_KT + (32 + 8 * part + j) * 272 + tt * 2) = (bf16)f2bf(k2[j]); }
            const int dv = tid >> 2, seg = tid & 3;
            const bf16* vsrc = C_VT0 + ((size_t)(b * 512 + h * 128 + dv)) * 2048 + 128 * c + seg * 32;
#pragma unroll
            for (int i = 0; i < 4; ++i) *(LAS v4u*)(L + RT_V + dv * 272 + (seg * 32 + 8 * i) * 2) = *(const GAS v4u*)(vsrc + 8 * i);
        }
        __syncthreads();
        bf16x8 qf[2];
#pragma unroll
        for (int ks = 0; ks < 2; ++ks) qf[ks] = *(const LAS bf16x8*)(L + RT_Q + (16 * w + fr) * 144 + (32 * ks + 8 * g) * 2);
        f32x4 o[8];
#pragma unroll
        for (int mt = 0; mt < 8; ++mt) o[mt] = (f32x4){0.f, 0.f, 0.f, 0.f};
#pragma unroll
        for (int kp = 0; kp < 4; ++kp) {
            if (kp <= (w >> 1)) {
                f32x4 s0 = (f32x4){0.f, 0.f, 0.f, 0.f}, s1 = (f32x4){0.f, 0.f, 0.f, 0.f};
#pragma unroll
                for (int ks = 0; ks < 2; ++ks) {
                    const bf16x8 a0 = *(const LAS bf16x8*)(L + RT_K + (32 * kp + fr) * 144 + (32 * ks + 8 * g) * 2);
                    const bf16x8 a1 = *(const LAS bf16x8*)(L + RT_K + (32 * kp + 16 + fr) * 144 + (32 * ks + 8 * g) * 2);
                    s0 = MFMA16(a0, qf[ks], s0); s1 = MFMA16(a1, qf[ks], s1);
                }
                const int tq = 16 * w + fr;
#pragma unroll
                for (int r = 0; r < 4; ++r) { if (32 * kp + 4 * g + r > tq) s0[r] = 0.f; if (32 * kp + 16 + 4 * g + r > tq) s1[r] = 0.f; }
                const bf16x8 pf = pack8(s0[0], s0[1], s0[2], s0[3], s1[0], s1[1], s1[2], s1[3]);
#pragma unroll
                for (int mt = 0; mt < 8; ++mt) {
                    const s16x4 lo = *(const LAS s16x4*)(L + RT_V + (16 * mt + fr) * 272 + (32 * kp + 4 * g) * 2);
                    const s16x4 hi = *(const LAS s16x4*)(L + RT_V + (16 * mt + fr) * 272 + (32 * kp + 16 + 4 * g) * 2);
                    o[mt] = MFMA16(cat4(lo, hi), pf, o[mt]);
                }
            }
        }
#pragma unroll
        for (int mt = 0; mt < 8; ++mt)
#pragma unroll
            for (int ks = 0; ks < 2; ++ks) o[mt] = MFMA16(*(const LAS bf16x8*)(L + RT_S + (16 * mt + fr) * 144 + (32 * ks + 8 * g) * 2), qf[ks], o[mt]);
#pragma unroll
        for (int ks = 0; ks < 4; ++ks) {
            const bf16x8 av = *(const LAS bf16x8*)(L + RT_V + (16 * w + fr) * 272 + (32 * ks + 8 * g) * 2);
#pragma unroll
            for (int nt = 0; nt < 4; ++nt) st[nt] = MFMA16(av, *(const LAS bf16x8*)(L + RT_KT + (16 * nt + fr) * 272 + (32 * ks + 8 * g) * 2), st[nt]);
        }
#pragma unroll
        for (int nt = 0; nt < 4; ++nt) st[nt] = st[nt] * gC;
        __syncthreads();
#pragma unroll
        for (int nt = 0; nt < 4; ++nt)
#pragma unroll
            for (int r = 0; r < 4; ++r) *(LAS bf16*)(L + RT_S + (16 * w + 4 * g + r) * 144 + (16 * nt + fr) * 2) = (bf16)f2bf(st[nt][r]);
        float ss = 0.f;
#pragma unroll
        for (int mt = 0; mt < 8; ++mt) ss += (o[mt][0] * o[mt][0] + o[mt][1] * o[mt][1]) + (o[mt][2] * o[mt][2] + o[mt][3] * o[mt][3]);
        ss += __shfl_xor(ss, 16); ss += __shfl_xor(ss, 32);
        const float rstd = rsqrtf(ss * (1.f / 128.f) + EPS);
        const size_t m = (size_t)b * SEQ + 128 * c + 16 * w + fr;
#pragma unroll
        for (int mt = 0; mt < 8; ++mt) {
            const u32x2 gv = *(const GAS u32x2*)(P + m * rs + E_RG + h * 128 + 16 * mt + 4 * g);
            const float g0 = __uint_as_float(gv.x << 16), g1 = __uint_as_float(gv.x & 0xffff0000u), g2 = __uint_as_float(gv.y << 16), g3 = __uint_as_float(gv.y & 0xffff0000u);
            u32x2 ov; ov.x = pkbf(o[mt][0] * rstd * siluf_(g0), o[mt][1] * rstd * siluf_(g1)); ov.y = pkbf(o[mt][2] * rstd * siluf_(g2), o[mt][3] * rstd * siluf_(g3));
            *(GAS u32x2*)(C_MIX + m * DM + h * 128 + 16 * mt + 4 * g) = ov;
        }
    }
    __syncthreads();
}
constexpr int CW_CTR = 64;
__device__ __forceinline__ void opt_even_mixer(Ctx& C, int li) {
    if (blockIdx.x < 64) for (int rr = 0; rr < REP_RET; ++rr) ret_unit(C, (int)blockIdx.x >> 2, (int)blockIdx.x & 3);
    unsigned* ctr = (unsigned*)(C.ws + WS_CTL) + CW_CTR + 64 * li;
    for (;;) {
        unsigned u = 0; if (C.lane == 0) u = __hip_atomic_fetch_add(ctr, 1u, __ATOMIC_RELAXED, __HIP_MEMORY_SCOPE_AGENT);
        u = __builtin_amdgcn_readfirstlane(u);
        if (u >= (unsigned)(BATCH * 8 * 64)) break;
        const int qblk = 63 - (int)(u >> 7), bh = (int)(u & 127);
        sb_wave_unit(C, bh >> 3, bh & 7, qblk);
    }
}

constexpr size_t WS_GD = 37 * MiB;
constexpr int H1_QR = 0, H1_KR = 17408, H1_KD = 34816, H1_QX = 52224, H1_TOT = 65280;
__device__ __forceinline__ void hg1_unit(Ctx& C, int u, int o) {
    const int sc = u & 31, bh = u >> 5, b = bh >> 2, h = bh & 3;
    const int lane = C.lane, w = C.wave, fr = lane & 15, g = lane >> 4;
    const int i = w >> 1, k = 64 * (w & 1) + lane;
    LAS unsigned char* L = C.lds; bf16* P = C_PROJ; const size_t rs = ODD_IN;
    const float lb = C_LB[o * 512 + h * 128 + k];
    const size_t m0 = (size_t)b * SEQ + 64 * sc + 16 * i;
    float q[16], kk[16], c[16]; float run = 0.f;
#pragma unroll
    for (int j = 0; j < 16; ++j) {
        const float fl = bf2f(P[(m0 + j) * rs + O_HF + h * 128 + k]); q[j] = bf2f(P[(m0 + j) * rs + O_HQ + h * 128 + k]);
        const float sig = 1.f / (1.f + __expf(-fl)), f = lb + (1.f - lb) * sig;
        run += __logf(f); c[j] = run; kk[j] = (1.f - lb) / (1.f + __expf(fl));
    }
    ((LAS float*)(L + H1_TOT))[i * 128 + k] = run;
    __syncthreads();
    const float t0 = ((LAS float*)(L + H1_TOT))[k], t1 = ((LAS float*)(L + H1_TOT))[128 + k], t2 = ((LAS float*)(L + H1_TOT))[256 + k], t3 = ((LAS float*)(L + H1_TOT))[384 + k];
    const float Bi = (i > 0 ? t0 : 0.f) + (i > 1 ? t1 : 0.f) + (i > 2 ? t2 : 0.f), B4 = (t0 + t1) + (t2 + t3), Bn = Bi + run;
    const float eBi = __expf(Bi), eEnd = __expf(B4 - Bn), eD = __expf(-run);
    const float fx0 = (i == 2) ? __expf(t1) : ((i == 3) ? __expf(t2) : 0.f), fx1 = (i == 3) ? __expf(t1 + t2) : 0.f;
    float ksv[16];
#pragma unroll
    for (int j = 0; j < 16; ++j) {
        const float qr = q[j] * __expf(c[j]), kr = kk[j] * __expf(run - c[j]);
        const int row = 16 * i + j;
        *(LAS bf16*)(L + H1_QR + row * 272 + k * 2) = (bf16)f2bf(qr);
        *(LAS bf16*)(L + H1_KR + row * 272 + k * 2) = (bf16)f2bf(kr);
        *(LAS bf16*)(L + H1_KD + row * 272 + k * 2) = (bf16)f2bf(kr * eD);
        if (i == 2) *(LAS bf16*)(L + H1_QX + j * 272 + k * 2) = (bf16)f2bf(qr * fx0);
        if (i == 3) { *(LAS bf16*)(L + H1_QX + (16 + j) * 272 + k * 2) = (bf16)f2bf(qr * fx0);
                      *(LAS bf16*)(L + H1_QX + (32 + j) * 272 + k * 2) = (bf16)f2bf(qr * fx1); }
        C_XN[(m0 + j) * 512 + h * 128 + k] = (bf16)f2bf(qr * eBi);
        ksv[j] = kr * eEnd;
    }
    {
        bf16* kd = C_KST + ((size_t)u * 128 + k) * 64 + 16 * i;
        v4u p0, p1; p0.x = pkbf(ksv[0], ksv[1]); p0.y = pkbf(ksv[2], ksv[3]); p0.z = pkbf(ksv[4], ksv[5]); p0.w = pkbf(ksv[6], ksv[7]);
        p1.x = pkbf(ksv[8], ksv[9]); p1.y = pkbf(ksv[10], ksv[11]); p1.z = pkbf(ksv[12], ksv[13]); p1.w = pkbf(ksv[14], ksv[15]);
        *(GAS v4u*)kd = p0; *(GAS v4u*)(kd + 8) = p1;
        if (i == 0) ((float*)(C.ws + WS_GD))[(size_t)u * 128 + k] = __expf(B4);
    }
    __syncthreads();
    const int ti = w & 3, vh = w >> 2;
    f32x4 at[4];
#pragma unroll
    for (int sj = 0; sj < 4; ++sj) {
        at[sj] = (f32x4){0.f, 0.f, 0.f, 0.f};
        if (sj <= ti) {
            const int kbase = (sj == ti) ? H1_KD : H1_KR;
            const int gap = ti - sj;
            const int qbase = (gap <= 1) ? (H1_QR + 16 * ti * 272) : ((ti == 2) ? H1_QX : ((sj == 1) ? (H1_QX + 16 * 272) : (H1_QX + 32 * 272)));
#pragma unroll
            for (int ks = 0; ks < 4; ++ks) {
                const bf16x8 a = *(const LAS bf16x8*)(L + kbase + (16 * sj + fr) * 272 + (32 * ks + 8 * g) * 2);
                const bf16x8 bq = *(const LAS bf16x8*)(L + qbase + fr * 272 + (32 * ks + 8 * g) * 2);
                at[sj] = MFMA16(a, bq, at[sj]);
            }
            if (sj == ti) {
#pragma unroll
                for (int r = 0; r < 4; ++r) if (4 * g + r > fr) at[sj][r] = 0.f;
            }
        }
    }
    f32x4 oo[4];
#pragma unroll
    for (int mt = 0; mt < 4; ++mt) oo[mt] = (f32x4){0.f, 0.f, 0.f, 0.f};
    const bf16* vtb = C_VT0 + ((size_t)(b * 512 + h * 128 + 64 * vh + fr)) * 2048 + 64 * sc + 4 * g;
#pragma unroll
    for (int kp = 0; kp < 2; ++kp) {
        if (2 * kp <= ti) {
            const bf16x8 pf = kp == 0 ? pack8(at[0][0], at[0][1], at[0][2], at[0][3], at[1][0], at[1][1], at[1][2], at[1][3]) : pack8(at[2][0], at[2][1], at[2][2], at[2][3], at[3][0], at[3][1], at[3][2], at[3][3]);
#pragma unroll
            for (int mt = 0; mt < 4; ++mt) {
                const s16x4 lo = *(const GAS s16x4*)(vtb + (size_t)mt * 16 * 2048 + 32 * kp), hi = *(const GAS s16x4*)(vtb + (size_t)mt * 16 * 2048 + 32 * kp + 16);
                oo[mt] = MFMA16(cat4(lo, hi), pf, oo[mt]);
            }
        }
    }
    bf16* op = C_OI + ((size_t)b * SEQ + 64 * sc + 16 * ti + fr) * 512 + h * 128 + 64 * vh + 4 * g;
#pragma unroll
    for (int mt = 0; mt < 4; ++mt) { u32x2 ov; ov.x = pkbf(oo[mt][0], oo[mt][1]); ov.y = pkbf(oo[mt][2], oo[mt][3]); *(GAS u32x2*)(op + 16 * mt) = ov; }
    __syncthreads();
}

constexpr int H2_ST = 0, H2_VT = 34816, H2_SS = 34816 + 2 * 18432;
__device__ __forceinline__ void hg2_unit(Ctx& C, int bh) {
    const int b = bh >> 2, h = bh & 3;
    const int tid = C.tid, lane = C.lane, w = C.wave, fr = lane & 15, g = lane >> 4, ti = w & 3, vh = w >> 2;
    LAS unsigned char* L = C.lds; const bf16* P = C_PROJ; const size_t rs = ODD_IN;
    f32x4 st[8];
#pragma unroll
    for (int nt = 0; nt < 8; ++nt) st[nt] = (f32x4){0.f, 0.f, 0.f, 0.f};
    for (int i = tid; i < 34816 / 4; i += 512) ((LAS unsigned*)(L + H2_ST))[i] = 0u;
    const int sv = tid >> 2, sseg = tid & 3;
    const bf16* vsrc = C_VT0 + ((size_t)(b * 512 + h * 128 + sv)) * 2048 + 16 * sseg;
    const float* gdp = (const float*)(C.ws + WS_GD) + (size_t)bh * 32 * 128 + 16 * w + 4 * g;
    const bf16* kstp = C_KST + ((size_t)bh * 32 * 128 + 16 * w + fr) * 64 + 8 * g;
    const size_t mrow = (size_t)b * SEQ + 16 * ti + fr;
    bf16x8 qf[4], ka[2]; f32x4 gd; u32x2 oi[4], gt[4]; v4u vs0, vs1;
#pragma unroll
    for (int ks = 0; ks < 4; ++ks) qf[ks] = *(const GAS bf16x8*)(C_XN + mrow * 512 + h * 128 + 32 * ks + 8 * g);
#pragma unroll
    for (int ks = 0; ks < 2; ++ks) ka[ks] = *(const GAS bf16x8*)(kstp + 32 * ks);
    gd = *(const GAS f32x4*)gdp;
#pragma unroll
    for (int mt = 0; mt < 4; ++mt) { oi[mt] = *(const GAS u32x2*)(C_OI + mrow * 512 + h * 128 + 64 * vh + 16 * mt + 4 * g); gt[mt] = *(const GAS u32x2*)(P + mrow * rs + O_HG + h * 128 + 64 * vh + 16 * mt + 4 * g); }
    vs0 = *(const GAS v4u*)vsrc; vs1 = *(const GAS v4u*)(vsrc + 8);
    *(LAS v4u*)(L + H2_VT + sv * 144 + sseg * 32) = vs0; *(LAS v4u*)(L + H2_VT + sv * 144 + sseg * 32 + 16) = vs1;
    vs0 = *(const GAS v4u*)(vsrc + 64); vs1 = *(const GAS v4u*)(vsrc + 64 + 8);
    __syncthreads();
    for (int sc = 0; sc < 32; ++sc) {
        const size_t m = mrow + 64 * sc;
        const int scn = sc < 31 ? sc + 1 : sc;
        const size_t mn = mrow + 64 * scn;
        bf16x8 qfn[4], kan[2]; f32x4 gdn; u32x2 oin[4], gtn[4];
#pragma unroll
        for (int ks = 0; ks < 4; ++ks) qfn[ks] = *(const GAS bf16x8*)(C_XN + mn * 512 + h * 128 + 32 * ks + 8 * g);
#pragma unroll
        for (int ks = 0; ks < 2; ++ks) kan[ks] = *(const GAS bf16x8*)(kstp + (size_t)scn * 128 * 64 + 32 * ks);
        gdn = *(const GAS f32x4*)(gdp + scn * 128);
#pragma unroll
        for (int mt = 0; mt < 4; ++mt) { oin[mt] = *(const GAS u32x2*)(C_OI + mn * 512 + h * 128 + 64 * vh + 16 * mt + 4 * g); gtn[mt] = *(const GAS u32x2*)(P + mn * rs + O_HG + h * 128 + 64 * vh + 16 * mt + 4 * g); }
        { LAS unsigned char* vn = L + H2_VT + ((sc + 1) & 1) * 18432; *(LAS v4u*)(vn + sv * 144 + sseg * 32) = vs0; *(LAS v4u*)(vn + sv * 144 + sseg * 32 + 16) = vs1; }
        { const int sc2 = sc < 30 ? sc + 2 : 31; vs0 = *(const GAS v4u*)(vsrc + 64 * sc2); vs1 = *(const GAS v4u*)(vsrc + 64 * sc2 + 8); }
        f32x4 o[4];
#pragma unroll
        for (int mt = 0; mt < 4; ++mt) {
            o[mt] = (f32x4){0.f, 0.f, 0.f, 0.f};
#pragma unroll
            for (int ks = 0; ks < 4; ++ks) o[mt] = MFMA16(*(const LAS bf16x8*)(L + H2_ST + (64 * vh + 16 * mt + fr) * 272 + (32 * ks + 8 * g) * 2), qf[ks], o[mt]);
        }
        float ss = 0.f;
#pragma unroll
        for (int mt = 0; mt < 4; ++mt) { const u32x2 iv = oi[mt];
            o[mt][0] += __uint_as_float(iv.x << 16); o[mt][1] += __uint_as_float(iv.x & 0xffff0000u); o[mt][2] += __uint_as_float(iv.y << 16); o[mt][3] += __uint_as_float(iv.y & 0xffff0000u);
            ss += (o[mt][0] * o[mt][0] + o[mt][1] * o[mt][1]) + (o[mt][2] * o[mt][2] + o[mt][3] * o[mt][3]); }
        ss += __shfl_xor(ss, 16); ss += __shfl_xor(ss, 32);
        if (g == 0) ((LAS float*)(L + H2_SS))[vh * 64 + 16 * ti + fr] = ss;
        __syncthreads();
        const LAS unsigned char* vt = L + H2_VT + (sc & 1) * 18432;
#pragma unroll
        for (int nt = 0; nt < 8; ++nt) { st[nt] = st[nt] * gd;
#pragma unroll
            for (int ks = 0; ks < 2; ++ks) st[nt] = MFMA16(ka[ks], *(const LAS bf16x8*)(vt + (16 * nt + fr) * 144 + (32 * ks + 8 * g) * 2), st[nt]); }
#pragma unroll
        for (int nt = 0; nt < 8; ++nt) { u32x2 svv; svv.x = pkbf(st[nt][0], st[nt][1]); svv.y = pkbf(st[nt][2], st[nt][3]); *(LAS u32x2*)(L + H2_ST + (16 * nt + fr) * 272 + (16 * w + 4 * g) * 2) = svv; }
        const float tot = ((LAS float*)(L + H2_SS))[16 * ti + fr] + ((LAS float*)(L + H2_SS))[64 + 16 * ti + fr];
        const float rstd = rsqrtf(tot * (1.f / 128.f) + EPS);
        bf16* op = C_MIX + m * DM + h * 128 + 64 * vh + 4 * g;
#pragma unroll
        for (int mt = 0; mt < 4; ++mt) {
            const u32x2 gv = gt[mt];
            const float g0 = __uint_as_float(gv.x << 16), g1 = __uint_as_float(gv.x & 0xffff0000u), g2 = __uint_as_float(gv.y << 16), g3 = __uint_as_float(gv.y & 0xffff0000u);
            u32x2 ov; ov.x = pkbf(o[mt][0] * rstd * siluf_(g0), o[mt][1] * rstd * siluf_(g1)); ov.y = pkbf(o[mt][2] * rstd * siluf_(g2), o[mt][3] * rstd * siluf_(g3));
            *(GAS u32x2*)(op + 16 * mt) = ov;
        }
#pragma unroll
        for (int ks = 0; ks < 4; ++ks) qf[ks] = qfn[ks];
        ka[0] = kan[0]; ka[1] = kan[1]; gd = gdn;
#pragma unroll
        for (int mt = 0; mt < 4; ++mt) { oi[mt] = oin[mt]; gt[mt] = gtn[mt]; }
        __syncthreads();
    }
}
constexpr int LR_WA = 0, LR_WX = 9216, LR_PW = 18432, LR_PWSZ = 14848, LR_XC = 0, LR_XCF = 2304, LR_AU = 6400, LR_CAR = 18432 + 8 * 14848;
__device__ __forceinline__ void lru_unit(Ctx& C, int b, int n, int o) {
    const int tid = C.tid, lane = C.lane, w = C.wave, fr = lane & 15, g = lane >> 4;
    LAS unsigned char* L = C.lds; const bf16* P = C_PROJ; const size_t rs = ODD_IN;
    {
        const float* Wa = IN(10) + ((size_t)o * 8 + n) * 4096; const float* Wx = IN(12) + ((size_t)o * 8 + n) * 4096;
        for (int e = tid; e < 4096; e += 512) { const int i = e >> 6, j = e & 63;
            *(LAS bf16*)(L + LR_WA + j * 144 + i * 2) = (bf16)f2bf(Wa[e]); *(LAS bf16*)(L + LR_WX + j * 144 + i * 2) = (bf16)f2bf(Wx[e]); }
    }
    const int ch = n * 64 + lane;
    const float* cw = IN(8) + (size_t)o * 4 * 512; const float cb = IN(9)[o * 512 + ch];
    const float w0 = cw[ch], w1 = cw[512 + ch], w2 = cw[1024 + ch], w3 = cw[1536 + ch];
    float ba[4], bx[4], sp8[4];
#pragma unroll
    for (int nt = 0; nt < 4; ++nt) { const int cj = o * 512 + n * 64 + 16 * nt + fr; ba[nt] = IN(11)[cj]; bx[nt] = IN(13)[cj]; sp8[nt] = 8.0f * log1pf(expf(-IN(14)[cj])); }
    LAS unsigned char* PW = L + LR_PW + w * LR_PWSZ;
    __syncthreads();
    float hin = 0.f;
    const size_t mb = (size_t)b * SEQ;
    for (int pass = 0; pass < 2; ++pass) {
        float hs = hin, aprod = 1.f;
        const int tw = 256 * w;
        float xm1 = tw >= 1 ? bf2f(P[(mb + tw - 1) * rs + O_LX + ch]) : 0.f, xm2 = tw >= 2 ? bf2f(P[(mb + tw - 2) * rs + O_LX + ch]) : 0.f, xm3 = tw >= 3 ? bf2f(P[(mb + tw - 3) * rs + O_LX + ch]) : 0.f;
        bf16 xv[16], gv[16];
#pragma unroll
        for (int p = 0; p < 16; ++p) { xv[p] = P[(mb + tw + p) * rs + O_LX + ch]; gv[p] = P[(mb + tw + p) * rs + (pass ? O_LG : O_LX) + ch]; }
        for (int tile = 0; tile < 16; ++tile) {
            const int t0 = tw + 16 * tile, tn = tw + 16 * (tile < 15 ? tile + 1 : tile);
            bf16 xn[16], gn[16];
#pragma unroll
            for (int p = 0; p < 16; ++p) { xn[p] = P[(mb + tn + p) * rs + O_LX + ch]; gn[p] = P[(mb + tn + p) * rs + (pass ? O_LG : O_LX) + ch]; }
#pragma unroll
            for (int p = 0; p < 16; ++p) { const float xcur = bf2f(xv[p]); const float xc = cb + w3 * xcur + w2 * xm1 + w1 * xm2 + w0 * xm3; xm3 = xm2; xm2 = xm1; xm1 = xcur;
                *(LAS bf16*)(PW + LR_XC + p * 144 + lane * 2) = (bf16)f2bf(xc); ((LAS float*)(PW + LR_XCF))[p * 64 + lane] = xc; }
            asm volatile("s_waitcnt lgkmcnt(0)" ::: "memory");
            f32x4 ra[4], rx[4];
#pragma unroll
            for (int nt = 0; nt < 4; ++nt) { ra[nt] = (f32x4){0.f, 0.f, 0.f, 0.f}; rx[nt] = (f32x4){0.f, 0.f, 0.f, 0.f}; }
#pragma unroll
            for (int ks = 0; ks < 2; ++ks) {
                const bf16x8 a = *(const LAS bf16x8*)(PW + LR_XC + fr * 144 + (32 * ks + 8 * g) * 2);
#pragma unroll
                for (int nt = 0; nt < 4; ++nt) {
                    ra[nt] = MFMA16(a, *(const LAS bf16x8*)(L + LR_WA + (16 * nt + fr) * 144 + (32 * ks + 8 * g) * 2), ra[nt]);
                    rx[nt] = MFMA16(a, *(const LAS bf16x8*)(L + LR_WX + (16 * nt + fr) * 144 + (32 * ks + 8 * g) * 2), rx[nt]);
                }
            }
#pragma unroll
            for (int nt = 0; nt < 4; ++nt)
#pragma unroll
                for (int r = 0; r < 4; ++r) {
                    const int p = 4 * g + r, j = 16 * nt + fr;
                    const float rr = __builtin_amdgcn_rcpf(1.f + __expf(-(ra[nt][r] + ba[nt]))), ig = __builtin_amdgcn_rcpf(1.f + __expf(-(rx[nt][r] + bx[nt])));
                    const float la = -rr * sp8[nt], a = __expf(la);
                    const float mult = (t0 + p == 0) ? 1.0f : __builtin_amdgcn_sqrtf(fmaxf(1.0f - a * a, 0.f));
                    const float xcv = ((const LAS float*)(PW + LR_XCF))[p * 64 + j];
                    f32x2_t au; au.x = a; au.y = mult * ig * xcv;
                    *(LAS f32x2_t*)(PW + LR_AU + (p * 64 + j) * 8) = au;
                }
            asm volatile("s_waitcnt lgkmcnt(0)" ::: "memory");
            if (pass == 0) {
#pragma unroll
                for (int p = 0; p < 16; ++p) { const f32x2_t au = *(const LAS f32x2_t*)(PW + LR_AU + (p * 64 + lane) * 8); hs = au.x * hs + au.y; aprod *= au.x; }
            } else {
#pragma unroll
                for (int p = 0; p < 16; ++p) { const f32x2_t au = *(const LAS f32x2_t*)(PW + LR_AU + (p * 64 + lane) * 8); hs = au.x * hs + au.y;
                    const float gg = bf2f(gv[p]); C_MIX[(mb + t0 + p) * DM + 512 + ch] = (bf16)f2bf(hs * gg * __builtin_amdgcn_rcpf(1.f + __expf(-gg))); }
            }
            asm volatile("s_waitcnt lgkmcnt(0)" ::: "memory");
#pragma unroll
            for (int p = 0; p < 16; ++p) { xv[p] = xn[p]; gv[p] = gn[p]; }
        }
        if (pass == 0) {
            f32x2_t cr; cr.x = aprod; cr.y = hs;
            *(LAS f32x2_t*)(L + LR_CAR + (w * 64 + lane) * 8) = cr;
            __syncthreads();
            hin = 0.f;
            for (int ww = 0; ww < w; ++ww) { const f32x2_t cc = *(const LAS f32x2_t*)(L + LR_CAR + (ww * 64 + lane) * 8); hin = cc.x * hin + cc.y; }
        }
    }
    __syncthreads();
}
__device__ __forceinline__ void opt_odd_mixer1(Ctx& C, int o) {
    const int per = (2048 + C.G - 1) / C.G;
    for (int kk = 0; kk < per; ++kk) { const int u = C.vcu * per + kk; if (u < 2048) for (int rr = 0; rr < REP_HG1; ++rr) hg1_unit(C, u, o); }
}
__device__ __forceinline__ void opt_odd_mixer2(Ctx& C, int o) {
    const int bx = (int)blockIdx.x;
    if (bx < 64) for (int rr = 0; rr < REP_HG2; ++rr) hg2_unit(C, bx);
    else if (bx < 192) for (int rr = 0; rr < REP_LRU; ++rr) lru_unit(C, (bx - 64) >> 3, (bx - 64) & 7, o);
}
#ifndef REP_GEMM
#define REP_GEMM 1
#endif
#ifndef REP_EVEN
#define REP_EVEN 1
#endif
#ifndef REP_ODD
#define REP_ODD 1
#endif
__global__ void __launch_bounds__(NWAVES * 64, 2) mega_fwd(Params prm) {
    extern __shared__ __attribute__((aligned(16))) unsigned char lds_raw[];
    Ctx C0;
    Ctx& C = C0;
    C.lds = (LAS unsigned char*)lds_raw;
    volatile LAS unsigned* MISC = (volatile LAS unsigned*)(C.lds + LDSCTL_OFF);
    C.tid = threadIdx.x; C.lane = C.tid & 63; C.wave = __builtin_amdgcn_readfirstlane(C.tid >> 6);
    C.G = gridDim.x; { const int bx = blockIdx.x; C.vcu = (C.G % 8 == 0) ? (bx % 8) * (C.G / 8) + bx / 8 : bx; }
    C.ws = (GAS unsigned char*)prm.ws;
    gu32* ctl = (gu32*)((GAS unsigned char*)prm.ws + WS_CTL);
    for (int u = C.tid; u < (LDS_BYTES - LDSCTL_OFF) / 4; u += NWAVES * 64) ((LAS unsigned*)(C.lds + LDSCTL_OFF))[u] = 0u;
    __syncthreads();
    XcdBarrier bar = xcd_barrier_post((unsigned*)(ctl + CW_BAR), MISC + 8);
    const unsigned my_xcc = bar.x;
#define GRID_BAR() do { GAS unsigned char* wsb_ = C0.ws; asm volatile("" : "+s"(wsb_)); XcdBarrier bb_; bb_.bar = (unsigned*)(wsb_ + WS_CTL) + CW_BAR; bb_.x = my_xcc; bb_.st = (volatile LAS unsigned*)(C0.lds + LDSCTL_OFF) + 8; xcd_barrier(bb_); } while (0)
#define FRESH() Ctx C = C0; asm volatile("" : "+v"(C.tid)); C.lane = C.tid & 63; C.wave = __builtin_amdgcn_readfirstlane(C.tid >> 6); asm volatile("" : "+s"(C.ws)); asm volatile("" : "+s"(C.vcu))

    { FRESH(); p0_prologue(C); }
    GRID_BAR();

    for (int L = 0; L < 4; ++L) {
        const bool even = (L & 1) == 0; const int li = L >> 1;
        for (int rep = 0; rep < REP_GEMM; ++rep) { if (rep) GRID_BAR(); FRESH();
            const int N = even ? EVEN_IN : ODD_IN;
            const size_t woff = (L == 0) ? WS_WIN0 : (L == 1) ? WS_WIN1 : (L == 2) ? WS_WIN2 : WS_WIN3;
            pg8::Gemm g{C_XN, (const bf16*)(C.ws + woff), MTOK, N, DM}; pg8::StaticOrder S; S.init(MTOK, N, C.G, (int)blockIdx.x);
            pg8::EpiProj E{C_PROJ, N, C_VT0, even ? E_RV : O_HI, C_VT1, even ? E_SV : -100000, 1};
            pg8::gemm_phase<pg8::EpiProj, pg8::StaticOrder, true, true>(C.lds, g, S, E);
        }
        GRID_BAR();
        if (even) { for (int rep = 0; rep < REP_EVEN; ++rep) { { FRESH(); opt_even_mixer(C, li + 2 * rep); } GRID_BAR(); } }
        else { for (int rep = 0; rep < REP_ODD; ++rep) { { FRESH(); opt_odd_mixer1(C, li); } GRID_BAR(); { FRESH(); opt_odd_mixer2(C, li); } GRID_BAR(); } }
        for (int rep = 0; rep < REP_GEMM; ++rep) { if (rep) GRID_BAR(); FRESH();
            pg8::Gemm g{C_MIX, (const bf16*)(C.ws + WS_WOUT + (size_t)L * 2 * MiB), MTOK, DM, DM}; pg8::StaticOrder S; S.init(MTOK, DM, C.G, (int)blockIdx.x);
            pg8::EpiProj E{C_PROJ, DM, nullptr, -100000, nullptr, -100000, 1};
            pg8::gemm_phase<pg8::EpiProj, pg8::StaticOrder, true, true>(C.lds, g, S, E);
        }
        GRID_BAR();
        { FRESH(); norm_rows_phase(C, C_PROJ, L == 0 ? IN(0) : OUTP(), IN(2) + (size_t)L * DM, L < 3 ? IN(1) + (size_t)(L + 1) * DM : nullptr); }
        if (L < 3) GRID_BAR();
    }
}

extern "C" void kernel_launch(void* const* d_in, const int* in_sizes, int n_in, void* d_out, int out_size, void* d_ws, size_t ws_size, hipStream_t stream) {
    static int grid = 0;
    if (grid == 0) {
        if (n_in != 15 || in_sizes[0] != MTOK * DM || out_size != MTOK * DM || ws_size < WS_END) { fprintf(stderr, "kernel_launch: unexpected shapes (n_in %d, in0 %d, out %d, ws %zu)\n", n_in, n_in > 0 ? in_sizes[0] : -1, out_size, ws_size); grid = -1; return; }
        int dev = 0, cus = 0, per_cu = 0;
        if (hipGetDevice(&dev) != hipSuccess || hipDeviceGetAttribute(&cus, hipDeviceAttributeMultiprocessorCount, dev) != hipSuccess) { grid = -1; return; }
        if (hipFuncSetAttribute((const void*)mega_fwd, hipFuncAttributeMaxDynamicSharedMemorySize, LDS_BYTES) != hipSuccess) { fprintf(stderr, "kernel_launch: hipFuncSetAttribute failed\n"); grid = -1; return; }
        if (hipOccupancyMaxActiveBlocksPerMultiprocessor(&per_cu, (const void*)mega_fwd, NWAVES * 64, LDS_BYTES) != hipSuccess || per_cu < 1) { fprintf(stderr, "kernel_launch: occupancy query reports %d blocks per CU\n", per_cu); (void)hipGetLastError(); per_cu = 1; }
        grid = cus;
    }
    if (grid < 0) return;
    if (hipMemsetAsync((char*)d_ws + WS_CTL, 0, CTL_ZERO_BYTES, stream) != hipSuccess) { fprintf(stderr, "kernel_launch: memset failed\n"); return; }
    Params a{};
    for (int i = 0; i < 15; ++i) a.in[i] = (const float*)d_in[i];
    a.out = (float*)d_out; a.ws = (unsigned char*)d_ws;
    hipLaunchKernelGGL(mega_fwd, dim3(grid), dim3(NWAVES * 64), LDS_BYTES, stream, a);
    const hipError_t le = hipPeekAtLastError();
    if (le != hipSuccess) fprintf(stderr, "kernel_launch: launch failed: %s\n", hipGetErrorName(le));
}
```

```cpp
#include <hip/hip_runtime.h>
#include <cstdio>
#include <cstdint>
#include <cmath>
namespace pg8 {
#define PG8_LAS __attribute__((address_space(3)))
typedef unsigned short bf16_t;
typedef short bf16x8 __attribute__((ext_vector_type(8)));
typedef float f32x4 __attribute__((ext_vector_type(4)));
typedef unsigned u32x4 __attribute__((ext_vector_type(4)));
constexpr int BM = 256, BK = 64, HALF = 128, HTB = HALF * BK * 2  , STAGE_BYTES = 8 * HTB, NXCD = 8, WGM = 8;

__host__ __device__ __forceinline__ int lds_byte(int r, int c) { const int st = (r >> 4) * 2 + (c >> 5), rr = r & 15, cc = c & 31, ob = rr * 64 + cc * 2; return st * 1024 + (ob ^ (((ob >> 9) & 1) << 5)); }
__host__ __device__ __forceinline__ void stage_rc(int b, int& R, int& C) { const int st = b / 1024, sb = b % 1024, swz = sb ^ (((sb >> 9) & 1) << 5); R = (st >> 1) * 16 + swz / 64; C = (st & 1) * 32 + (swz % 64) / 2; }
__host__ __device__ __forceinline__ int perm32(int rho) { const int n = rho >> 4, i = rho & 15; return 8 * (i >> 2) + 4 * n + (i & 3); }

struct Unit { int pm, pn; };
struct Gemm { const bf16_t* A; const bf16_t* Bt; int M, N, K; };

struct StaticOrder {
    int nM, nN, nwg, G, c;
    __host__ __device__ void init(int M, int N, int G_, int c_) { nM = M / BM; nN = N / BM; nwg = nM * nN; G = G_; c = c_; }
    __host__ __device__ bool next(int i, Unit& u) const {
        const long L = (long)i * G + c; if (L >= nwg) return false;
        int wgid = (int)L; { const int q = nwg / NXCD, r = nwg % NXCD, xcd = wgid % NXCD, off = wgid / NXCD; wgid = (xcd < r ? xcd * (q + 1) : r * (q + 1) + (xcd - r) * q) + off; }
        const int nig = WGM * nN, gid = wgid / nig, fm = gid * WGM, gsz = (nM - fm) < WGM ? (nM - fm) : WGM;
        u.pm = fm + ((wgid % nig) % gsz); u.pn = (wgid % nig) / gsz; return true;
    }
    __device__ __forceinline__ void a_ready(const Unit&) const {}
    __device__ __forceinline__ void done(const Unit&) const {}
};

__device__ __forceinline__ unsigned cvt_pk_bf16(float lo, float hi) { unsigned r; asm volatile("v_cvt_pk_bf16_f32 %0, %1, %2" : "=v"(r) : "v"(lo), "v"(hi)); return r; }
struct EpiProj {
    static constexpr bool PERM = true, AFTER_DRAIN = false;
    bf16_t* O; int ldc; bf16_t* T0; int lo0; bf16_t* T1; int lo1; int nat;
    __device__ __forceinline__ void operator()(const f32x4 (&acc)[2][2][4][2], const Unit& u, int wr, int wc, int fr, int fq) const {
        const int row0 = u.pm * BM + wr * 64 + fr; const int colt = u.pn * BM;
        const int col0 = colt + wc * 32 + 8 * fq;
        bf16_t* T = nullptr; int cc0 = 0;
        if (colt >= lo0 && colt < lo0 + 512) { T = T0; cc0 = colt - lo0; } else if (colt >= lo1 && colt < lo1 + 512) { T = T1; cc0 = colt - lo1; }
        if (T == nullptr || nat) {
#pragma unroll
            for (int ai = 0; ai < 2; ++ai)
#pragma unroll
                for (int m = 0; m < 4; ++m) { bf16_t* rowp = O + (size_t)(row0 + ai * HALF + m * 16) * ldc + col0;
#pragma unroll
                    for (int bj = 0; bj < 2; ++bj) { const f32x4 v0 = acc[ai][bj][m][0], v1 = acc[ai][bj][m][1];
                        u32x4 w; w.x = cvt_pk_bf16(v0[0], v0[1]); w.y = cvt_pk_bf16(v0[2], v0[3]); w.z = cvt_pk_bf16(v1[0], v1[1]); w.w = cvt_pk_bf16(v1[2], v1[3]);
                        *(u32x4*)(rowp + bj * HALF) = w; } }
        }
        if (T != nullptr) {
            const int b = (u.pm * BM) >> 11; const int s0 = ((u.pm * BM) & 2047) + wr * 64 + fr;
            bf16_t* tb = T + ((size_t)(b * 512 + cc0 + wc * 32 + 8 * fq)) * 2048 + s0;
#pragma unroll
            for (int ai = 0; ai < 2; ++ai)
#pragma unroll
                for (int m = 0; m < 4; ++m)
#pragma unroll
                    for (int bj = 0; bj < 2; ++bj)
#pragma unroll
                        for (int n = 0; n < 2; ++n) { const f32x4 v = acc[ai][bj][m][n];
                            const unsigned p01 = cvt_pk_bf16(v[0], v[1]), p23 = cvt_pk_bf16(v[2], v[3]);
                            bf16_t* q = tb + (size_t)(bj * HALF + 4 * n) * 2048 + ai * HALF + m * 16;
                            q[0] = (bf16_t)(p01 & 0xffffu); q[2048] = (bf16_t)(p01 >> 16); q[2 * 2048] = (bf16_t)(p23 & 0xffffu); q[3 * 2048] = (bf16_t)(p23 >> 16); }
        }
    }
};
template <class Epi, class Sched, bool ALIGN_EPI = false, bool SP2 = false>
__device__ __forceinline__ void gemm_phase(PG8_LAS unsigned char* lds, const Gemm g, const Sched& S, const Epi& E) {
    int tid_ = threadIdx.x; asm volatile("" : "+v"(tid_));
    const int tid = tid_, wid = __builtin_amdgcn_readfirstlane(tid >> 6), lane = tid & 63, wr = wid >> 2, wc = wid & 3, fr = lane & 15, fq = lane >> 4;
    const int K = g.K, nt = K / BK;
    unsigned voffA[2], voffB[2];
#pragma unroll
    for (int i = 0; i < 2; ++i) { int R, C; stage_rc(tid * 16 + i * 8192, R, C); const int Rb = Epi::PERM ? ((R & ~31) + perm32(R & 31)) : R;
        voffA[i] = (unsigned)(R * K + C) * 2u; voffB[i] = (unsigned)(Rb * K + C) * 2u; }
    const size_t kstep = (size_t)(BK * 2);
    const size_t hstep = (size_t)HALF * K * 2;
    const size_t tstep = 2 * hstep;
    const unsigned ldsw = (unsigned)wid * 1024u;
    const int aoff = lds_byte(wr * 64 + fr, fq * 8), boff = lds_byte(wc * 32 + fr, fq * 8);
#define PG8_SA(b, h) (((b) * 2 + (h)) * HTB)
#define PG8_SB(b, h) ((4 + (b) * 2 + (h)) * HTB)
#define PG8_STAGE(bufoff, gbase, voff) do { _Pragma("unroll") for (int _i = 0; _i < 2; ++_i) \
        __builtin_amdgcn_global_load_lds((const unsigned*)((const char*)(gbase) + (voff)[_i]), (PG8_LAS unsigned*)(lds + (bufoff) + ldsw + _i * 8192), 16, 0, 0); } while (0)
#define PG8_LDA(dst, b, h) do { _Pragma("unroll") for (int m = 0; m < 4; ++m) _Pragma("unroll") for (int k = 0; k < 2; ++k) dst[m][k] = *(const PG8_LAS bf16x8*)(lds + PG8_SA(b, h) + aoff + m * 2048 + k * 1024); } while (0)
#define PG8_LDB(dst, b, h) do { _Pragma("unroll") for (int n = 0; n < 2; ++n) _Pragma("unroll") for (int k = 0; k < 2; ++k) dst[n][k] = *(const PG8_LAS bf16x8*)(lds + PG8_SB(b, h) + boff + n * 2048 + k * 1024); } while (0)
#define PG8_MMA(ai, bj, At, Bt) do { __builtin_amdgcn_s_setprio(1); _Pragma("unroll") for (int m = 0; m < 4; ++m) _Pragma("unroll") for (int n = 0; n < 2; ++n) _Pragma("unroll") for (int k = 0; k < 2; ++k) \
        acc[ai][bj][m][n] = __builtin_amdgcn_mfma_f32_16x16x32_bf16(Bt[n][k], At[m][k], acc[ai][bj][m][n], 0, 0, 0); __builtin_amdgcn_s_setprio(0); } while (0)
#define PG8_WAIT_V(n) asm volatile("s_waitcnt vmcnt(" #n ")" ::: "memory")
#define PG8_WAIT_L(n) asm volatile("s_waitcnt lgkmcnt(" #n ")" ::: "memory")
#define PG8_BAR __builtin_amdgcn_s_barrier()
#define PG8_SCHED __builtin_amdgcn_sched_barrier(0)
    Unit cur, nxt; int ui = 0;
    if (!S.next(0, cur)) return;
    f32x4 acc[2][2][4][2];
#pragma unroll
    for (int a = 0; a < 2; ++a)
#pragma unroll
        for (int b = 0; b < 2; ++b)
#pragma unroll
            for (int m = 0; m < 4; ++m)
#pragma unroll
                for (int n = 0; n < 2; ++n) acc[a][b][m][n] = (f32x4){0.f, 0.f, 0.f, 0.f};
    bf16x8 At[4][2], B0[2][2], B1[2][2];
    const char* cA = (const char*)g.A + (size_t)cur.pm * tstep; const char* cB = (const char*)g.Bt + (size_t)cur.pn * tstep;
    S.a_ready(cur);
    if constexpr (SP2) {
        PG8_STAGE(PG8_SB(0, 0), cB, voffB); PG8_STAGE(PG8_SB(0, 1), cB + hstep, voffB); PG8_STAGE(PG8_SA(0, 0), cA, voffA); PG8_STAGE(PG8_SA(0, 1), cA + hstep, voffA);
        if (wr == 1) PG8_BAR;
        PG8_WAIT_V(2); PG8_BAR;
        PG8_STAGE(PG8_SB(1, 0), cB + kstep, voffB); PG8_STAGE(PG8_SA(1, 0), cA + kstep, voffA); PG8_STAGE(PG8_SB(1, 1), cB + hstep + kstep, voffB);
        PG8_WAIT_V(6); PG8_BAR;
    } else {
        PG8_STAGE(PG8_SB(0, 0), cB, voffB); PG8_STAGE(PG8_SA(0, 0), cA, voffA); PG8_STAGE(PG8_SB(0, 1), cB + hstep, voffB); PG8_STAGE(PG8_SA(0, 1), cA + hstep, voffA);
        if (wr == 1) PG8_BAR;
        PG8_WAIT_V(4); PG8_BAR;
        PG8_STAGE(PG8_SB(1, 0), cB + kstep, voffB); PG8_STAGE(PG8_SA(1, 0), cA + kstep, voffA); PG8_STAGE(PG8_SB(1, 1), cB + hstep + kstep, voffB);
        PG8_WAIT_V(6); PG8_BAR;
    }
    for (;;) {
        const bool has_next = S.next(ui + 1, nxt);
        const char* nA = has_next ? (const char*)g.A + (size_t)nxt.pm * tstep : cA; const char* nB = has_next ? (const char*)g.Bt + (size_t)nxt.pn * tstep : cB;
        for (int t = 0; t < nt; t += 2) {
            const bool last = (t == nt - 2);
            const char* a1 = cA + (size_t)(t + 1) * kstep;
            const char* a2 = last ? nA : cA + (size_t)(t + 2) * kstep; const char* b2 = last ? nB : cB + (size_t)(t + 2) * kstep;
            const char* a3 = a2 + kstep; const char* b3 = b2 + kstep;
            if (last && has_next) S.a_ready(nxt);
            if constexpr (SP2) {
            PG8_LDB(B0, 0, 0); PG8_LDB(B1, 0, 1); PG8_SCHED; PG8_LDA(At, 0, 0); PG8_STAGE(PG8_SA(1, 1), a1 + hstep, voffA);
            PG8_WAIT_V(8); PG8_WAIT_L(0); PG8_BAR; PG8_MMA(0, 0, At, B0); PG8_MMA(0, 1, At, B1); PG8_BAR; PG8_SCHED;
            PG8_LDA(At, 0, 1); PG8_STAGE(PG8_SB(0, 0), b2, voffB); PG8_STAGE(PG8_SB(0, 1), b2 + hstep, voffB); PG8_STAGE(PG8_SA(0, 0), a2, voffA);
            PG8_WAIT_V(8); PG8_WAIT_L(0); PG8_BAR; PG8_MMA(1, 0, At, B0); PG8_MMA(1, 1, At, B1); PG8_BAR; PG8_SCHED;
            PG8_LDB(B0, 1, 0); PG8_LDB(B1, 1, 1); PG8_SCHED; PG8_LDA(At, 1, 0); PG8_STAGE(PG8_SA(0, 1), a2 + hstep, voffA);
            PG8_WAIT_V(8); PG8_WAIT_L(0); PG8_BAR; PG8_MMA(0, 0, At, B0); PG8_MMA(0, 1, At, B1); PG8_BAR; PG8_SCHED;
            PG8_LDA(At, 1, 1); PG8_STAGE(PG8_SB(1, 0), b3, voffB); PG8_STAGE(PG8_SB(1, 1), b3 + hstep, voffB); PG8_STAGE(PG8_SA(1, 0), a3, voffA);
            PG8_WAIT_V(8); PG8_WAIT_L(0); PG8_BAR; PG8_MMA(1, 0, At, B0); PG8_MMA(1, 1, At, B1); PG8_BAR; PG8_SCHED;
            } else {
            PG8_LDB(B0, 0, 0); PG8_SCHED; PG8_LDA(At, 0, 0); PG8_STAGE(PG8_SA(1, 1), a1 + hstep, voffA);
            PG8_WAIT_L(8); PG8_BAR; PG8_WAIT_L(0); PG8_MMA(0, 0, At, B0); PG8_BAR; PG8_SCHED;
            PG8_LDB(B1, 0, 1); PG8_STAGE(PG8_SB(0, 0), b2, voffB);
            PG8_BAR; PG8_WAIT_L(0); PG8_MMA(0, 1, At, B1); PG8_BAR;
            PG8_LDA(At, 0, 1); PG8_STAGE(PG8_SA(0, 0), a2, voffA);
            PG8_BAR; PG8_WAIT_L(0); PG8_MMA(1, 0, At, B0); PG8_BAR; PG8_SCHED;
            PG8_STAGE(PG8_SB(0, 1), b2 + hstep, voffB);
            PG8_WAIT_V(6); PG8_BAR; PG8_MMA(1, 1, At, B1); PG8_BAR;
            PG8_LDB(B0, 1, 0); PG8_SCHED; PG8_LDA(At, 1, 0); PG8_STAGE(PG8_SA(0, 1), a2 + hstep, voffA);
            PG8_WAIT_L(8); PG8_BAR; PG8_WAIT_L(0); PG8_MMA(0, 0, At, B0); PG8_BAR; PG8_SCHED;
            PG8_LDB(B1, 1, 1); PG8_STAGE(PG8_SB(1, 0), b3, voffB);
            PG8_BAR; PG8_WAIT_L(0); PG8_MMA(0, 1, At, B1); PG8_BAR;
            PG8_LDA(At, 1, 1); PG8_STAGE(PG8_SA(1, 0), a3, voffA);
            PG8_BAR; PG8_WAIT_L(0); PG8_MMA(1, 0, At, B0); PG8_BAR; PG8_SCHED;
            PG8_STAGE(PG8_SB(1, 1), b3 + hstep, voffB);
            PG8_WAIT_V(6); PG8_BAR; PG8_MMA(1, 1, At, B1); PG8_BAR;
            }
        }
        if constexpr (ALIGN_EPI) { if (wr == 0) PG8_BAR; }
        if constexpr (!Epi::AFTER_DRAIN) { E(acc, cur, wr, wc, fr, fq); S.done(cur); }
        if (!has_next) break;
#pragma unroll
        for (int a = 0; a < 2; ++a)
#pragma unroll
            for (int b = 0; b < 2; ++b)
#pragma unroll
                for (int m = 0; m < 4; ++m)
#pragma unroll
                    for (int n = 0; n < 2; ++n) acc[a][b][m][n] = (f32x4){0.f, 0.f, 0.f, 0.f};
        cur = nxt; cA = nA; cB = nB; ++ui;
        if constexpr (ALIGN_EPI) { if (wr == 1) PG8_BAR; }
    }
    PG8_WAIT_V(0);
    if constexpr (!ALIGN_EPI) { if (wr == 0) PG8_BAR; }
    PG8_BAR;
    if constexpr (Epi::AFTER_DRAIN) { E.fused(acc, cur, wr, wc, fr, fq, lds, wid, lane); S.done(cur); }
#undef PG8_SA
#undef PG8_SB
#undef PG8_STAGE
#undef PG8_LDA
#undef PG8_LDB
#undef PG8_MMA
#undef PG8_WAIT_V
#undef PG8_WAIT_L
#undef PG8_BAR
#undef PG8_SCHED
}
}
#define GAS __attribute__((address_space(1)))
#define LAS __attribute__((address_space(3)))
typedef unsigned short bf16;
typedef unsigned v4u __attribute__((ext_vector_type(4)));
typedef float f32x4 __attribute__((ext_vector_type(4)));
typedef short bf16x8 __attribute__((ext_vector_type(8)));
typedef GAS unsigned gu32;
typedef GAS unsigned long long gu64;
#define RLX_AGENT __ATOMIC_RELAXED, __HIP_MEMORY_SCOPE_AGENT
#define LDS_WAIT() asm volatile("s_waitcnt lgkmcnt(0)" ::: "memory")
#define VM_WAIT() asm volatile("s_waitcnt vmcnt(0)" ::: "memory")
__device__ __forceinline__ unsigned long long rt() { return __builtin_amdgcn_s_memrealtime(); }
__device__ __forceinline__ unsigned f2bf(float f) { unsigned u = __builtin_bit_cast(unsigned, f); return (u + 0x7fffu + ((u >> 16) & 1u)) >> 16; }
__device__ __forceinline__ unsigned pk2(float lo, float hi) { return f2bf(lo) | (f2bf(hi) << 16); }

#define XB_TMO      128
#define XB_XCNT(j)  (256  + 64 * (j))
#define XB_XSUB(j)  (1280 + 64 * (j))
#define XB_XGEN(j)  (2304 + 64 * (j))
#define XB_TOP      3328
#define XB_TOPGEN   3392
#define XCD_BAR_WORDS 3456
#define XB_SPIN_CAP (1u << 22)

__device__ __forceinline__ unsigned xb_ld(unsigned* p)              { return __hip_atomic_load(p, __ATOMIC_RELAXED, __HIP_MEMORY_SCOPE_AGENT); }
__device__ __forceinline__ unsigned xb_add(unsigned* p, unsigned v) { return __hip_atomic_fetch_add(p, v, __ATOMIC_RELAXED, __HIP_MEMORY_SCOPE_AGENT); }
__device__ __forceinline__ unsigned xb_xcc_id() { return (unsigned)__builtin_amdgcn_s_getreg((3 << 11) | 20) & 0xFu; }
#define XB_SPIN(cond, bar) do { unsigned _sp = 0; while (cond) { __builtin_amdgcn_s_sleep(1); \
    if ((++_sp & 255u) == 0u) { if (xb_ld(&(bar)[XB_TMO])) break; if (_sp > XB_SPIN_CAP) { atomicAdd(&(bar)[XB_TMO], 1u); break; } } } } while (0)

struct XcdBarrier {
    unsigned* bar; unsigned x;
    volatile LAS unsigned* st;
};

__device__ __forceinline__ XcdBarrier xcd_barrier_post(unsigned* bar, volatile LAS unsigned* st) {
    XcdBarrier b; b.bar = bar; b.x = xb_xcc_id(); b.st = st;
    if (threadIdx.x == 0) (void)xb_add(&bar[XB_XCNT(b.x)], 1u);
    return b;
}
__device__ __forceinline__ void xcd_barrier_complete(unsigned* bar, unsigned x, unsigned& nloc, unsigned& nx) {
    const unsigned G = gridDim.x * gridDim.y * gridDim.z;
    unsigned sum, cnt, mine, sp = 0u;
    for (;;) {
        sum = 0u; cnt = 0u; mine = 0u;
#pragma unroll
        for (unsigned j = 0; j < 16; ++j) { const unsigned c = xb_ld(&bar[XB_XCNT(j)]); sum += c; cnt += (c > 0u) ? 1u : 0u; mine = (j == x) ? c : mine; }
        if (sum == G) break;
        __builtin_amdgcn_s_sleep(1);
        if ((++sp & 255u) == 0u) { if (xb_ld(&bar[XB_TMO])) break; if (sp > XB_SPIN_CAP) { atomicAdd(&bar[XB_TMO], 1u); break; } }
    }
    nloc = mine > 0u ? mine : 1u; nx = cnt > 0u ? cnt : 1u;
}

__device__ __forceinline__ void xcd_barrier(const XcdBarrier& b) {
    asm volatile("s_waitcnt vmcnt(0)" ::: "memory");
    __syncthreads();
    if (threadIdx.x == 0) {
        unsigned* bar = b.bar;
        __builtin_amdgcn_s_waitcnt(0);
        unsigned nloc = b.st[0], nx = b.st[1];
        if (nloc == 0u) { xcd_barrier_complete(bar, b.x, nloc, nx); b.st[0] = nloc; b.st[1] = nx; }
        const unsigned old = xb_add(&bar[XB_XSUB(b.x)], 1u);
        const unsigned gen = old / nloc;
        if (old + 1u == (gen + 1u) * nloc) {
            __builtin_amdgcn_fence(__ATOMIC_RELEASE, "agent");
            asm volatile("s_waitcnt vmcnt(0)" ::: "memory");
            const unsigned og = xb_add(&bar[XB_TOP], 1u);
            const unsigned tg = og / nx;
            if (og + 1u == (tg + 1u) * nx) xb_add(&bar[XB_TOPGEN], 1u);
            else XB_SPIN(xb_ld(&bar[XB_TOPGEN]) == tg, bar);
            __builtin_amdgcn_fence(__ATOMIC_ACQUIRE, "agent");
            xb_add(&bar[XB_XGEN(b.x)], 1u);
            asm volatile("s_waitcnt vmcnt(0)" ::: "memory");
        } else {
            XB_SPIN(xb_ld(&bar[XB_XGEN(b.x)]) == gen, bar);
            __builtin_amdgcn_fence(__ATOMIC_ACQUIRE, "agent");
            asm volatile("s_waitcnt vmcnt(0)" ::: "memory");
        }
    }
    __syncthreads();
}
constexpr int NWAVES = 8;
constexpr int BATCH = 16, SEQ = 2048, DM = 1024, MTOK = BATCH * SEQ;
constexpr int EVEN_IN = 3584, ODD_IN = 3072;
constexpr int E_RQ = 0, E_RK = 256, E_RV = 512, E_RG = 1024, E_SQ = 1536, E_SK = 2048, E_SV = 2560, E_SG = 3072;
constexpr int O_HQ = 0, O_HF = 512, O_HI = 1024, O_HG = 1536, O_LX = 2048, O_LG = 2560;
constexpr float EPS = 1e-6f;
constexpr size_t MiB = 1u << 20;
constexpr size_t WS_CTL = 0, CTL_ZERO_BYTES = 1 * MiB;
constexpr size_t WS_WIN0 = 2 * MiB, WS_WIN1 = 9 * MiB, WS_WIN2 = 15 * MiB, WS_WIN3 = 22 * MiB;
constexpr size_t WS_WOUT = 28 * MiB;
constexpr size_t WS_TAB = 36 * MiB;
constexpr size_t WS_LB = 36 * MiB + 768 * 1024;
constexpr size_t WS_XN = 40 * MiB;
constexpr size_t WS_MIX = 104 * MiB;
constexpr size_t WS_PROJ = 168 * MiB;
constexpr size_t WS_VT0 = 392 * MiB, WS_VT1 = 424 * MiB;
constexpr size_t WS_KST = 456 * MiB;
constexpr size_t WS_END = 488 * MiB;
constexpr int CW_BAR = 4096;
constexpr int RING_BYTES = 131072;
constexpr int LDS_BYTES = 147456;
constexpr int LDSCTL_OFF = LDS_BYTES - 512;
constexpr int XTRA_OFF = RING_BYTES;
__device__ __forceinline__ float bf2f(bf16 u) { return __uint_as_float((unsigned)u << 16); }
__device__ __forceinline__ float wave_sum(float v) {
#pragma unroll
    for (int o = 1; o < 64; o <<= 1) v += __shfl_xor(v, o);
    return v;
}
__device__ __forceinline__ float sigmoidf_(float x) { return 1.f / (1.f + __expf(-x)); }
__device__ __forceinline__ float siluf_(float x) { return x * __builtin_amdgcn_rcpf(1.f + __expf(-x)); }
__device__ __forceinline__ float log_sigmoidf_(float z) { return fminf(z, 0.f) - log1pf(__expf(-fabsf(z))); }

#ifndef TSCALE
#define TSCALE 0
#endif
#define TWORD(C) ((volatile LAS unsigned*)((C).lds + LDSCTL_OFF) + 16)
#define TIC(C, sel) long long tic_##sel = 0; if (TSCALE && TSEL == sel && blockIdx.x == 0 && (C).wave == 0) tic_##sel = (long long)__builtin_amdgcn_s_memrealtime()
#define TOC(C, sel) do { if (TSCALE && TSEL == sel && blockIdx.x == 0 && (C).wave == 0) { const unsigned d_ = (unsigned)((long long)__builtin_amdgcn_s_memrealtime() - tic_##sel); if ((C).lane == 0) *TWORD(C) = *TWORD(C) + d_; } } while (0)
#ifndef TSEL
#define TSEL 0
#endif
struct Ctx {
    LAS unsigned char* lds;
    int tid, lane, wave, vcu, G;
    GAS unsigned char* ws;
};
struct Params { const float* in[15]; float* out; unsigned char* ws; };
__device__ __forceinline__ const float* IN(int i) { return (const float*)(const GAS float*)(((const __attribute__((address_space(4))) Params*)__builtin_amdgcn_kernarg_segment_ptr())->in[i]); }
__device__ __forceinline__ float* OUTP() { return (float*)(GAS float*)(((const __attribute__((address_space(4))) Params*)__builtin_amdgcn_kernarg_segment_ptr())->out); }
#define C_XN   ((bf16*)(C.ws + WS_XN))
#define C_MIX  ((bf16*)(C.ws + WS_MIX))
#define C_OI   ((bf16*)(C.ws + WS_XN + 32 * MiB))
#define C_PROJ ((bf16*)(C.ws + WS_PROJ))
#define C_VT0  ((bf16*)(C.ws + WS_VT0))
#define C_VT1  ((bf16*)(C.ws + WS_VT1))
#define C_KST  ((bf16*)(C.ws + WS_KST))
#define C_TABC ((const float*)(C.ws + WS_TAB))
#define C_TABS ((const float*)(C.ws + WS_TAB) + SEQ * 32)
#define C_LB   ((const float*)(C.ws + WS_LB))

__device__ __forceinline__ void p0_transpose_item(const float* W, int K, int N, bf16* WT, LAS float* scr, int item, int lane) {
    const int nblk = N / 32, kb = item / nblk, nb = item % nblk, k0 = 64 * kb, n0 = 32 * nb;
#pragma unroll 8
    for (int i = 0; i < 32; ++i) { const int kk = 2 * i + (lane >> 5); scr[kk * 33 + (lane & 31)] = W[(size_t)(k0 + kk) * N + n0 + (lane & 31)]; }
    LDS_WAIT(); asm volatile("" ::: "memory");
    const int c = lane & 7;
#pragma unroll
    for (int j = 0; j < 4; ++j) { const int n = (lane >> 3) + 8 * j; const LAS float* s = scr + (8 * c) * 33 + n;
        v4u o; o.x = pk2(s[0 * 33], s[1 * 33]); o.y = pk2(s[2 * 33], s[3 * 33]); o.z = pk2(s[4 * 33], s[5 * 33]); o.w = pk2(s[6 * 33], s[7 * 33]);
        *(GAS v4u*)(WT + (size_t)(n0 + n) * K + k0 + 8 * c) = o; }
    LDS_WAIT(); asm volatile("" ::: "memory");
}
__device__ __forceinline__ void rms_row_to_bf16(const float* xrow, const float* w, bf16* orow, int lane) {
    const GAS f32x4* xr = (const GAS f32x4*)xrow + lane; const GAS f32x4* wr = (const GAS f32x4*)w + lane;
    f32x4 v[4]; float s = 0.f;
#pragma unroll
    for (int j = 0; j < 4; ++j) { v[j] = xr[64 * j]; s += (v[j].x * v[j].x + v[j].y * v[j].y) + (v[j].z * v[j].z + v[j].w * v[j].w); }
    const float rstd = rsqrtf(wave_sum(s) * (1.f / DM) + EPS);
    GAS unsigned long long* o8 = (GAS unsigned long long*)orow + lane;
#pragma unroll
    for (int j = 0; j < 4; ++j) { const f32x4 g = wr[64 * j];
        o8[64 * j] = (unsigned long long)pk2(v[j].x * rstd * g.x, v[j].y * rstd * g.y) | ((unsigned long long)pk2(v[j].z * rstd * g.z, v[j].w * rstd * g.w) << 32); }
}
__device__ __forceinline__ void p0_prologue(Ctx& C) {
    LAS float* scr = (LAS float*)(C.lds + C.wave * 16384);
    const int gw = C.vcu * NWAVES + C.wave, NGW = C.G * NWAVES;
    constexpr int I_E = (DM / 64) * (EVEN_IN / 32), I_O = (DM / 64) * (ODD_IN / 32), I_W = (DM / 64) * (DM / 32);
    constexpr int NITEMS = 2 * I_E + 2 * I_O + 4 * I_W;
    for (int it = gw; it < NITEMS; it += NGW) {
        int r = it;
        if (r < 2 * I_E) { const int e = r / I_E; p0_transpose_item(IN(3) + (size_t)e * DM * EVEN_IN, DM, EVEN_IN, (bf16*)(C.ws + (e ? WS_WIN2 : WS_WIN0)), scr, r % I_E, C.lane); continue; } r -= 2 * I_E;
        if (r < 2 * I_O) { const int o = r / I_O; p0_transpose_item(IN(5) + (size_t)o * DM * ODD_IN, DM, ODD_IN, (bf16*)(C.ws + (o ? WS_WIN3 : WS_WIN1)), scr, r % I_O, C.lane); continue; } r -= 2 * I_O;
        { const int l = r / I_W; const float* src = (l & 1) ? IN(6) + (size_t)(l >> 1) * DM * DM : IN(4) + (size_t)(l >> 1) * DM * DM;
          p0_transpose_item(src, DM, DM, (bf16*)(C.ws + WS_WOUT + (size_t)l * 2 * MiB), scr, r % I_W, C.lane); }
    }
    for (int m = gw; m < MTOK; m += NGW) rms_row_to_bf16(IN(0) + (size_t)m * DM, IN(1), C_XN + (size_t)m * DM, C.lane);
    float* tc = (float*)(C.ws + WS_TAB); float* ts = tc + SEQ * 32;
    for (int e = C.vcu * 512 + C.tid; e < SEQ * 32; e += C.G * 512) {
        const int t = e >> 5, i = e & 31;
        const float inv = powf(10000.0f, -(float)i / 32.0f);
        const float ang = (float)t * inv;
        double r = (double)ang * 0.15915494309189533577; r -= floor(r);
        const float rev = (float)r;
        tc[e] = __builtin_amdgcn_cosf(rev); ts[e] = __builtin_amdgcn_sinf(rev);
    }
    float* lbp = (float*)(C.ws + WS_LB);
    if (C.vcu == 0) for (int c = C.tid; c < 512; c += 512) { const float l0 = IN(7)[c], l1 = IN(7)[512 + c]; lbp[c] = 0.f; lbp[512 + c] = 1.f / (1.f + expf(l0 - l1)); }
}

__device__ __forceinline__ void norm_rows_phase(Ctx& C, const bf16* Y, const float* xsrc, const float* wpost, const float* wpre_next) {
    const int gw = C.vcu * NWAVES + C.wave, NGW = C.G * NWAVES;
    for (int m = gw; m < MTOK; m += NGW) {
        const GAS unsigned long long* yr = (const GAS unsigned long long*)(Y + (size_t)m * DM) + C.lane;
        const GAS f32x4* xr = (const GAS f32x4*)(xsrc + (size_t)m * DM) + C.lane;
        GAS f32x4* xo = (GAS f32x4*)(OUTP() + (size_t)m * DM) + C.lane;
        f32x4 y[4], x[4]; float s = 0.f;
#pragma unroll
        for (int j = 0; j < 4; ++j) { const unsigned long long w = yr[64 * j]; x[j] = xr[64 * j];
            y[j].x = __uint_as_float(((unsigned)w) << 16); y[j].y = __uint_as_float(((unsigned)w) & 0xffff0000u);
            y[j].z = __uint_as_float(((unsigned)(w >> 32)) << 16); y[j].w = __uint_as_float(((unsigned)(w >> 32)) & 0xffff0000u);
            s += (y[j].x * y[j].x + y[j].y * y[j].y) + (y[j].z * y[j].z + y[j].w * y[j].w); }
        const float rstd = rsqrtf(wave_sum(s) * (1.f / DM) + EPS); float s2 = 0.f;
#pragma unroll
        for (int j = 0; j < 4; ++j) { const f32x4 g = ((const GAS f32x4*)wpost + C.lane)[64 * j];
            x[j].x += y[j].x * rstd * g.x; x[j].y += y[j].y * rstd * g.y; x[j].z += y[j].z * rstd * g.z; x[j].w += y[j].w * rstd * g.w;
            xo[64 * j] = x[j];
            s2 += (x[j].x * x[j].x + x[j].y * x[j].y) + (x[j].z * x[j].z + x[j].w * x[j].w); }
        if (wpre_next) {
            const float r2 = rsqrtf(wave_sum(s2) * (1.f / DM) + EPS);
            GAS unsigned long long* o8 = (GAS unsigned long long*)(C_XN + (size_t)m * DM) + C.lane;
#pragma unroll
            for (int j = 0; j < 4; ++j) { const f32x4 g = ((const GAS f32x4*)wpre_next + C.lane)[64 * j];
                o8[64 * j] = (unsigned long long)pk2(x[j].x * r2 * g.x, x[j].y * r2 * g.y) | ((unsigned long long)pk2(x[j].z * r2 * g.z, x[j].w * r2 * g.w) << 32); }
        }
    }
}

__device__ __forceinline__ void unpack8(const v4u w, float* f) {
    f[0] = __uint_as_float(w.x << 16); f[1] = __uint_as_float(w.x & 0xffff0000u); f[2] = __uint_as_float(w.y << 16); f[3] = __uint_as_float(w.y & 0xffff0000u);
    f[4] = __uint_as_float(w.z << 16); f[5] = __uint_as_float(w.z & 0xffff0000u); f[6] = __uint_as_float(w.w << 16); f[7] = __uint_as_float(w.w & 0xffff0000u);
}
__device__ __forceinline__ void naive_ret_token(Ctx& C, int b, int h, int t) {
    const int lane = C.lane; const size_t rs = EVEN_IN;
    const bf16* P = C_PROJ; const size_t m = (size_t)b * SEQ + t;
    float qa[32], qb[32];
    {
        float q[64];
#pragma unroll
        for (int c = 0; c < 8; ++c) unpack8(*(const GAS v4u*)(P + m * rs + E_RQ + h * 64 + 8 * c), q + 8 * c);
#pragma unroll
        for (int i = 0; i < 32; ++i) { const float cs = C_TABC[t * 32 + i], sn = C_TABS[t * 32 + i]; qa[i] = q[i] * cs - q[32 + i] * sn; qb[i] = q[i] * sn + q[32 + i] * cs; }
    }
    const float lg2 = log2f(1.0f - exp2f(-5.0f - (float)h));
    float o0 = 0.f, o1 = 0.f;
    for (int shi = t; shi >= 0; shi -= 64) {
        const int s = shi - lane; const bool valid = s >= 0; const int sc = valid ? s : 0;
        const size_t ms = (size_t)b * SEQ + sc;
        float k[64];
#pragma unroll
        for (int c = 0; c < 8; ++c) unpack8(*(const GAS v4u*)(P + ms * rs + E_RK + h * 64 + 8 * c), k + 8 * c);
        float acc = 0.f;
#pragma unroll
        for (int i = 0; i < 32; ++i) { const float cs = C_TABC[sc * 32 + i], sn = C_TABS[sc * 32 + i];
            acc += qa[i] * (k[i] * cs - k[32 + i] * sn) + qb[i] * (k[i] * sn + k[32 + i] * cs); }
        const float w = valid ? acc * 0.125f * exp2f((float)(t - s) * lg2) : 0.f;
#pragma unroll 8
        for (int j = 0; j < 64; ++j) { const float wj = __shfl(w, j); const int sj = shi - j; const size_t mj = (size_t)b * SEQ + (sj >= 0 ? sj : 0);
            o0 += wj * bf2f(P[mj * rs + E_RV + h * 128 + lane]); o1 += wj * bf2f(P[mj * rs + E_RV + h * 128 + 64 + lane]); }
    }
    const float rstd = rsqrtf(wave_sum(o0 * o0 + o1 * o1) * (1.f / 128.f) + EPS);
    const float g0 = bf2f(P[m * rs + E_RG + h * 128 + lane]), g1 = bf2f(P[m * rs + E_RG + h * 128 + 64 + lane]);
    C_MIX[m * DM + h * 128 + lane] = (bf16)f2bf(o0 * rstd * siluf_(g0)); C_MIX[m * DM + h * 128 + 64 + lane] = (bf16)f2bf(o1 * rstd * siluf_(g1));
}
template <bool EARLY> __device__ __forceinline__ void naive_sb_token(Ctx& C, int b, int hh, int t) {
    const int lane = C.lane; const size_t rs = EVEN_IN; const bf16* P = C_PROJ; const size_t m = (size_t)b * SEQ + t;
    float q[64];
#pragma unroll
    for (int c = 0; c < 8; ++c) unpack8(*(const GAS v4u*)(P + m * rs + E_SQ + hh * 64 + 8 * c), q + 8 * c);
    float R = 0.f, o = 0.f;
    for (int shi = t - 1; shi >= 0; shi -= 64) {
        const int s = shi - lane; const bool valid = s >= 0; const size_t ms = (size_t)b * SEQ + (valid ? s : 0);
        float acc = 0.f;
#pragma unroll
        for (int c = 0; c < 8; ++c) { float k[8]; unpack8(*(const GAS v4u*)(P + ms * rs + E_SK + hh * 64 + 8 * c), k);
#pragma unroll
            for (int j = 0; j < 8; ++j) acc += q[8 * c + j] * k[j]; }
        const float z = acc * 0.125f, lb = log_sigmoidf_(z), lom = valid ? lb - z : 0.f;
        float incl = lom;
#pragma unroll
        for (int off = 1; off < 64; off <<= 1) { const float tmp = __shfl_up(incl, off); if (lane >= off) incl += tmp; }
        const float w = valid ? __expf(lb + R + (incl - lom)) : 0.f;
        R += __shfl(incl, 63);
#pragma unroll 8
        for (int j = 0; j < 64; ++j) { const float wj = __shfl(w, j); const int sj = shi - j; const size_t mj = (size_t)b * SEQ + (sj >= 0 ? sj : 0);
            o += wj * bf2f(P[mj * rs + E_SV + hh * 64 + lane]); }
        if (EARLY && R < -100.f) break;
    }
    const float g = bf2f(P[m * rs + E_SG + hh * 64 + lane]);
    C_MIX[m * DM + 512 + hh * 64 + lane] = (bf16)f2bf(o * siluf_(g));
}
__device__ __forceinline__ void naive_even_mixer(Ctx& C) {
    constexpr int NRET = BATCH * 4 * 256, NSB = BATCH * 8 * 256;
    for (int u = C.vcu; u < NRET + NSB; u += C.G) {
        if (u < NRET) { const int bh = u >> 8, tb = (u + bh) & 255; naive_ret_token(C, bh >> 2, bh & 3, tb * 8 + C.wave); }
        else { const int v = u - NRET, bh = v >> 8, tb = (v + bh) & 255; naive_sb_token<false>(C, bh >> 3, bh & 7, tb * 8 + C.wave); }
    }
}
__device__ __forceinline__ void naive_hgrn_unit(Ctx& C, int b, int h, int vs, int o, float* OS) {
    const int tid = C.tid, lane = C.lane, k = tid >> 2, vq = tid & 3; const size_t rs = ODD_IN; const bf16* P = C_PROJ;
    LAS float* red = (LAS float*)C.lds;
    const float lb = C_LB[o * 512 + h * 128 + k];
    float st[8];
#pragma unroll
    for (int j = 0; j < 8; ++j) st[j] = 0.f;
    for (int t0 = 0; t0 < SEQ; t0 += 4) {
        float flv[4], qv[4]; v4u vvv[4];
#pragma unroll
        for (int u = 0; u < 4; ++u) { const size_t m = (size_t)b * SEQ + t0 + u; flv[u] = bf2f(P[m * rs + O_HF + h * 128 + k]); qv[u] = bf2f(P[m * rs + O_HQ + h * 128 + k]);
            vvv[u] = *(const GAS v4u*)(P + m * rs + O_HI + h * 128 + vs * 32 + vq * 8); }
#pragma unroll
        for (int u = 0; u < 4; ++u) {
            const int t = t0 + u; const size_t m = (size_t)b * SEQ + t;
            const float fl = flv[u], q = qv[u];
            const float sig = 1.f / (1.f + __expf(-fl)), f = lb + (1.f - lb) * sig, kk = (1.f - lb) / (1.f + __expf(fl));
            float v[8]; unpack8(vvv[u], v);
            float part[8];
#pragma unroll
            for (int j = 0; j < 8; ++j) { st[j] = f * st[j] + kk * v[j]; part[j] = q * st[j]; }
#pragma unroll
            for (int j = 0; j < 8; ++j) { part[j] += __shfl_xor(part[j], 4); part[j] += __shfl_xor(part[j], 8); part[j] += __shfl_xor(part[j], 16); part[j] += __shfl_xor(part[j], 32); }
            LAS float* rb = red + (t & 1) * 256;
            if (lane < 4) {
#pragma unroll
                for (int j = 0; j < 8; ++j) rb[C.wave * 32 + vq * 8 + j] = part[j];
            }
            __syncthreads();
            if (tid < 32) { float s = 0.f;
#pragma unroll
                for (int w = 0; w < 8; ++w) s += rb[w * 32 + tid];
                OS[m * 512 + h * 128 + vs * 32 + tid] = s; }
        }
    }
    __syncthreads();
}
__device__ __forceinline__ void naive_lru_unit(Ctx& C, int b, int n, int o) {
    const int lane = C.lane, wave = C.wave; const size_t rs = ODD_IN; const bf16* P = C_PROJ;
    LAS float* AU = (LAS float*)C.lds;
    LAS float* xb = (LAS float*)(C.lds + XTRA_OFF) + wave * 64;
    const int ch = n * 64 + lane;
    const float* cw = IN(8) + (size_t)o * 4 * 512; const float cb = IN(9)[o * 512 + ch];
    const float w0 = cw[0 * 512 + ch], w1 = cw[1 * 512 + ch], w2 = cw[2 * 512 + ch], w3 = cw[3 * 512 + ch];
    const float* Wa = IN(10) + ((size_t)o * 8 + n) * 4096; const float* Wx = IN(12) + ((size_t)o * 8 + n) * 4096;
    const float ba = IN(11)[o * 512 + ch], bx = IN(13)[o * 512 + ch], lam = IN(14)[o * 512 + ch];
    const float sp = log1pf(expf(-lam));
    float hst = 0.f;
    for (int c = 0; c < 8; ++c) {
        for (int tt = wave * 32; tt < wave * 32 + 32; ++tt) {
            const int t = c * 256 + tt; const size_t m = (size_t)b * SEQ + t;
            float xc = cb + w3 * bf2f(P[m * rs + O_LX + ch]);
            if (t >= 1) xc += w2 * bf2f(P[(m - 1) * rs + O_LX + ch]);
            if (t >= 2) xc += w1 * bf2f(P[(m - 2) * rs + O_LX + ch]);
            if (t >= 3) xc += w0 * bf2f(P[(m - 3) * rs + O_LX + ch]);
            xb[lane] = xc; LDS_WAIT(); asm volatile("" ::: "memory");
            float ra = ba, rx = bx;
            for (int i = 0; i < 64; ++i) { const float xi = xb[i]; ra += xi * Wa[i * 64 + lane]; rx += xi * Wx[i * 64 + lane]; }
            LDS_WAIT(); asm volatile("" ::: "memory");
            const float r = sigmoidf_(ra), ig = sigmoidf_(rx);
            const float la = -8.0f * r * sp, a = __expf(la);
            const float mult = (t == 0) ? 1.0f : sqrtf(-expm1f(2.0f * la));
            AU[(tt * 64 + lane) * 2] = a; AU[(tt * 64 + lane) * 2 + 1] = mult * ig * xc;
        }
        __syncthreads();
        if (wave == 0) {
            for (int tt = 0; tt < 256; ++tt) { const size_t m = (size_t)b * SEQ + c * 256 + tt;
                hst = AU[(tt * 64 + lane) * 2] * hst + AU[(tt * 64 + lane) * 2 + 1];
                const float g = bf2f(P[m * rs + O_LG + ch]);
                C_MIX[m * DM + 512 + ch] = (bf16)f2bf(hst * siluf_(g)); }
        }
        __syncthreads();
    }
}
__device__ __forceinline__ void naive_odd_mixer1(Ctx& C, int o) {
    float* OS = (float*)(C.ws + WS_XN);
    for (int u = C.vcu; u < 256 + 128; u += C.G) {
        if (u < 256) naive_hgrn_unit(C, u >> 4, (u >> 2) & 3, u & 3, o, OS);
        else naive_lru_unit(C, (u - 256) >> 3, (u - 256) & 7, o);
    }
}
__device__ __forceinline__ void naive_odd_mixer2(Ctx& C) {
    const float* OS = (const float*)(C.ws + WS_XN); const bf16* P = C_PROJ; const size_t rs = ODD_IN;
    const int gw = C.vcu * NWAVES + C.wave, NGW = C.G * NWAVES;
    for (int it = gw; it < MTOK * 4; it += NGW) { const size_t m = it >> 2; const int h = it & 3;
        const float o0 = OS[m * 512 + h * 128 + C.lane], o1 = OS[m * 512 + h * 128 + 64 + C.lane];
        const float rstd = rsqrtf(wave_sum(o0 * o0 + o1 * o1) * (1.f / 128.f) + EPS);
        const float g0 = bf2f(P[m * rs + O_HG + h * 128 + C.lane]), g1 = bf2f(P[m * rs + O_HG + h * 128 + 64 + C.lane]);
        C_MIX[m * DM + h * 128 + C.lane] = (bf16)f2bf(o0 * rstd * siluf_(g0)); C_MIX[m * DM + h * 128 + 64 + C.lane] = (bf16)f2bf(o1 * rstd * siluf_(g1)); }
}
#ifndef REP_RET
#define REP_RET 1
#endif
#ifndef REP_HG1
#define REP_HG1 1
#endif
#ifndef REP_HG2
#define REP_HG2 1
#endif
#ifndef REP_LRU
#define REP_LRU 1
#endif
typedef float f32x16 __attribute__((ext_vector_type(16)));
typedef short s16x4 __attribute__((ext_vector_type(4)));
typedef __bf16 bf16x2_t __attribute__((ext_vector_type(2)));
typedef float f32x2_t __attribute__((ext_vector_type(2)));
typedef unsigned u32x2 __attribute__((ext_vector_type(2)));
#define MFMA32(a, b, c) __builtin_amdgcn_mfma_f32_32x32x16_bf16((a), (b), (c), 0, 0, 0)
#define MFMA16(a, b, c) __builtin_amdgcn_mfma_f32_16x16x32_bf16((a), (b), (c), 0, 0, 0)
__device__ __forceinline__ unsigned pkbf(float lo, float hi) { const f32x2_t v = {lo, hi}; return __builtin_bit_cast(unsigned, __builtin_convertvector(v, bf16x2_t)); }
__device__ __forceinline__ bf16x8 pack8(float a0, float a1, float a2, float a3, float a4, float a5, float a6, float a7) {
    v4u p; p.x = pkbf(a0, a1); p.y = pkbf(a2, a3); p.z = pkbf(a4, a5); p.w = pkbf(a6, a7); return __builtin_bit_cast(bf16x8, p); }
__device__ __forceinline__ bf16x8 cat4(s16x4 lo, s16x4 hi) { return __builtin_shufflevector(lo, hi, 0, 1, 2, 3, 4, 5, 6, 7); }
__device__ __forceinline__ int crow32(int i, int h) { return (i & 3) + 8 * (i >> 2) + 4 * h; }
__device__ __forceinline__ float fast_log_sigmoid(float z) { return fminf(z, 0.f) - __logf(1.f + __expf(-fabsf(z))); }

__device__ __forceinline__ void sb_wave_unit(Ctx& C, int b, int hh, int qblk) {
    const int lane = C.lane, r = lane & 31, h = lane >> 5;
    const bf16* P = C_PROJ; const size_t rs = EVEN_IN;
    const int t0 = qblk * 32; const size_t m0 = (size_t)b * SEQ + t0;
    bf16x8 qf[4];
#pragma unroll
    for (int ks = 0; ks < 4; ++ks) qf[ks] = *(const GAS bf16x8*)(P + (m0 + r) * rs + E_SQ + hh * 64 + 16 * ks + 8 * h);
    bf16x8 tri[2];
#pragma unroll
    for (int st = 0; st < 2; ++st)
#pragma unroll
        for (int j = 0; j < 8; ++j) { const int k = 16 * st + 8 * (j >> 2) + 4 * h + (j & 3); tri[st][j] = (k > r) ? (short)0x3F80 : (short)0; }
    f32x16 o0, o1;
#pragma unroll
    for (int i = 0; i < 16; ++i) { o0[i] = 0.f; o1[i] = 0.f; }
    float R = 0.f;
    const bf16* vt = C_VT1 + ((size_t)(b * 512 + hh * 64 + r)) * 2048;
    for (int s0 = t0; s0 >= 0; s0 -= 32) {
        const bf16* kp = P + ((size_t)b * SEQ + s0 + r) * rs + E_SK + hh * 64 + 8 * h;
        bf16x8 kf[4];
#pragma unroll
        for (int ks = 0; ks < 4; ++ks) kf[ks] = *(const GAS bf16x8*)(kp + 16 * ks);
        s16x4 va[2][2][2];
#pragma unroll
        for (int mt = 0; mt < 2; ++mt)
#pragma unroll
            for (int st = 0; st < 2; ++st)
#pragma unroll
                for (int hf = 0; hf < 2; ++hf) va[mt][st][hf] = *(const GAS s16x4*)(vt + (size_t)mt * 32 * 2048 + s0 + 16 * st + 8 * hf + 4 * h);
        f32x16 x;
#pragma unroll
        for (int i = 0; i < 16; ++i) x[i] = 0.f;
#pragma unroll
        for (int ks = 0; ks < 4; ++ks) x = MFMA32(kf[ks], qf[ks], x);
        const bool diag = (s0 == t0);
        float lom[16], lbv[16];
#pragma unroll
        for (int i = 0; i < 16; ++i) { const float z = x[i] * 0.125f, lb = fast_log_sigmoid(z); const bool valid = !diag || (crow32(i, h) < r);
            lom[i] = valid ? lb - z : 0.f; lbv[i] = valid ? lb : -1e30f; }
        const bf16x8 lf0 = pack8(lom[0], lom[1], lom[2], lom[3], lom[4], lom[5], lom[6], lom[7]);
        const bf16x8 lf1 = pack8(lom[8], lom[9], lom[10], lom[11], lom[12], lom[13], lom[14], lom[15]);
        f32x16 y;
#pragma unroll
        for (int i = 0; i < 16; ++i) y[i] = 0.f;
        y = MFMA32(tri[0], lf0, y); y = MFMA32(tri[1], lf1, y);
        const float tot = __shfl(y[0] + lom[0], r);
        float w[16];
#pragma unroll
        for (int i = 0; i < 16; ++i) w[i] = __expf(lbv[i] + y[i] + R);
        R += tot;
        const bf16x8 wf0 = pack8(w[0], w[1], w[2], w[3], w[4], w[5], w[6], w[7]);
        const bf16x8 wf1 = pack8(w[8], w[9], w[10], w[11], w[12], w[13], w[14], w[15]);
        o0 = MFMA32(cat4(va[0][0][0], va[0][0][1]), wf0, o0); o0 = MFMA32(cat4(va[0][1][0], va[0][1][1]), wf1, o0);
        o1 = MFMA32(cat4(va[1][0][0], va[1][0][1]), wf0, o1); o1 = MFMA32(cat4(va[1][1][0], va[1][1][1]), wf1, o1);
        if (__all(R < -100.f)) break;
    }
    const bf16* gp = P + (m0 + r) * rs + E_SG + hh * 64 + 4 * h;
    bf16* op = C_MIX + (m0 + r) * DM + 512 + hh * 64 + 4 * h;
#pragma unroll
    for (int mt = 0; mt < 2; ++mt)
#pragma unroll
        for (int q4 = 0; q4 < 4; ++q4) {
            const u32x2 gv = *(const GAS u32x2*)(gp + 32 * mt + 8 * q4);
            const float g0 = __uint_as_float(gv.x << 16), g1 = __uint_as_float(gv.x & 0xffff0000u), g2 = __uint_as_float(gv.y << 16), g3 = __uint_as_float(gv.y & 0xffff0000u);
            const float a0 = mt ? o1[4 * q4 + 0] : o0[4 * q4 + 0], a1 = mt ? o1[4 * q4 + 1] : o0[4 * q4 + 1], a2 = mt ? o1[4 * q4 + 2] : o0[4 * q4 + 2], a3 = mt ? o1[4 * q4 + 3] : o0[4 * q4 + 3];
            u32x2 ov; ov.x = pkbf(a0 * siluf_(g0), a1 * siluf_(g1)); ov.y = pkbf(a2 * siluf_(g2), a3 * siluf_(g3));
            *(GAS u32x2*)(op + 32 * mt + 8 * q4) = ov;
        }
}

constexpr int RT_Q = 0, RT_K = 18432, RT_KT = 36864, RT_V = 54272, RT_S = 89088;
__device__ __forceinline__ void ret_unit(Ctx& C, int b, int h) {
    const int tid = C.tid, lane = C.lane, w = C.wave, fr = lane & 15, g = lane >> 4;
    LAS unsigned char* L = C.lds;
    const bf16* P = C_PROJ; const size_t rs = EVEN_IN;
    const float lg2 = log2f(1.0f - exp2f(-5.0f - (float)h));
    const float gC = exp2f(128.0f * lg2);
    f32x4 st[4];
#pragma unroll
    for (int nt = 0; nt < 4; ++nt) st[nt] = (f32x4){0.f, 0.f, 0.f, 0.f};
    for (int i = tid; i < 18432 / 4; i += 512) ((LAS unsigned*)(L + RT_S))[i] = 0u;
    for (int c = 0; c < 16; ++c) {
        {
            const int tt = tid >> 2, part = tid & 3, t = 128 * c + tt; const size_t m = (size_t)b * SEQ + t;
            float qa[8], qb[8], ka[8], kb[8], cs[8], sn[8];
            unpack8(*(const GAS v4u*)(P + m * rs + E_RQ + h * 64 + 8 * part), qa); unpack8(*(const GAS v4u*)(P + m * rs + E_RQ + h * 64 + 32 + 8 * part), qb);
            unpack8(*(const GAS v4u*)(P + m * rs + E_RK + h * 64 + 8 * part), ka); unpack8(*(const GAS v4u*)(P + m * rs + E_RK + h * 64 + 32 + 8 * part), kb);
            { const f32x4 c0 = *(const GAS f32x4*)(C_TABC + t * 32 + 8 * part), c1 = *(const GAS f32x4*)(C_TABC + t * 32 + 8 * part + 4);
              const f32x4 s0 = *(const GAS f32x4*)(C_TABS + t * 32 + 8 * part), s1 = *(const GAS f32x4*)(C_TABS + t * 32 + 8 * part + 4);
              cs[0] = c0.x; cs[1] = c0.y; cs[2] = c0.z; cs[3] = c0.w; cs[4] = c1.x; cs[5] = c1.y; cs[6] = c1.z; cs[7] = c1.w;
              sn[0] = s0.x; sn[1] = s0.y; sn[2] = s0.z; sn[3] = s0.w; sn[4] = s1.x; sn[5] = s1.y; sn[6] = s1.z; sn[7] = s1.w; }
            const float fq = exp2f((float)tt * lg2), fk = 0.125f * exp2f(-(float)tt * lg2);
            float q1[8], q2[8], k1[8], k2[8];
#pragma unroll
            for (int j = 0; j < 8; ++j) { q1[j] = (qa[j] * cs[j] - qb[j] * sn[j]) * fq; q2[j] = (qa[j] * sn[j] + qb[j] * cs[j]) * fq;
                                          k1[j] = (ka[j] * cs[j] - kb[j] * sn[j]) * fk; k2[j] = (ka[j] * sn[j] + kb[j] * cs[j]) * fk; }
            *(LAS bf16x8*)(L + RT_Q + tt * 144 + 16 * part) = pack8(q1[0], q1[1], q1[2], q1[3], q1[4], q1[5], q1[6], q1[7]);
            *(LAS bf16x8*)(L + RT_Q + tt * 144 + 64 + 16 * part) = pack8(q2[0], q2[1], q2[2], q2[3], q2[4], q2[5], q2[6], q2[7]);
            *(LAS bf16x8*)(L + RT_K + tt * 144 + 16 * part) = pack8(k1[0], k1[1], k1[2], k1[3], k1[4], k1[5], k1[6], k1[7]);
            *(LAS bf16x8*)(L + RT_K + tt * 144 + 64 + 16 * part) = pack8(k2[0], k2[1], k2[2], k2[3], k2[4], k2[5], k2[6], k2[7]);
#pragma unroll
            for (int j = 0; j < 8; ++j) { *(LAS bf16*)(L + RT_KT + (8 * part + j) * 272 + tt * 2) = (bf16)f2bf(k1[j]); *(LAS bf16*)(L + RT_KT + (32 + 8 * part + j) * 272 + tt * 2) = (bf16)f2bf(k2[j]); }
            const int dv = tid >> 2, seg = tid & 3;
            const bf16* vsrc = C_VT0 + ((size_t)(b * 512 + h * 128 + dv)) * 2048 + 128 * c + seg * 32;
#pragma unroll
            for (int i = 0; i < 4; ++i) *(LAS v4u*)(L + RT_V + dv * 272 + (seg * 32 + 8 * i) * 2) = *(const GAS v4u*)(vsrc + 8 * i);
        }
        __syncthreads();
        bf16x8 qf[2];
#pragma unroll
        for (int ks = 0; ks < 2; ++ks) qf[ks] = *(const LAS bf16x8*)(L + RT_Q + (16 * w + fr) * 144 + (32 * ks + 8 * g) * 2);
        f32x4 o[8];
#pragma unroll
        for (int mt = 0; mt < 8; ++mt) o[mt] = (f32x4){0.f, 0.f, 0.f, 0.f};
#pragma unroll
        for (int kp = 0; kp < 4; ++kp) {
            if (kp <= (w >> 1)) {
                f32x4 s0 = (f32x4){0.f, 0.f, 0.f, 0.f}, s1 = (f32x4){0.f, 0.f, 0.f, 0.f};
#pragma unroll
                for (int ks = 0; ks < 2; ++ks) {
                    const bf16x8 a0 = *(const LAS bf16x8*)(L + RT_K + (32 * kp + fr) * 144 + (32 * ks + 8 * g) * 2);
                    const bf16x8 a1 = *(const LAS bf16x8*)(L + RT_K + (32 * kp + 16 + fr) * 144 + (32 * ks + 8 * g) * 2);
                    s0 = MFMA16(a0, qf[ks], s0); s1 = MFMA16(a1, qf[ks], s1);
                }
                const int tq = 16 * w + fr;
#pragma unroll
                for (int r = 0; r < 4; ++r) { if (32 * kp + 4 * g + r > tq) s0[r] = 0.f; if (32 * kp + 16 + 4 * g + r > tq) s1[r] = 0.f; }
                const bf16x8 pf = pack8(s0[0], s0[1], s0[2], s0[3], s1[0], s1[1], s1[2], s1[3]);
#pragma unroll
                for (int mt = 0; mt < 8; ++mt) {
                    const s16x4 lo = *(const LAS s16x4*)(L + RT_V + (16 * mt + fr) * 272 + (32 * kp + 4 * g) * 2);
                    const s16x4 hi = *(const LAS s16x4*)(L + RT_V + (16 * mt + fr) * 272 + (32 * kp + 16 + 4 * g) * 2);
                    o[mt] = MFMA16(cat4(lo, hi), pf, o[mt]);
                }
            }
        }
#pragma unroll
        for (int mt = 0; mt < 8; ++mt)
#pragma unroll
            for (int ks = 0; ks < 2; ++ks) o[mt] = MFMA16(*(const LAS bf16x8*)(L + RT_S + (16 * mt + fr) * 144 + (32 * ks + 8 * g) * 2), qf[ks], o[mt]);
#pragma unroll
        for (int ks = 0; ks < 4; ++ks) {
            const bf16x8 av = *(const LAS bf16x8*)(L + RT_V + (16 * w + fr) * 272 + (32 * ks + 8 * g) * 2);
#pragma unroll
            for (int nt = 0; nt < 4; ++nt) st[nt] = MFMA16(av, *(const LAS bf16x8*)(L + RT_KT + (16 * nt + fr) * 272 + (32 * ks + 8 * g) * 2), st[nt]);
        }
#pragma unroll
        for (int nt = 0; nt < 4; ++nt) st[nt] = st[nt] * gC;
        __syncthreads();
#pragma unroll
        for (int nt = 0; nt < 4; ++nt)
#pragma unroll
            for (int r = 0; r < 4; ++r) *(LAS bf16*)(L + RT_S + (16 * w + 4 * g + r) * 144 + (16 * nt + fr) * 2) = (bf16)f2bf(st[nt][r]);
        float ss = 0.f;
#pragma unroll
        for (int mt = 0; mt < 8; ++mt) ss += (o[mt][0] * o[mt][0] + o[mt][1] * o[mt][1]) + (o[mt][2] * o[mt][2] + o[mt][3] * o[mt][3]);
        ss += __shfl_xor(ss, 16); ss += __shfl_xor(ss, 32);
        const float rstd = rsqrtf(ss * (1.f / 128.f) + EPS);
        const size_t m = (size_t)b * SEQ + 128 * c + 16 * w + fr;
#pragma unroll
        for (int mt = 0; mt < 8; ++mt) {
            const u32x2 gv = *(const GAS u32x2*)(P + m * rs + E_RG + h * 128 + 16 * mt + 4 * g);
            const float g0 = __uint_as_float(gv.x << 16), g1 = __uint_as_float(gv.x & 0xffff0000u), g2 = __uint_as_float(gv.y << 16), g3 = __uint_as_float(gv.y & 0xffff0000u);
            u32x2 ov; ov.x = pkbf(o[mt][0] * rstd * siluf_(g0), o[mt][1] * rstd * siluf_(g1)); ov.y = pkbf(o[mt][2] * rstd * siluf_(g2), o[mt][3] * rstd * siluf_(g3));
            *(GAS u32x2*)(C_MIX + m * DM + h * 128 + 16 * mt + 4 * g) = ov;
        }
    }
    __syncthreads();
}
constexpr int CW_CTR = 64;
__device__ __forceinline__ void opt_even_mixer(Ctx& C, int li) {
    if (blockIdx.x < 64) for (int rr = 0; rr < REP_RET; ++rr) ret_unit(C, (int)blockIdx.x >> 2, (int)blockIdx.x & 3);
    unsigned* ctr = (unsigned*)(C.ws + WS_CTL) + CW_CTR + 64 * li;
    for (;;) {
        unsigned u = 0; if (C.lane == 0) u = __hip_atomic_fetch_add(ctr, 1u, __ATOMIC_RELAXED, __HIP_MEMORY_SCOPE_AGENT);
        u = __builtin_amdgcn_readfirstlane(u);
        if (u >= (unsigned)(BATCH * 8 * 64)) break;
        const int qblk = 63 - (int)(u >> 7), bh = (int)(u & 127);
        sb_wave_unit(C, bh >> 3, bh & 7, qblk);
    }
}

constexpr size_t WS_GD = 37 * MiB;
constexpr int H1_QR = 0, H1_KR = 17408, H1_KD = 34816, H1_QX = 52224, H1_TOT = 65280;
__device__ __forceinline__ void hg1_unit(Ctx& C, int u, int o) {
    const int sc = u & 31, bh = u >> 5, b = bh >> 2, h = bh & 3;
    const int lane = C.lane, w = C.wave, fr = lane & 15, g = lane >> 4;
    const int i = w >> 1, k = 64 * (w & 1) + lane;
    LAS unsigned char* L = C.lds; bf16* P = C_PROJ; const size_t rs = ODD_IN;
    const float lb = C_LB[o * 512 + h * 128 + k];
    const size_t m0 = (size_t)b * SEQ + 64 * sc + 16 * i;
    float q[16], kk[16], c[16]; float run = 0.f;
#pragma unroll
    for (int j = 0; j < 16; ++j) {
        const float fl = bf2f(P[(m0 + j) * rs + O_HF + h * 128 + k]); q[j] = bf2f(P[(m0 + j) * rs + O_HQ + h * 128 + k]);
        const float sig = 1.f / (1.f + __expf(-fl)), f = lb + (1.f - lb) * sig;
        run += __logf(f); c[j] = run; kk[j] = (1.f - lb) / (1.f + __expf(fl));
    }
    ((LAS float*)(L + H1_TOT))[i * 128 + k] = run;
    __syncthreads();
    const float t0 = ((LAS float*)(L + H1_TOT))[k], t1 = ((LAS float*)(L + H1_TOT))[128 + k], t2 = ((LAS float*)(L + H1_TOT))[256 + k], t3 = ((LAS float*)(L + H1_TOT))[384 + k];
    const float Bi = (i > 0 ? t0 : 0.f) + (i > 1 ? t1 : 0.f) + (i > 2 ? t2 : 0.f), B4 = (t0 + t1) + (t2 + t3), Bn = Bi + run;
    const float eBi = __expf(Bi), eEnd = __expf(B4 - Bn), eD = __expf(-run);
    const float fx0 = (i == 2) ? __expf(t1) : ((i == 3) ? __expf(t2) : 0.f), fx1 = (i == 3) ? __expf(t1 + t2) : 0.f;
    float ksv[16];
#pragma unroll
    for (int j = 0; j < 16; ++j) {
        const float qr = q[j] * __expf(c[j]), kr = kk[j] * __expf(run - c[j]);
        const int row = 16 * i + j;
        *(LAS bf16*)(L + H1_QR + row * 272 + k * 2) = (bf16)f2bf(qr);
        *(LAS bf16*)(L + H1_KR + row * 272 + k * 2) = (bf16)f2bf(kr);
        *(LAS bf16*)(L + H1_KD + row * 272 + k * 2) = (bf16)f2bf(kr * eD);
        if (i == 2) *(LAS bf16*)(L + H1_QX + j * 272 + k * 2) = (bf16)f2bf(qr * fx0);
        if (i == 3) { *(LAS bf16*)(L + H1_QX + (16 + j) * 272 + k * 2) = (bf16)f2bf(qr * fx0);
                      *(LAS bf16*)(L + H1_QX + (32 + j) * 272 + k * 2) = (bf16)f2bf(qr * fx1); }
        C_XN[(m0 + j) * 512 + h * 128 + k] = (bf16)f2bf(qr * eBi);
        ksv[j] = kr * eEnd;
    }
    {
        bf16* kd = C_KST + ((size_t)u * 128 + k) * 64 + 16 * i;
        v4u p0, p1; p0.x = pkbf(ksv[0], ksv[1]); p0.y = pkbf(ksv[2], ksv[3]); p0.z = pkbf(ksv[4], ksv[5]); p0.w = pkbf(ksv[6], ksv[7]);
        p1.x = pkbf(ksv[8], ksv[9]); p1.y = pkbf(ksv[10], ksv[11]); p1.z = pkbf(ksv[12], ksv[13]); p1.w = pkbf(ksv[14], ksv[15]);
        *(GAS v4u*)kd = p0; *(GAS v4u*)(kd + 8) = p1;
        if (i == 0) ((float*)(C.ws + WS_GD))[(size_t)u * 128 + k] = __expf(B4);
    }
    __syncthreads();
    const int ti = w & 3, vh = w >> 2;
    f32x4 at[4];
#pragma unroll
    for (int sj = 0; sj < 4; ++sj) {
        at[sj] = (f32x4){0.f, 0.f, 0.f, 0.f};
        if (sj <= ti) {
            const int kbase = (sj == ti) ? H1_KD : H1_KR;
            const int gap = ti - sj;
            const int qbase = (gap <= 1) ? (H1_QR + 16 * ti * 272) : ((ti == 2) ? H1_QX : ((sj == 1) ? (H1_QX + 16 * 272) : (H1_QX + 32 * 272)));
#pragma unroll
            for (int ks = 0; ks < 4; ++ks) {
                const bf16x8 a = *(const LAS bf16x8*)(L + kbase + (16 * sj + fr) * 272 + (32 * ks + 8 * g) * 2);
                const bf16x8 bq = *(const LAS bf16x8*)(L + qbase + fr * 272 + (32 * ks + 8 * g) * 2);
                at[sj] = MFMA16(a, bq, at[sj]);
            }
            if (sj == ti) {
#pragma unroll
                for (int r = 0; r < 4; ++r) if (4 * g + r > fr) at[sj][r] = 0.f;
            }
        }
    }
    f32x4 oo[4];
#pragma unroll
    for (int mt = 0; mt < 4; ++mt) oo[mt] = (f32x4){0.f, 0.f, 0.f, 0.f};
    const bf16* vtb = C_VT0 + ((size_t)(b * 512 + h * 128 + 64 * vh + fr)) * 2048 + 64 * sc + 4 * g;
#pragma unroll
    for (int kp = 0; kp < 2; ++kp) {
        if (2 * kp <= ti) {
            const bf16x8 pf = kp == 0 ? pack8(at[0][0], at[0][1], at[0][2], at[0][3], at[1][0], at[1][1], at[1][2], at[1][3]) : pack8(at[2][0], at[2][1], at[2][2], at[2][3], at[3][0], at[3][1], at[3][2], at[3][3]);
#pragma unroll
            for (int mt = 0; mt < 4; ++mt) {
                const s16x4 lo = *(const GAS s16x4*)(vtb + (size_t)mt * 16 * 2048 + 32 * kp), hi = *(const GAS s16x4*)(vtb + (size_t)mt * 16 * 2048 + 32 * kp + 16);
                oo[mt] = MFMA16(cat4(lo, hi), pf, oo[mt]);
            }
        }
    }
    bf16* op = C_OI + ((size_t)b * SEQ + 64 * sc + 16 * ti + fr) * 512 + h * 128 + 64 * vh + 4 * g;
#pragma unroll
    for (int mt = 0; mt < 4; ++mt) { u32x2 ov; ov.x = pkbf(oo[mt][0], oo[mt][1]); ov.y = pkbf(oo[mt][2], oo[mt][3]); *(GAS u32x2*)(op + 16 * mt) = ov; }
    __syncthreads();
}

constexpr int H2_ST = 0, H2_VT = 34816, H2_SS = 34816 + 2 * 18432;
__device__ __forceinline__ void hg2_unit(Ctx& C, int bh) {
    const int b = bh >> 2, h = bh & 3;
    const int tid = C.tid, lane = C.lane, w = C.wave, fr = lane & 15, g = lane >> 4, ti = w & 3, vh = w >> 2;
    LAS unsigned char* L = C.lds; const bf16* P = C_PROJ; const size_t rs = ODD_IN;
    f32x4 st[8];
#pragma unroll
    for (int nt = 0; nt < 8; ++nt) st[nt] = (f32x4){0.f, 0.f, 0.f, 0.f};
    for (int i = tid; i < 34816 / 4; i += 512) ((LAS unsigned*)(L + H2_ST))[i] = 0u;
    const int sv = tid >> 2, sseg = tid & 3;
    const bf16* vsrc = C_VT0 + ((size_t)(b * 512 + h * 128 + sv)) * 2048 + 16 * sseg;
    const float* gdp = (const float*)(C.ws + WS_GD) + (size_t)bh * 32 * 128 + 16 * w + 4 * g;
    const bf16* kstp = C_KST + ((size_t)bh * 32 * 128 + 16 * w + fr) * 64 + 8 * g;
    const size_t mrow = (size_t)b * SEQ + 16 * ti + fr;
    bf16x8 qf[4], ka[2]; f32x4 gd; u32x2 oi[4], gt[4]; v4u vs0, vs1;
    u32x2 ovp[4];
#pragma unroll
    for (int ks = 0; ks < 4; ++ks) qf[ks] = *(const GAS bf16x8*)(C_XN + mrow * 512 + h * 128 + 32 * ks + 8 * g);
#pragma unroll
    for (int ks = 0; ks < 2; ++ks) ka[ks] = *(const GAS bf16x8*)(kstp + 32 * ks);
    gd = *(const GAS f32x4*)gdp;
#pragma unroll
    for (int mt = 0; mt < 4; ++mt) { oi[mt] = *(const GAS u32x2*)(C_OI + mrow * 512 + h * 128 + 64 * vh + 16 * mt + 4 * g); gt[mt] = *(const GAS u32x2*)(P + mrow * rs + O_HG + h * 128 + 64 * vh + 16 * mt + 4 * g); }
    vs0 = *(const GAS v4u*)vsrc; vs1 = *(const GAS v4u*)(vsrc + 8);
    *(LAS v4u*)(L + H2_VT + sv * 144 + sseg * 32) = vs0; *(LAS v4u*)(L + H2_VT + sv * 144 + sseg * 32 + 16) = vs1;
    vs0 = *(const GAS v4u*)(vsrc + 64); vs1 = *(const GAS v4u*)(vsrc + 64 + 8);
    __syncthreads();
    TIC(C, 1);
    for (int sc = 0; sc < 32; ++sc) {
        { TIC(C, 2); if (TSCALE && TSEL == 2) asm volatile("s_waitcnt vmcnt(0)" ::: "memory"); TOC(C, 2); }
        const size_t m = mrow + 64 * sc;
        const int scn = sc < 31 ? sc + 1 : sc;
        const size_t mn = mrow + 64 * scn;
        if (sc > 0) { bf16* opp = C_MIX + (m - 64) * DM + h * 128 + 64 * vh + 4 * g;
#pragma unroll
            for (int mt = 0; mt < 4; ++mt) *(GAS u32x2*)(opp + 16 * mt) = ovp[mt]; }
        bf16x8 qfn[4], kan[2]; f32x4 gdn; u32x2 oin[4], gtn[4];
#pragma unroll
        for (int ks = 0; ks < 4; ++ks) qfn[ks] = *(const GAS bf16x8*)(C_XN + mn * 512 + h * 128 + 32 * ks + 8 * g);
#pragma unroll
        for (int ks = 0; ks < 2; ++ks) kan[ks] = *(const GAS bf16x8*)(kstp + (size_t)scn * 128 * 64 + 32 * ks);
        gdn = *(const GAS f32x4*)(gdp + scn * 128);
#pragma unroll
        for (int mt = 0; mt < 4; ++mt) { oin[mt] = *(const GAS u32x2*)(C_OI + mn * 512 + h * 128 + 64 * vh + 16 * mt + 4 * g); gtn[mt] = *(const GAS u32x2*)(P + mn * rs + O_HG + h * 128 + 64 * vh + 16 * mt + 4 * g); }
        { LAS unsigned char* vn = L + H2_VT + ((sc + 1) & 1) * 18432; *(LAS v4u*)(vn + sv * 144 + sseg * 32) = vs0; *(LAS v4u*)(vn + sv * 144 + sseg * 32 + 16) = vs1; }
        { const int sc2 = sc < 30 ? sc + 2 : 31; vs0 = *(const GAS v4u*)(vsrc + 64 * sc2); vs1 = *(const GAS v4u*)(vsrc + 64 * sc2 + 8); }
        f32x4 o[4];
#pragma unroll
        for (int mt = 0; mt < 4; ++mt) {
            o[mt] = (f32x4){0.f, 0.f, 0.f, 0.f};
#pragma unroll
            for (int ks = 0; ks < 4; ++ks) o[mt] = MFMA16(*(const LAS bf16x8*)(L + H2_ST + (64 * vh + 16 * mt + fr) * 272 + (32 * ks + 8 * g) * 2), qf[ks], o[mt]);
        }
        float ss = 0.f;
#pragma unroll
        for (int mt = 0; mt < 4; ++mt) { const u32x2 iv = oi[mt];
            o[mt][0] += __uint_as_float(iv.x << 16); o[mt][1] += __uint_as_float(iv.x & 0xffff0000u); o[mt][2] += __uint_as_float(iv.y << 16); o[mt][3] += __uint_as_float(iv.y & 0xffff0000u);
            ss += (o[mt][0] * o[mt][0] + o[mt][1] * o[mt][1]) + (o[mt][2] * o[mt][2] + o[mt][3] * o[mt][3]); }
        ss += __shfl_xor(ss, 16); ss += __shfl_xor(ss, 32);
        if (g == 0) ((LAS float*)(L + H2_SS))[vh * 64 + 16 * ti + fr] = ss;
        { TIC(C, 3); __syncthreads(); TOC(C, 3); }
        const LAS unsigned char* vt = L + H2_VT + (sc & 1) * 18432;
#pragma unroll
        for (int nt = 0; nt < 8; ++nt) { st[nt] = st[nt] * gd;
#pragma unroll
            for (int ks = 0; ks < 2; ++ks) st[nt] = MFMA16(ka[ks], *(const LAS bf16x8*)(vt + (16 * nt + fr) * 144 + (32 * ks + 8 * g) * 2), st[nt]); }
#pragma unroll
        for (int nt = 0; nt < 8; ++nt) { u32x2 svv; svv.x = pkbf(st[nt][0], st[nt][1]); svv.y = pkbf(st[nt][2], st[nt][3]); *(LAS u32x2*)(L + H2_ST + (16 * nt + fr) * 272 + (16 * w + 4 * g) * 2) = svv; }
        const float tot = ((LAS float*)(L + H2_SS))[16 * ti + fr] + ((LAS float*)(L + H2_SS))[64 + 16 * ti + fr];
        const float rstd = rsqrtf(tot * (1.f / 128.f) + EPS);
#pragma unroll
        for (int mt = 0; mt < 4; ++mt) {
            const u32x2 gv = gt[mt];
            const float g0 = __uint_as_float(gv.x << 16), g1 = __uint_as_float(gv.x & 0xffff0000u), g2 = __uint_as_float(gv.y << 16), g3 = __uint_as_float(gv.y & 0xffff0000u);
            ovp[mt].x = pkbf(o[mt][0] * rstd * siluf_(g0), o[mt][1] * rstd * siluf_(g1)); ovp[mt].y = pkbf(o[mt][2] * rstd * siluf_(g2), o[mt][3] * rstd * siluf_(g3));
        }
#pragma unroll
        for (int ks = 0; ks < 4; ++ks) qf[ks] = qfn[ks];
        ka[0] = kan[0]; ka[1] = kan[1]; gd = gdn;
#pragma unroll
        for (int mt = 0; mt < 4; ++mt) { oi[mt] = oin[mt]; gt[mt] = gtn[mt]; }
        { TIC(C, 4); __syncthreads(); TOC(C, 4); }
    }
    TOC(C, 1);
    { bf16* opp = C_MIX + (mrow + 64 * 31) * DM + h * 128 + 64 * vh + 4 * g;
#pragma unroll
      for (int mt = 0; mt < 4; ++mt) *(GAS u32x2*)(opp + 16 * mt) = ovp[mt]; }
}
__device__ __forceinline__ bf16 ldg_u16(const GAS bf16* ubase, unsigned voff) { asm volatile("" : "+s"(ubase)); return *(const GAS bf16*)((const GAS unsigned char*)ubase + voff); }
__device__ __forceinline__ void stg_u16(GAS bf16* ubase, unsigned voff, bf16 v) { asm volatile("" : "+s"(ubase)); *(GAS bf16*)((GAS unsigned char*)ubase + voff) = v; }
constexpr int LR_WA = 0, LR_WX = 9216, LR_PW = 18432, LR_PWSZ = 14848, LR_XC = 0, LR_XCF = 2304, LR_AU = 6400, LR_CAR = 18432 + 8 * 14848;
__device__ __forceinline__ void lru_unit(Ctx& C, int b, int n, int o) {
    const int tid = C.tid, lane = C.lane, w = C.wave, fr = lane & 15, g = lane >> 4;
    LAS unsigned char* L = C.lds; const bf16* P = C_PROJ; const size_t rs = ODD_IN;
    {
        const float* Wa = IN(10) + ((size_t)o * 8 + n) * 4096; const float* Wx = IN(12) + ((size_t)o * 8 + n) * 4096;
        for (int e = tid; e < 4096; e += 512) { const int i = e >> 6, j = e & 63;
            *(LAS bf16*)(L + LR_WA + j * 144 + i * 2) = (bf16)f2bf(Wa[e]); *(LAS bf16*)(L + LR_WX + j * 144 + i * 2) = (bf16)f2bf(Wx[e]); }
    }
    const int ch = n * 64 + lane;
    const float* cw = IN(8) + (size_t)o * 4 * 512; const float cb = IN(9)[o * 512 + ch];
    const float w0 = cw[ch], w1 = cw[512 + ch], w2 = cw[1024 + ch], w3 = cw[1536 + ch];
    float ba[4], bx[4], sp8[4];
#pragma unroll
    for (int nt = 0; nt < 4; ++nt) { const int cj = o * 512 + n * 64 + 16 * nt + fr; ba[nt] = IN(11)[cj]; bx[nt] = IN(13)[cj]; sp8[nt] = 8.0f * log1pf(expf(-IN(14)[cj])); }
    LAS unsigned char* PW = L + LR_PW + w * LR_PWSZ;
    __syncthreads();
    float hin = 0.f;
    const size_t mb = (size_t)b * SEQ;
    for (int pass = 0; pass < 2; ++pass) {
        float hs = hin, aprod = 1.f;
        const int tw = 256 * w;
        float xm1 = tw >= 1 ? bf2f(P[(mb + tw - 1) * rs + O_LX + ch]) : 0.f, xm2 = tw >= 2 ? bf2f(P[(mb + tw - 2) * rs + O_LX + ch]) : 0.f, xm3 = tw >= 3 ? bf2f(P[(mb + tw - 3) * rs + O_LX + ch]) : 0.f;
        bf16 xv[16], gv[16];
#pragma unroll
        for (int p = 0; p < 16; ++p) { const GAS bf16* rowp = (const GAS bf16*)P + (mb + tw + p) * rs + n * 64; xv[p] = ldg_u16(rowp + O_LX, lane * 2u); gv[p] = ldg_u16(rowp + (pass ? O_LG : O_LX), lane * 2u); }
        bf16 outv[16];
        for (int tile = 0; tile < 16; ++tile) {
            const int t0 = tw + 16 * tile, tn = tw + 16 * (tile < 15 ? tile + 1 : tile);
            if (pass && tile > 0) {
#pragma unroll
                for (int p = 0; p < 16; ++p) stg_u16((GAS bf16*)C_MIX + (mb + t0 - 16 + p) * DM + 512 + n * 64, lane * 2u, outv[p]); }
            bf16 xn[16], gn[16];
#pragma unroll
            for (int p = 0; p < 16; ++p) { const GAS bf16* rowp = (const GAS bf16*)P + (mb + tn + p) * rs + n * 64; xn[p] = ldg_u16(rowp + O_LX, lane * 2u); gn[p] = ldg_u16(rowp + (pass ? O_LG : O_LX), lane * 2u); }
#pragma unroll
            for (int p = 0; p < 16; ++p) { const float xcur = bf2f(xv[p]); const float xc = cb + w3 * xcur + w2 * xm1 + w1 * xm2 + w0 * xm3; xm3 = xm2; xm2 = xm1; xm1 = xcur;
                *(LAS bf16*)(PW + LR_XC + p * 144 + lane * 2) = (bf16)f2bf(xc); ((LAS float*)(PW + LR_XCF))[p * 64 + lane] = xc; }
            asm volatile("s_waitcnt lgkmcnt(0)" ::: "memory");
            f32x4 ra[4], rx[4];
#pragma unroll
            for (int nt = 0; nt < 4; ++nt) { ra[nt] = (f32x4){0.f, 0.f, 0.f, 0.f}; rx[nt] = (f32x4){0.f, 0.f, 0.f, 0.f}; }
#pragma unroll
            for (int ks = 0; ks < 2; ++ks) {
                const bf16x8 a = *(const LAS bf16x8*)(PW + LR_XC + fr * 144 + (32 * ks + 8 * g) * 2);
#pragma unroll
                for (int nt = 0; nt < 4; ++nt) {
                    ra[nt] = MFMA16(a, *(const LAS bf16x8*)(L + LR_WA + (16 * nt + fr) * 144 + (32 * ks + 8 * g) * 2), ra[nt]);
                    rx[nt] = MFMA16(a, *(const LAS bf16x8*)(L + LR_WX + (16 * nt + fr) * 144 + (32 * ks + 8 * g) * 2), rx[nt]);
                }
            }
#pragma unroll
            for (int nt = 0; nt < 4; ++nt)
#pragma unroll
                for (int r = 0; r < 4; ++r) {
                    const int p = 4 * g + r, j = 16 * nt + fr;
                    const float rr = __builtin_amdgcn_rcpf(1.f + __expf(-(ra[nt][r] + ba[nt]))), ig = __builtin_amdgcn_rcpf(1.f + __expf(-(rx[nt][r] + bx[nt])));
                    const float la = -rr * sp8[nt], a = __expf(la);
                    const float mult = (t0 + p == 0) ? 1.0f : __builtin_amdgcn_sqrtf(fmaxf(1.0f - a * a, 0.f));
                    const float xcv = ((const LAS float*)(PW + LR_XCF))[p * 64 + j];
                    f32x2_t au; au.x = a; au.y = mult * ig * xcv;
                    *(LAS f32x2_t*)(PW + LR_AU + (p * 64 + j) * 8) = au;
                }
            asm volatile("s_waitcnt lgkmcnt(0)" ::: "memory");
            if (pass == 0) {
#pragma unroll
                for (int p = 0; p < 16; ++p) { const f32x2_t au = *(const LAS f32x2_t*)(PW + LR_AU + (p * 64 + lane) * 8); hs = au.x * hs + au.y; aprod *= au.x; }
            } else {
#pragma unroll
                for (int p = 0; p < 16; ++p) { const f32x2_t au = *(const LAS f32x2_t*)(PW + LR_AU + (p * 64 + lane) * 8); hs = au.x * hs + au.y;
                    const float gg = bf2f(gv[p]); outv[p] = (bf16)f2bf(hs * gg * __builtin_amdgcn_rcpf(1.f + __expf(-gg))); }
            }
            asm volatile("s_waitcnt lgkmcnt(0)" ::: "memory");
#pragma unroll
            for (int p = 0; p < 16; ++p) { xv[p] = xn[p]; gv[p] = gn[p]; }
        }
        if (pass) {
#pragma unroll
            for (int p = 0; p < 16; ++p) stg_u16((GAS bf16*)C_MIX + (mb + tw + 240 + p) * DM + 512 + n * 64, lane * 2u, outv[p]); }
        if (pass == 0) {
            f32x2_t cr; cr.x = aprod; cr.y = hs;
            *(LAS f32x2_t*)(L + LR_CAR + (w * 64 + lane) * 8) = cr;
            __syncthreads();
            hin = 0.f;
            for (int ww = 0; ww < w; ++ww) { const f32x2_t cc = *(const LAS f32x2_t*)(L + LR_CAR + (ww * 64 + lane) * 8); hin = cc.x * hin + cc.y; }
        }
    }
    __syncthreads();
}
__device__ __forceinline__ void opt_odd_mixer1(Ctx& C, int o) {
    const int per = (2048 + C.G - 1) / C.G;
    for (int kk = 0; kk < per; ++kk) { const int u = C.vcu * per + kk; if (u < 2048) for (int rr = 0; rr < REP_HG1; ++rr) hg1_unit(C, u, o); }
}
__device__ __forceinline__ void opt_odd_mixer2(Ctx& C, int o) {
    const int bx = (int)blockIdx.x;
    if (bx < 64) for (int rr = 0; rr < REP_HG2; ++rr) hg2_unit(C, bx);
    else if (bx < 192) for (int rr = 0; rr < REP_LRU; ++rr) lru_unit(C, (bx - 64) >> 3, (bx - 64) & 7, o);
}

constexpr size_t WS_CAR = 38 * MiB;
__device__ __forceinline__ GAS bf16* sst_base(Ctx& C, int b, int h, int sc) {
    return (GAS bf16*)(C.ws + (b < 8 ? (WS_PROJ + 192 * MiB) : WS_VT1) + ((size_t)(((b & 7) * 4 + h) * 32 + sc)) * 32768);
}
template <int PASS> __device__ __forceinline__ void lru_pass(Ctx& C, int b, int n, int half, int o) {
    const int tid = C.tid, lane = C.lane, w = C.wave, fr = lane & 15, g = lane >> 4;
    LAS unsigned char* L = C.lds; const bf16* P = C_PROJ; const size_t rs = ODD_IN;
    {
        const float* Wa = IN(10) + ((size_t)o * 8 + n) * 4096; const float* Wx = IN(12) + ((size_t)o * 8 + n) * 4096;
        for (int e = tid; e < 4096; e += 512) { const int i = e >> 6, j = e & 63;
            *(LAS bf16*)(L + LR_WA + j * 144 + i * 2) = (bf16)f2bf(Wa[e]); *(LAS bf16*)(L + LR_WX + j * 144 + i * 2) = (bf16)f2bf(Wx[e]); }
    }
    const int ch = n * 64 + lane, c = 8 * half + w;
    const float* cw = IN(8) + (size_t)o * 4 * 512; const float cb = IN(9)[o * 512 + ch];
    const float w0 = cw[ch], w1 = cw[512 + ch], w2 = cw[1024 + ch], w3 = cw[1536 + ch];
    float ba[4], bx[4], sp8[4];
#pragma unroll
    for (int nt = 0; nt < 4; ++nt) { const int cj = o * 512 + n * 64 + 16 * nt + fr; ba[nt] = IN(11)[cj]; bx[nt] = IN(13)[cj]; sp8[nt] = 8.0f * log1pf(expf(-IN(14)[cj])); }
    LAS unsigned char* PW = L + LR_PW + w * LR_PWSZ;
    GAS f32x2_t* car = (GAS f32x2_t*)(C.ws + WS_CAR) + ((size_t)(b * 8 + n) * 16) * 64 + lane;
    float hs = 0.f, aprod = 1.f;
    if (PASS == 1) { for (int cc = 0; cc < c; ++cc) { const f32x2_t v = car[cc * 64]; hs = v.x * hs + v.y; } }
    __syncthreads();
    const size_t mb = (size_t)b * SEQ; const int tw = 128 * c;
    const GAS bf16* xbase = (const GAS bf16*)P + (mb + tw) * rs + n * 64;
    float xm1 = tw >= 1 ? bf2f(ldg_u16(xbase - rs + O_LX, lane * 2u)) : 0.f, xm2 = tw >= 2 ? bf2f(ldg_u16(xbase - 2 * rs + O_LX, lane * 2u)) : 0.f, xm3 = tw >= 3 ? bf2f(ldg_u16(xbase - 3 * rs + O_LX, lane * 2u)) : 0.f;
    bf16 xv[16], gv[16], outv[16];
#pragma unroll
    for (int p = 0; p < 16; ++p) { const GAS bf16* rowp = xbase + (size_t)p * rs; xv[p] = ldg_u16(rowp + O_LX, lane * 2u); gv[p] = ldg_u16(rowp + (PASS ? O_LG : O_LX), lane * 2u); }
    for (int tile = 0; tile < 8; ++tile) {
        const int t0 = tw + 16 * tile, tn = tw + 16 * (tile < 7 ? tile + 1 : tile);
        if (PASS && tile > 0) {
#pragma unroll
            for (int p = 0; p < 16; ++p) stg_u16((GAS bf16*)C_MIX + (mb + t0 - 16 + p) * DM + 512 + n * 64, lane * 2u, outv[p]); }
        bf16 xn[16], gn[16];
#pragma unroll
        for (int p = 0; p < 16; ++p) { const GAS bf16* rowp = (const GAS bf16*)P + (mb + tn + p) * rs + n * 64; xn[p] = ldg_u16(rowp + O_LX, lane * 2u); gn[p] = ldg_u16(rowp + (PASS ? O_LG : O_LX), lane * 2u); }
#pragma unroll
        for (int p = 0; p < 16; ++p) { const float xcur = bf2f(xv[p]); const float xc = cb + w3 * xcur + w2 * xm1 + w1 * xm2 + w0 * xm3; xm3 = xm2; xm2 = xm1; xm1 = xcur;
            *(LAS bf16*)(PW + LR_XC + p * 144 + lane * 2) = (bf16)f2bf(xc); ((LAS float*)(PW + LR_XCF))[p * 64 + lane] = xc; }
        asm volatile("s_waitcnt lgkmcnt(0)" ::: "memory");
        f32x4 ra[4], rx[4];
#pragma unroll
        for (int nt = 0; nt < 4; ++nt) { ra[nt] = (f32x4){0.f, 0.f, 0.f, 0.f}; rx[nt] = (f32x4){0.f, 0.f, 0.f, 0.f}; }
#pragma unroll
        for (int ks = 0; ks < 2; ++ks) {
            const bf16x8 a = *(const LAS bf16x8*)(PW + LR_XC + fr * 144 + (32 * ks + 8 * g) * 2);
#pragma unroll
            for (int nt = 0; nt < 4; ++nt) {
                ra[nt] = MFMA16(a, *(const LAS bf16x8*)(L + LR_WA + (16 * nt + fr) * 144 + (32 * ks + 8 * g) * 2), ra[nt]);
                rx[nt] = MFMA16(a, *(const LAS bf16x8*)(L + LR_WX + (16 * nt + fr) * 144 + (32 * ks + 8 * g) * 2), rx[nt]);
            }
        }
#pragma unroll
        for (int nt = 0; nt < 4; ++nt)
#pragma unroll
            for (int r = 0; r < 4; ++r) {
                const int p = 4 * g + r, j = 16 * nt + fr;
                const float rr = __builtin_amdgcn_rcpf(1.f + __expf(-(ra[nt][r] + ba[nt]))), ig = __builtin_amdgcn_rcpf(1.f + __expf(-(rx[nt][r] + bx[nt])));
                const float la = -rr * sp8[nt], a = __expf(la);
                const float mult = (t0 + p == 0) ? 1.0f : __builtin_amdgcn_sqrtf(fmaxf(1.0f - a * a, 0.f));
                const float xcv = ((const LAS float*)(PW + LR_XCF))[p * 64 + j];
                f32x2_t au; au.x = a; au.y = mult * ig * xcv;
                *(LAS f32x2_t*)(PW + LR_AU + (p * 64 + j) * 8) = au;
            }
        asm volatile("s_waitcnt lgkmcnt(0)" ::: "memory");
        if (PASS == 0) {
#pragma unroll
            for (int p = 0; p < 16; ++p) { const f32x2_t au = *(const LAS f32x2_t*)(PW + LR_AU + (p * 64 + lane) * 8); hs = au.x * hs + au.y; aprod *= au.x; }
        } else {
#pragma unroll
            for (int p = 0; p < 16; ++p) { const f32x2_t au = *(const LAS f32x2_t*)(PW + LR_AU + (p * 64 + lane) * 8); hs = au.x * hs + au.y;
                const float gg = bf2f(gv[p]); outv[p] = (bf16)f2bf(hs * gg * __builtin_amdgcn_rcpf(1.f + __expf(-gg))); }
        }
        asm volatile("s_waitcnt lgkmcnt(0)" ::: "memory");
#pragma unroll
        for (int p = 0; p < 16; ++p) { xv[p] = xn[p]; gv[p] = gn[p]; }
    }
    if (PASS) {
#pragma unroll
        for (int p = 0; p < 16; ++p) stg_u16((GAS bf16*)C_MIX + (mb + tw + 112 + p) * DM + 512 + n * 64, lane * 2u, outv[p]);
    } else { f32x2_t cr; cr.x = aprod; cr.y = hs; car[c * 64] = cr; }
    __syncthreads();
}
__device__ __forceinline__ void hg2seq_unit(Ctx& C, int b, int h, int vq) {
    const int lane = C.lane, w = C.wave, fr = lane & 15, g = lane >> 4; const int bh = b * 4 + h;
    f32x4 st[2] = {(f32x4){0.f, 0.f, 0.f, 0.f}, (f32x4){0.f, 0.f, 0.f, 0.f}};
    const GAS bf16* kstp = (const GAS bf16*)C_KST + ((size_t)bh * 32 * 128 + 16 * w + fr) * 64 + 8 * g;
    const GAS bf16* vtp = (const GAS bf16*)C_VT0 + ((size_t)(b * 512 + h * 128 + 32 * vq + fr)) * 2048 + 8 * g;
    const GAS float* gdp = (const GAS float*)(C.ws + WS_GD) + (size_t)bh * 32 * 128 + 16 * w + 4 * g;
    bf16x8 ka[2], vb[2][2]; f32x4 gd;
#pragma unroll
    for (int ks = 0; ks < 2; ++ks) { ka[ks] = *(const GAS bf16x8*)(kstp + 32 * ks); vb[0][ks] = *(const GAS bf16x8*)(vtp + 32 * ks); vb[1][ks] = *(const GAS bf16x8*)(vtp + (size_t)16 * 2048 + 32 * ks); }
    gd = *(const GAS f32x4*)gdp;
    for (int sc = 0; sc < 32; ++sc) {
        if (sc > 0) { GAS bf16* sp = sst_base(C, b, h, sc) + (size_t)(32 * vq + fr) * 128 + 16 * w + 4 * g;
#pragma unroll
            for (int nt = 0; nt < 2; ++nt) { u32x2 sv; sv.x = pkbf(st[nt][0], st[nt][1]); sv.y = pkbf(st[nt][2], st[nt][3]); *(GAS u32x2*)(sp + (size_t)nt * 16 * 128) = sv; } }
        const int scn = sc < 31 ? sc + 1 : sc;
        bf16x8 kan[2], vbn[2][2]; f32x4 gdn;
#pragma unroll
        for (int ks = 0; ks < 2; ++ks) { kan[ks] = *(const GAS bf16x8*)(kstp + (size_t)scn * 128 * 64 + 32 * ks); vbn[0][ks] = *(const GAS bf16x8*)(vtp + 64 * scn + 32 * ks); vbn[1][ks] = *(const GAS bf16x8*)(vtp + (size_t)16 * 2048 + 64 * scn + 32 * ks); }
        gdn = *(const GAS f32x4*)(gdp + scn * 128);
#pragma unroll
        for (int nt = 0; nt < 2; ++nt) { st[nt] = st[nt] * gd;
#pragma unroll
            for (int ks = 0; ks < 2; ++ks) st[nt] = MFMA16(ka[ks], vb[nt][ks], st[nt]); }
#pragma unroll
        for (int ks = 0; ks < 2; ++ks) { ka[ks] = kan[ks]; vb[0][ks] = vbn[0][ks]; vb[1][ks] = vbn[1][ks]; }
        gd = gdn;
    }
}
__device__ __forceinline__ void hg3_wave_unit(Ctx& C, int b, int h, int sc, int ti) {
    const int lane = C.lane, fr = lane & 15, g = lane >> 4; const bf16* P = C_PROJ; const size_t rs = ODD_IN;
    const size_t m = (size_t)b * SEQ + 64 * sc + 16 * ti + fr;
    u32x2 oi[8], gt[8];
#pragma unroll
    for (int mt = 0; mt < 8; ++mt) { oi[mt] = *(const GAS u32x2*)(C_OI + m * 512 + h * 128 + 16 * mt + 4 * g); gt[mt] = *(const GAS u32x2*)(P + m * rs + O_HG + h * 128 + 16 * mt + 4 * g); }
    f32x4 o[8];
#pragma unroll
    for (int mt = 0; mt < 8; ++mt) o[mt] = (f32x4){0.f, 0.f, 0.f, 0.f};
    if (sc > 0) {
        bf16x8 qf[4];
#pragma unroll
        for (int ks = 0; ks < 4; ++ks) qf[ks] = *(const GAS bf16x8*)(C_XN + m * 512 + h * 128 + 32 * ks + 8 * g);
        const GAS bf16* sp = sst_base(C, b, h, sc) + (size_t)fr * 128 + 8 * g;
#pragma unroll
        for (int hf = 0; hf < 2; ++hf) {
            bf16x8 af[4][4];
#pragma unroll
            for (int mt = 0; mt < 4; ++mt)
#pragma unroll
                for (int ks = 0; ks < 4; ++ks) af[mt][ks] = *(const GAS bf16x8*)(sp + (size_t)(64 * hf + 16 * mt) * 128 + 32 * ks);
#pragma unroll
            for (int mt = 0; mt < 4; ++mt)
#pragma unroll
                for (int ks = 0; ks < 4; ++ks) o[4 * hf + mt] = MFMA16(af[mt][ks], qf[ks], o[4 * hf + mt]);
        }
    }
    float ss = 0.f;
#pragma unroll
    for (int mt = 0; mt < 8; ++mt) { const u32x2 iv = oi[mt];
        o[mt][0] += __uint_as_float(iv.x << 16); o[mt][1] += __uint_as_float(iv.x & 0xffff0000u); o[mt][2] += __uint_as_float(iv.y << 16); o[mt][3] += __uint_as_float(iv.y & 0xffff0000u);
        ss += (o[mt][0] * o[mt][0] + o[mt][1] * o[mt][1]) + (o[mt][2] * o[mt][2] + o[mt][3] * o[mt][3]); }
    ss += __shfl_xor(ss, 16); ss += __shfl_xor(ss, 32);
    const float rstd = rsqrtf(ss * (1.f / 128.f) + EPS);
    bf16* op = C_MIX + m * DM + h * 128 + 4 * g;
#pragma unroll
    for (int mt = 0; mt < 8; ++mt) {
        const u32x2 gv = gt[mt];
        const float g0 = __uint_as_float(gv.x << 16), g1 = __uint_as_float(gv.x & 0xffff0000u), g2 = __uint_as_float(gv.y << 16), g3 = __uint_as_float(gv.y & 0xffff0000u);
        u32x2 ov; ov.x = pkbf(o[mt][0] * rstd * siluf_(g0), o[mt][1] * rstd * siluf_(g1)); ov.y = pkbf(o[mt][2] * rstd * siluf_(g2), o[mt][3] * rstd * siluf_(g3));
        *(GAS u32x2*)(op + 16 * mt) = ov;
    }
}

constexpr int H1_TOT8 = 65280;
__device__ __forceinline__ f32x2_t bf2x(unsigned w) { f32x2_t r; r.x = __uint_as_float(w << 16); r.y = __uint_as_float(w & 0xffff0000u); return r; }
__device__ __forceinline__ f32x2_t exp2x(f32x2_t v) { f32x2_t r; r.x = __expf(v.x); r.y = __expf(v.y); return r; }
__device__ __forceinline__ unsigned pk2x(f32x2_t v) { return pkbf(v.x, v.y); }
__device__ __forceinline__ void hg1_units(Ctx& C, int u0, int nu, int o) {
    const int lane = C.lane, w = C.wave, fr = lane & 15, g = lane >> 4;
    const int i = w >> 1, hf = w & 1, ti = w & 3, vh = w >> 2;
    LAS unsigned char* L = C.lds; const size_t rs = ODD_IN;
    unsigned flr[8], qr_[8];
    {
        const int u = u0, sc = u & 31, bh = u >> 5, b = bh >> 2, h = bh & 3;
        const GAS bf16* src = (const GAS bf16*)C_PROJ + ((size_t)b * SEQ + 64 * sc + 16 * i + 8 * hf) * rs + h * 128 + 2 * lane;
#pragma unroll
        for (int j = 0; j < 8; ++j) { flr[j] = *(const GAS unsigned*)(src + (size_t)j * rs + O_HF); qr_[j] = *(const GAS unsigned*)(src + (size_t)j * rs + O_HQ); }
    }
    for (int un = 0; un < nu; ++un) {
        const int u = u0 + un, sc = u & 31, bh = u >> 5, b = bh >> 2, h = bh & 3;
        s16x4 vlo[4][2], vhi[4][2];
        {
            const GAS bf16* vtb = (const GAS bf16*)C_VT0 + ((size_t)(b * 512 + h * 128 + 64 * vh + fr)) * 2048 + 64 * sc + 4 * g;
#pragma unroll
            for (int mt = 0; mt < 4; ++mt)
#pragma unroll
                for (int kp = 0; kp < 2; ++kp) { vlo[mt][kp] = *(const GAS s16x4*)(vtb + (size_t)mt * 16 * 2048 + 32 * kp); vhi[mt][kp] = *(const GAS s16x4*)(vtb + (size_t)mt * 16 * 2048 + 32 * kp + 16); }
        }
        unsigned fln[8], qn[8];
        {
            const int u2 = (un + 1 < nu) ? u + 1 : u, sc2 = u2 & 31, bh2 = u2 >> 5;
            const GAS bf16* src = (const GAS bf16*)C_PROJ + ((size_t)(bh2 >> 2) * SEQ + 64 * sc2 + 16 * i + 8 * hf) * rs + (bh2 & 3) * 128 + 2 * lane;
#pragma unroll
            for (int j = 0; j < 8; ++j) { fln[j] = *(const GAS unsigned*)(src + (size_t)j * rs + O_HF); qn[j] = *(const GAS unsigned*)(src + (size_t)j * rs + O_HQ); }
        }
        const f32x2_t lb = *(const GAS f32x2_t*)(C_LB + o * 512 + h * 128 + 2 * lane);
        const f32x2_t omlb = (f32x2_t){1.f, 1.f} - lb;
        f32x2_t c[8], kk[8]; f32x2_t run = {0.f, 0.f};
#pragma unroll
        for (int j = 0; j < 8; ++j) {
            const f32x2_t fl = bf2x(flr[j]); const f32x2_t e = exp2x(-fl);
            f32x2_t sig; sig.x = __builtin_amdgcn_rcpf(1.f + e.x); sig.y = __builtin_amdgcn_rcpf(1.f + e.y);
            const f32x2_t f = lb + omlb * sig;
            run.x += __logf(f.x); run.y += __logf(f.y); c[j] = run; kk[j] = omlb * ((f32x2_t){1.f, 1.f} - sig);
        }
        *(LAS f32x2_t*)(L + H1_TOT8 + (w * 128 + 2 * lane) * 4) = run;
        __syncthreads();
        f32x2_t pt[8];
#pragma unroll
        for (int ww = 0; ww < 8; ++ww) pt[ww] = *(const LAS f32x2_t*)(L + H1_TOT8 + (ww * 128 + 2 * lane) * 4);
        const f32x2_t t0 = pt[0] + pt[1], t1 = pt[2] + pt[3], t2 = pt[4] + pt[5], t3 = pt[6] + pt[7];
        const f32x2_t zz = {0.f, 0.f};
        const f32x2_t toti = i == 0 ? t0 : (i == 1 ? t1 : (i == 2 ? t2 : t3));
        const f32x2_t hb = hf ? (i == 0 ? pt[0] : (i == 1 ? pt[2] : (i == 2 ? pt[4] : pt[6]))) : zz;
        const f32x2_t Bi = (i > 0 ? t0 : zz) + (i > 1 ? t1 : zz) + (i > 2 ? t2 : zz), B4 = (t0 + t1) + (t2 + t3), Bn = Bi + toti;
        const f32x2_t eBi = exp2x(Bi), eEnd = exp2x(B4 - Bn), eD = exp2x(-toti);
        const f32x2_t fx0 = (i == 2) ? exp2x(t1) : ((i == 3) ? exp2x(t2) : zz), fx1 = (i == 3) ? exp2x(t1 + t2) : zz;
        const size_t m0 = (size_t)b * SEQ + 64 * sc + 16 * i + 8 * hf;
        unsigned ks0[4], ks1[4];
#pragma unroll
        for (int j = 0; j < 8; ++j) {
            const f32x2_t cc = hb + c[j];
            const f32x2_t qr = bf2x(qr_[j]) * exp2x(cc), kr = kk[j] * exp2x(toti - cc);
            const int row = 16 * i + 8 * hf + j;
            *(LAS unsigned*)(L + H1_QR + row * 272 + lane * 4) = pk2x(qr);
            *(LAS unsigned*)(L + H1_KR + row * 272 + lane * 4) = pk2x(kr);
            *(LAS unsigned*)(L + H1_KD + row * 272 + lane * 4) = pk2x(kr * eD);
            if (i == 2) *(LAS unsigned*)(L + H1_QX + (8 * hf + j) * 272 + lane * 4) = pk2x(qr * fx0);
            if (i == 3) { *(LAS unsigned*)(L + H1_QX + (16 + 8 * hf + j) * 272 + lane * 4) = pk2x(qr * fx0); *(LAS unsigned*)(L + H1_QX + (32 + 8 * hf + j) * 272 + lane * 4) = pk2x(qr * fx1); }
            *(GAS unsigned*)(C_XN + (m0 + j) * 512 + h * 128 + 2 * lane) = pk2x(qr * eBi);
            const f32x2_t ks = kr * eEnd;
            if (j & 1) { ks0[j >> 1] = pkbf(__uint_as_float(ks0[j >> 1]), ks.x); ks1[j >> 1] = pkbf(__uint_as_float(ks1[j >> 1]), ks.y); }
            else { ks0[j >> 1] = __float_as_uint(ks.x); ks1[j >> 1] = __float_as_uint(ks.y); }
        }
        {
            bf16* kd = C_KST + ((size_t)u * 128 + 2 * lane) * 64 + 16 * i + 8 * hf;
            v4u p0, p1; p0.x = ks0[0]; p0.y = ks0[1]; p0.z = ks0[2]; p0.w = ks0[3]; p1.x = ks1[0]; p1.y = ks1[1]; p1.z = ks1[2]; p1.w = ks1[3];
            *(GAS v4u*)kd = p0; *(GAS v4u*)(kd + 64) = p1;
            if (w == 0) *(GAS f32x2_t*)((float*)(C.ws + WS_GD) + (size_t)u * 128 + 2 * lane) = exp2x(B4);
        }
        __syncthreads();
        f32x4 at[4];
#pragma unroll
        for (int sj = 0; sj < 4; ++sj) {
            at[sj] = (f32x4){0.f, 0.f, 0.f, 0.f};
            if (sj <= ti) {
                const int kbase = (sj == ti) ? H1_KD : H1_KR;
                const int gap = ti - sj;
                const int qbase = (gap <= 1) ? (H1_QR + 16 * ti * 272) : ((ti == 2) ? H1_QX : ((sj == 1) ? (H1_QX + 16 * 272) : (H1_QX + 32 * 272)));
#pragma unroll
                for (int ks = 0; ks < 4; ++ks) {
                    const bf16x8 a = *(const LAS bf16x8*)(L + kbase + (16 * sj + fr) * 272 + (32 * ks + 8 * g) * 2);
                    const bf16x8 bq = *(const LAS bf16x8*)(L + qbase + fr * 272 + (32 * ks + 8 * g) * 2);
                    at[sj] = MFMA16(a, bq, at[sj]);
                }
                if (sj == ti) {
#pragma unroll
                    for (int r = 0; r < 4; ++r) if (4 * g + r > fr) at[sj][r] = 0.f;
                }
            }
        }
        f32x4 oo[4];
#pragma unroll
        for (int mt = 0; mt < 4; ++mt) oo[mt] = (f32x4){0.f, 0.f, 0.f, 0.f};
#pragma unroll
        for (int kp = 0; kp < 2; ++kp) {
            if (2 * kp <= ti) {
                const bf16x8 pf = kp == 0 ? pack8(at[0][0], at[0][1], at[0][2], at[0][3], at[1][0], at[1][1], at[1][2], at[1][3]) : pack8(at[2][0], at[2][1], at[2][2], at[2][3], at[3][0], at[3][1], at[3][2], at[3][3]);
#pragma unroll
                for (int mt = 0; mt < 4; ++mt) oo[mt] = MFMA16(cat4(vlo[mt][kp], vhi[mt][kp]), pf, oo[mt]);
            }
        }
        bf16* op = C_OI + ((size_t)b * SEQ + 64 * sc + 16 * ti + fr) * 512 + h * 128 + 64 * vh + 4 * g;
#pragma unroll
        for (int mt = 0; mt < 4; ++mt) { u32x2 ov; ov.x = pkbf(oo[mt][0], oo[mt][1]); ov.y = pkbf(oo[mt][2], oo[mt][3]); *(GAS u32x2*)(op + 16 * mt) = ov; }
#pragma unroll
        for (int j = 0; j < 8; ++j) { flr[j] = fln[j]; qr_[j] = qn[j]; }
        __syncthreads();
    }
}
__device__ __forceinline__ void odd_phase1(Ctx& C, int o) {
    const int per = (2048 + C.G - 1) / C.G;
    { TIC(C, 13); { const int ub = C.vcu * per, ne = (ub + per <= 2048) ? per : (2048 - ub); if (ne > 0) hg1_units(C, ub, ne, o); } TOC(C, 13); }
    { TIC(C, 14); for (int u = C.vcu; u < 256; u += C.G) lru_pass<0>(C, u >> 4, (u >> 1) & 7, u & 1, o); TOC(C, 14); }
}
__device__ __forceinline__ void odd_phase2(Ctx& C, int o) {
    { TIC(C, 15); for (int u = C.vcu; u < 256; u += C.G) hg2seq_unit(C, u >> 4, (u >> 2) & 3, u & 3); TOC(C, 15); }
    { TIC(C, 16); for (int u = C.vcu; u < 256; u += C.G) lru_pass<1>(C, u >> 4, (u >> 1) & 7, u & 1, o); TOC(C, 16); }
}
__device__ __forceinline__ void odd_phase3(Ctx& C) {
    TIC(C, 12); for (int u = C.vcu * 2 + (C.wave >> 2); u < 2048; u += 2 * C.G) hg3_wave_unit(C, u >> 7, (u >> 5) & 3, u & 31, C.wave & 3); TOC(C, 12);
}
#ifndef REP_GEMM
#define REP_GEMM 1
#endif
#ifndef REP_EVEN
#define REP_EVEN 1
#endif
#ifndef REP_ODD
#define REP_ODD 1
#endif
__global__ void __launch_bounds__(NWAVES * 64, 2) mega_fwd(Params prm) {
    extern __shared__ __attribute__((aligned(16))) unsigned char lds_raw[];
    Ctx C0;
    Ctx& C = C0;
    C.lds = (LAS unsigned char*)lds_raw;
    volatile LAS unsigned* MISC = (volatile LAS unsigned*)(C.lds + LDSCTL_OFF);
    C.tid = threadIdx.x; C.lane = C.tid & 63; C.wave = __builtin_amdgcn_readfirstlane(C.tid >> 6);
    C.G = gridDim.x; { const int bx = blockIdx.x; C.vcu = (C.G % 8 == 0) ? (bx % 8) * (C.G / 8) + bx / 8 : bx; }
    C.ws = (GAS unsigned char*)prm.ws;
    gu32* ctl = (gu32*)((GAS unsigned char*)prm.ws + WS_CTL);
    for (int u = C.tid; u < (LDS_BYTES - LDSCTL_OFF) / 4; u += NWAVES * 64) ((LAS unsigned*)(C.lds + LDSCTL_OFF))[u] = 0u;
    __syncthreads();
    XcdBarrier bar = xcd_barrier_post((unsigned*)(ctl + CW_BAR), MISC + 8);
    const unsigned my_xcc = bar.x;
#define GRID_BAR() do { GAS unsigned char* wsb_ = C0.ws; asm volatile("" : "+s"(wsb_)); XcdBarrier bb_; bb_.bar = (unsigned*)(wsb_ + WS_CTL) + CW_BAR; bb_.x = my_xcc; bb_.st = (volatile LAS unsigned*)(C0.lds + LDSCTL_OFF) + 8; TIC(C0, 7); xcd_barrier(bb_); TOC(C0, 7); } while (0)
#define FRESH() Ctx C = C0; asm volatile("" : "+v"(C.tid)); C.lane = C.tid & 63; C.wave = __builtin_amdgcn_readfirstlane(C.tid >> 6); asm volatile("" : "+s"(C.ws)); asm volatile("" : "+s"(C.vcu))

    { FRESH(); TIC(C, 6); p0_prologue(C); TOC(C, 6); }
    GRID_BAR();

    for (int L = 0; L < 4; ++L) {
        const bool even = (L & 1) == 0; const int li = L >> 1;
        for (int rep = 0; rep < REP_GEMM; ++rep) { if (rep) GRID_BAR(); FRESH();
            const int N = even ? EVEN_IN : ODD_IN;
            const size_t woff = (L == 0) ? WS_WIN0 : (L == 1) ? WS_WIN1 : (L == 2) ? WS_WIN2 : WS_WIN3;
            pg8::Gemm g{C_XN, (const bf16*)(C.ws + woff), MTOK, N, DM}; pg8::StaticOrder S; S.init(MTOK, N, C.G, (int)blockIdx.x);
            pg8::EpiProj E{C_PROJ, N, C_VT0, even ? E_RV : O_HI, C_VT1, even ? E_SV : -100000, 1};
            TIC(C, 8); pg8::gemm_phase<pg8::EpiProj, pg8::StaticOrder, true, true>(C.lds, g, S, E); TOC(C, 8);
        }
        GRID_BAR();
        if (even) { for (int rep = 0; rep < REP_EVEN; ++rep) { { FRESH(); opt_even_mixer(C, li + 2 * rep); } GRID_BAR(); } }
        else { for (int rep = 0; rep < REP_ODD; ++rep) { { FRESH(); odd_phase1(C, li); } GRID_BAR(); { FRESH(); odd_phase2(C, li); } GRID_BAR(); { FRESH(); odd_phase3(C); } GRID_BAR(); } }
        for (int rep = 0; rep < REP_GEMM; ++rep) { if (rep) GRID_BAR(); FRESH();
            pg8::Gemm g{C_MIX, (const bf16*)(C.ws + WS_WOUT + (size_t)L * 2 * MiB), MTOK, DM, DM}; pg8::StaticOrder S; S.init(MTOK, DM, C.G, (int)blockIdx.x);
            pg8::EpiProj E{C_PROJ, DM, nullptr, -100000, nullptr, -100000, 1};
            pg8::gemm_phase<pg8::EpiProj, pg8::StaticOrder, true, true>(C.lds, g, S, E);
        }
        GRID_BAR();
        { FRESH(); TIC(C, 5); norm_rows_phase(C, C_PROJ, L == 0 ? IN(0) : OUTP(), IN(2) + (size_t)L * DM, L < 3 ? IN(1) + (size_t)(L + 1) * DM : nullptr); TOC(C, 5); }
        if (L < 3) GRID_BAR();
    }
    if (TSCALE && blockIdx.x == 0 && C0.tid == 0) { const unsigned acc = *TWORD(C0); const long long t0 = (long long)__builtin_amdgcn_s_memrealtime(); while ((long long)__builtin_amdgcn_s_memrealtime() - t0 < (long long)acc * TSCALE) __builtin_amdgcn_s_sleep(8); }
}

extern "C" void kernel_launch(void* const* d_in, const int* in_sizes, int n_in, void* d_out, int out_size, void* d_ws, size_t ws_size, hipStream_t stream) {
    static int grid = 0;
    if (grid == 0) {
        if (n_in != 15 || in_sizes[0] != MTOK * DM || out_size != MTOK * DM || ws_size < WS_END) { fprintf(stderr, "kernel_launch: unexpected shapes (n_in %d, in0 %d, out %d, ws %zu)\n", n_in, n_in > 0 ? in_sizes[0] : -1, out_size, ws_size); grid = -1; return; }
        int dev = 0, cus = 0, per_cu = 0;
        if (hipGetDevice(&dev) != hipSuccess || hipDeviceGetAttribute(&cus, hipDeviceAttributeMultiprocessorCount, dev) != hipSuccess) { grid = -1; return; }
        if (hipFuncSetAttribute((const void*)mega_fwd, hipFuncAttributeMaxDynamicSharedMemorySize, LDS_BYTES) != hipSuccess) { fprintf(stderr, "kernel_launch: hipFuncSetAttribute failed\n"); grid = -1; return; }
        if (hipOccupancyMaxActiveBlocksPerMultiprocessor(&per_cu, (const void*)mega_fwd, NWAVES * 64, LDS_BYTES) != hipSuccess || per_cu < 1) { fprintf(stderr, "kernel_launch: occupancy query reports %d blocks per CU\n", per_cu); (void)hipGetLastError(); per_cu = 1; }
        grid = cus;
    }
    if (grid < 0) return;
    if (hipMemsetAsync((char*)d_ws + WS_CTL, 0, CTL_ZERO_BYTES, stream) != hipSuccess) { fprintf(stderr, "kernel_launch: memset failed\n"); return; }
    Params a{};
    for (int i = 0; i < 15; ++i) a.in[i] = (const float*)d_in[i];
    a.out = (float*)d_out; a.ws = (unsigned char*)d_ws;
    hipLaunchKernelGGL(mega_fwd, dim3(grid), dim3(NWAVES * 64), LDS_BYTES, stream, a);
    const hipError_t le = hipPeekAtLastError();
    if (le != hipSuccess) fprintf(stderr, "kernel_launch: launch failed: %s\n", hipGetErrorName(le));
}
```

```cpp
#include <hip/hip_runtime.h>
#include <cstdio>
#include <cstdint>
#include <cmath>
namespace pg8 {
#define PG8_LAS __attribute__((address_space(3)))
typedef unsigned short bf16_t;
typedef short bf16x8 __attribute__((ext_vector_type(8)));
typedef float f32x4 __attribute__((ext_vector_type(4)));
typedef unsigned u32x4 __attribute__((ext_vector_type(4)));
constexpr int BM = 256, BK = 64, HALF = 128, HTB = HALF * BK * 2  , STAGE_BYTES = 8 * HTB, NXCD = 8, WGM = 8;

__host__ __device__ __forceinline__ int lds_byte(int r, int c) { const int st = (r >> 4) * 2 + (c >> 5), rr = r & 15, cc = c & 31, ob = rr * 64 + cc * 2; return st * 1024 + (ob ^ (((ob >> 9) & 1) << 5)); }
__host__ __device__ __forceinline__ void stage_rc(int b, int& R, int& C) { const int st = b / 1024, sb = b % 1024, swz = sb ^ (((sb >> 9) & 1) << 5); R = (st >> 1) * 16 + swz / 64; C = (st & 1) * 32 + (swz % 64) / 2; }
__host__ __device__ __forceinline__ int perm32(int rho) { const int n = rho >> 4, i = rho & 15; return 8 * (i >> 2) + 4 * n + (i & 3); }

struct Unit { int pm, pn; };
struct Gemm { const bf16_t* A; const bf16_t* Bt; int M, N, K; };

struct StaticOrder {
    int nM, nN, nwg, G, c;
    __host__ __device__ void init(int M, int N, int G_, int c_) { nM = M / BM; nN = N / BM; nwg = nM * nN; G = G_; c = c_; }
    __host__ __device__ bool next(int i, Unit& u) const {
        const long L = (long)i * G + c; if (L >= nwg) return false;
        int wgid = (int)L; { const int q = nwg / NXCD, r = nwg % NXCD, xcd = wgid % NXCD, off = wgid / NXCD; wgid = (xcd < r ? xcd * (q + 1) : r * (q + 1) + (xcd - r) * q) + off; }
        const int nig = WGM * nN, gid = wgid / nig, fm = gid * WGM, gsz = (nM - fm) < WGM ? (nM - fm) : WGM;
        u.pm = fm + ((wgid % nig) % gsz); u.pn = (wgid % nig) / gsz; return true;
    }
    __device__ __forceinline__ void a_ready(const Unit&) const {}
    __device__ __forceinline__ void done(const Unit&) const {}
};

__device__ __forceinline__ unsigned cvt_pk_bf16(float lo, float hi) { unsigned r; asm volatile("v_cvt_pk_bf16_f32 %0, %1, %2" : "=v"(r) : "v"(lo), "v"(hi)); return r; }
struct EpiProj {
    static constexpr bool PERM = true, AFTER_DRAIN = false;
    bf16_t* O; int ldc; bf16_t* T0; int lo0; bf16_t* T1; int lo1; int nat;
    __device__ __forceinline__ void operator()(const f32x4 (&acc)[2][2][4][2], const Unit& u, int wr, int wc, int fr, int fq) const {
        const int row0 = u.pm * BM + wr * 64 + fr; const int colt = u.pn * BM;
        const int col0 = colt + wc * 32 + 8 * fq;
        bf16_t* T = nullptr; int cc0 = 0;
        if (colt >= lo0 && colt < lo0 + 512) { T = T0; cc0 = colt - lo0; } else if (colt >= lo1 && colt < lo1 + 512) { T = T1; cc0 = colt - lo1; }
        if (T == nullptr || nat) {
#pragma unroll
            for (int ai = 0; ai < 2; ++ai)
#pragma unroll
                for (int m = 0; m < 4; ++m) { bf16_t* rowp = O + (size_t)(row0 + ai * HALF + m * 16) * ldc + col0;
#pragma unroll
                    for (int bj = 0; bj < 2; ++bj) { const f32x4 v0 = acc[ai][bj][m][0], v1 = acc[ai][bj][m][1];
                        u32x4 w; w.x = cvt_pk_bf16(v0[0], v0[1]); w.y = cvt_pk_bf16(v0[2], v0[3]); w.z = cvt_pk_bf16(v1[0], v1[1]); w.w = cvt_pk_bf16(v1[2], v1[3]);
                        *(u32x4*)(rowp + bj * HALF) = w; } }
        }
        if (T != nullptr) {
            const int b = (u.pm * BM) >> 11; const int s0 = ((u.pm * BM) & 2047) + wr * 64 + fr;
            bf16_t* tb = T + ((size_t)(b * 512 + cc0 + wc * 32 + 8 * fq)) * 2048 + s0;
#pragma unroll
            for (int ai = 0; ai < 2; ++ai)
#pragma unroll
                for (int m = 0; m < 4; ++m)
#pragma unroll
                    for (int bj = 0; bj < 2; ++bj)
#pragma unroll
                        for (int n = 0; n < 2; ++n) { const f32x4 v = acc[ai][bj][m][n];
                            const unsigned p01 = cvt_pk_bf16(v[0], v[1]), p23 = cvt_pk_bf16(v[2], v[3]);
                            bf16_t* q = tb + (size_t)(bj * HALF + 4 * n) * 2048 + ai * HALF + m * 16;
                            q[0] = (bf16_t)(p01 & 0xffffu); q[2048] = (bf16_t)(p01 >> 16); q[2 * 2048] = (bf16_t)(p23 & 0xffffu); q[3 * 2048] = (bf16_t)(p23 >> 16); }
        }
    }
};
template <class Epi, class Sched, bool ALIGN_EPI = false, bool SP2 = false>
__device__ __forceinline__ void gemm_phase(PG8_LAS unsigned char* lds, const Gemm g, const Sched& S, const Epi& E) {
    int tid_ = threadIdx.x; asm volatile("" : "+v"(tid_));
    const int tid = tid_, wid = __builtin_amdgcn_readfirstlane(tid >> 6), lane = tid & 63, wr = wid >> 2, wc = wid & 3, fr = lane & 15, fq = lane >> 4;
    const int K = g.K, nt = K / BK;
    unsigned voffA[2], voffB[2];
#pragma unroll
    for (int i = 0; i < 2; ++i) { int R, C; stage_rc(tid * 16 + i * 8192, R, C); const int Rb = Epi::PERM ? ((R & ~31) + perm32(R & 31)) : R;
        voffA[i] = (unsigned)(R * K + C) * 2u; voffB[i] = (unsigned)(Rb * K + C) * 2u; }
    const size_t kstep = (size_t)(BK * 2);
    const size_t hstep = (size_t)HALF * K * 2;
    const size_t tstep = 2 * hstep;
    const unsigned ldsw = (unsigned)wid * 1024u;
    const int aoff = lds_byte(wr * 64 + fr, fq * 8), boff = lds_byte(wc * 32 + fr, fq * 8);
#define PG8_SA(b, h) (((b) * 2 + (h)) * HTB)
#define PG8_SB(b, h) ((4 + (b) * 2 + (h)) * HTB)
#define PG8_STAGE(bufoff, gbase, voff) do { _Pragma("unroll") for (int _i = 0; _i < 2; ++_i) \
        __builtin_amdgcn_global_load_lds((const unsigned*)((const char*)(gbase) + (voff)[_i]), (PG8_LAS unsigned*)(lds + (bufoff) + ldsw + _i * 8192), 16, 0, 0); } while (0)
#define PG8_LDA(dst, b, h) do { _Pragma("unroll") for (int m = 0; m < 4; ++m) _Pragma("unroll") for (int k = 0; k < 2; ++k) dst[m][k] = *(const PG8_LAS bf16x8*)(lds + PG8_SA(b, h) + aoff + m * 2048 + k * 1024); } while (0)
#define PG8_LDB(dst, b, h) do { _Pragma("unroll") for (int n = 0; n < 2; ++n) _Pragma("unroll") for (int k = 0; k < 2; ++k) dst[n][k] = *(const PG8_LAS bf16x8*)(lds + PG8_SB(b, h) + boff + n * 2048 + k * 1024); } while (0)
#define PG8_MMA(ai, bj, At, Bt) do { __builtin_amdgcn_s_setprio(1); _Pragma("unroll") for (int m = 0; m < 4; ++m) _Pragma("unroll") for (int n = 0; n < 2; ++n) _Pragma("unroll") for (int k = 0; k < 2; ++k) \
        acc[ai][bj][m][n] = __builtin_amdgcn_mfma_f32_16x16x32_bf16(Bt[n][k], At[m][k], acc[ai][bj][m][n], 0, 0, 0); __builtin_amdgcn_s_setprio(0); } while (0)
#define PG8_WAIT_V(n) asm volatile("s_waitcnt vmcnt(" #n ")" ::: "memory")
#define PG8_WAIT_L(n) asm volatile("s_waitcnt lgkmcnt(" #n ")" ::: "memory")
#define PG8_BAR __builtin_amdgcn_s_barrier()
#define PG8_SCHED __builtin_amdgcn_sched_barrier(0)
    Unit cur, nxt; int ui = 0;
    if (!S.next(0, cur)) return;
    f32x4 acc[2][2][4][2];
#pragma unroll
    for (int a = 0; a < 2; ++a)
#pragma unroll
        for (int b = 0; b < 2; ++b)
#pragma unroll
            for (int m = 0; m < 4; ++m)
#pragma unroll
                for (int n = 0; n < 2; ++n) acc[a][b][m][n] = (f32x4){0.f, 0.f, 0.f, 0.f};
    bf16x8 At[4][2], B0[2][2], B1[2][2];
    const char* cA = (const char*)g.A + (size_t)cur.pm * tstep; const char* cB = (const char*)g.Bt + (size_t)cur.pn * tstep;
    S.a_ready(cur);
    if constexpr (SP2) {
        PG8_STAGE(PG8_SB(0, 0), cB, voffB); PG8_STAGE(PG8_SB(0, 1), cB + hstep, voffB); PG8_STAGE(PG8_SA(0, 0), cA, voffA); PG8_STAGE(PG8_SA(0, 1), cA + hstep, voffA);
        if (wr == 1) PG8_BAR;
        PG8_WAIT_V(2); PG8_BAR;
        PG8_STAGE(PG8_SB(1, 0), cB + kstep, voffB); PG8_STAGE(PG8_SA(1, 0), cA + kstep, voffA); PG8_STAGE(PG8_SB(1, 1), cB + hstep + kstep, voffB);
        PG8_WAIT_V(6); PG8_BAR;
    } else {
        PG8_STAGE(PG8_SB(0, 0), cB, voffB); PG8_STAGE(PG8_SA(0, 0), cA, voffA); PG8_STAGE(PG8_SB(0, 1), cB + hstep, voffB); PG8_STAGE(PG8_SA(0, 1), cA + hstep, voffA);
        if (wr == 1) PG8_BAR;
        PG8_WAIT_V(4); PG8_BAR;
        PG8_STAGE(PG8_SB(1, 0), cB + kstep, voffB); PG8_STAGE(PG8_SA(1, 0), cA + kstep, voffA); PG8_STAGE(PG8_SB(1, 1), cB + hstep + kstep, voffB);
        PG8_WAIT_V(6); PG8_BAR;
    }
    for (;;) {
        const bool has_next = S.next(ui + 1, nxt);
        const char* nA = has_next ? (const char*)g.A + (size_t)nxt.pm * tstep : cA; const char* nB = has_next ? (const char*)g.Bt + (size_t)nxt.pn * tstep : cB;
        for (int t = 0; t < nt; t += 2) {
            const bool last = (t == nt - 2);
            const char* a1 = cA + (size_t)(t + 1) * kstep;
            const char* a2 = last ? nA : cA + (size_t)(t + 2) * kstep; const char* b2 = last ? nB : cB + (size_t)(t + 2) * kstep;
            const char* a3 = a2 + kstep; const char* b3 = b2 + kstep;
            if (last && has_next) S.a_ready(nxt);
            if constexpr (SP2) {
            PG8_LDB(B0, 0, 0); PG8_LDB(B1, 0, 1); PG8_SCHED; PG8_LDA(At, 0, 0); PG8_STAGE(PG8_SA(1, 1), a1 + hstep, voffA);
            PG8_WAIT_V(8); PG8_WAIT_L(0); PG8_BAR; PG8_MMA(0, 0, At, B0); PG8_MMA(0, 1, At, B1); PG8_BAR; PG8_SCHED;
            PG8_LDA(At, 0, 1); PG8_STAGE(PG8_SB(0, 0), b2, voffB); PG8_STAGE(PG8_SB(0, 1), b2 + hstep, voffB); PG8_STAGE(PG8_SA(0, 0), a2, voffA);
            PG8_WAIT_V(8); PG8_WAIT_L(0); PG8_BAR; PG8_MMA(1, 0, At, B0); PG8_MMA(1, 1, At, B1); PG8_BAR; PG8_SCHED;
            PG8_LDB(B0, 1, 0); PG8_LDB(B1, 1, 1); PG8_SCHED; PG8_LDA(At, 1, 0); PG8_STAGE(PG8_SA(0, 1), a2 + hstep, voffA);
            PG8_WAIT_V(8); PG8_WAIT_L(0); PG8_BAR; PG8_MMA(0, 0, At, B0); PG8_MMA(0, 1, At, B1); PG8_BAR; PG8_SCHED;
            PG8_LDA(At, 1, 1); PG8_STAGE(PG8_SB(1, 0), b3, voffB); PG8_STAGE(PG8_SB(1, 1), b3 + hstep, voffB); PG8_STAGE(PG8_SA(1, 0), a3, voffA);
            PG8_WAIT_V(8); PG8_WAIT_L(0); PG8_BAR; PG8_MMA(1, 0, At, B0); PG8_MMA(1, 1, At, B1); PG8_BAR; PG8_SCHED;
            } else {
            PG8_LDB(B0, 0, 0); PG8_SCHED; PG8_LDA(At, 0, 0); PG8_STAGE(PG8_SA(1, 1), a1 + hstep, voffA);
            PG8_WAIT_L(8); PG8_BAR; PG8_WAIT_L(0); PG8_MMA(0, 0, At, B0); PG8_BAR; PG8_SCHED;
            PG8_LDB(B1, 0, 1); PG8_STAGE(PG8_SB(0, 0), b2, voffB);
            PG8_BAR; PG8_WAIT_L(0); PG8_MMA(0, 1, At, B1); PG8_BAR;
            PG8_LDA(At, 0, 1); PG8_STAGE(PG8_SA(0, 0), a2, voffA);
            PG8_BAR; PG8_WAIT_L(0); PG8_MMA(1, 0, At, B0); PG8_BAR; PG8_SCHED;
            PG8_STAGE(PG8_SB(0, 1), b2 + hstep, voffB);
            PG8_WAIT_V(6); PG8_BAR; PG8_MMA(1, 1, At, B1); PG8_BAR;
            PG8_LDB(B0, 1, 0); PG8_SCHED; PG8_LDA(At, 1, 0); PG8_STAGE(PG8_SA(0, 1), a2 + hstep, voffA);
            PG8_WAIT_L(8); PG8_BAR; PG8_WAIT_L(0); PG8_MMA(0, 0, At, B0); PG8_BAR; PG8_SCHED;
            PG8_LDB(B1, 1, 1); PG8_STAGE(PG8_SB(1, 0), b3, voffB);
            PG8_BAR; PG8_WAIT_L(0); PG8_MMA(0, 1, At, B1); PG8_BAR;
            PG8_LDA(At, 1, 1); PG8_STAGE(PG8_SA(1, 0), a3, voffA);
            PG8_BAR; PG8_WAIT_L(0); PG8_MMA(1, 0, At, B0); PG8_BAR; PG8_SCHED;
            PG8_STAGE(PG8_SB(1, 1), b3 + hstep, voffB);
            PG8_WAIT_V(6); PG8_BAR; PG8_MMA(1, 1, At, B1); PG8_BAR;
            }
        }
        if constexpr (ALIGN_EPI) { if (wr == 0) PG8_BAR; }
        if constexpr (!Epi::AFTER_DRAIN) { E(acc, cur, wr, wc, fr, fq); S.done(cur); }
        if (!has_next) break;
#pragma unroll
        for (int a = 0; a < 2; ++a)
#pragma unroll
            for (int b = 0; b < 2; ++b)
#pragma unroll
                for (int m = 0; m < 4; ++m)
#pragma unroll
                    for (int n = 0; n < 2; ++n) acc[a][b][m][n] = (f32x4){0.f, 0.f, 0.f, 0.f};
        cur = nxt; cA = nA; cB = nB; ++ui;
        if constexpr (ALIGN_EPI) { if (wr == 1) PG8_BAR; }
    }
    PG8_WAIT_V(0);
    if constexpr (!ALIGN_EPI) { if (wr == 0) PG8_BAR; }
    PG8_BAR;
    if constexpr (Epi::AFTER_DRAIN) { E.fused(acc, cur, wr, wc, fr, fq, lds, wid, lane); S.done(cur); }
#undef PG8_SA
#undef PG8_SB
#undef PG8_STAGE
#undef PG8_LDA
#undef PG8_LDB
#undef PG8_MMA
#undef PG8_WAIT_V
#undef PG8_WAIT_L
#undef PG8_BAR
#undef PG8_SCHED
}
}
#define GAS __attribute__((address_space(1)))
#define LAS __attribute__((address_space(3)))
typedef unsigned short bf16;
typedef unsigned v4u __attribute__((ext_vector_type(4)));
typedef float f32x4 __attribute__((ext_vector_type(4)));
typedef short bf16x8 __attribute__((ext_vector_type(8)));
typedef GAS unsigned gu32;
typedef GAS unsigned long long gu64;
#define RLX_AGENT __ATOMIC_RELAXED, __HIP_MEMORY_SCOPE_AGENT
#define LDS_WAIT() asm volatile("s_waitcnt lgkmcnt(0)" ::: "memory")
#define VM_WAIT() asm volatile("s_waitcnt vmcnt(0)" ::: "memory")
__device__ __forceinline__ unsigned long long rt() { return __builtin_amdgcn_s_memrealtime(); }
__device__ __forceinline__ unsigned f2bf(float f) { unsigned u = __builtin_bit_cast(unsigned, f); return (u + 0x7fffu + ((u >> 16) & 1u)) >> 16; }
__device__ __forceinline__ unsigned pk2(float lo, float hi) { return f2bf(lo) | (f2bf(hi) << 16); }

#define XB_TMO      128
#define XB_XCNT(j)  (256  + 64 * (j))
#define XB_XSUB(j)  (1280 + 64 * (j))
#define XB_XGEN(j)  (2304 + 64 * (j))
#define XB_TOP      3328
#define XB_TOPGEN   3392
#define XCD_BAR_WORDS 3456
#define XB_SPIN_CAP (1u << 22)

__device__ __forceinline__ unsigned xb_ld(unsigned* p)              { return __hip_atomic_load(p, __ATOMIC_RELAXED, __HIP_MEMORY_SCOPE_AGENT); }
__device__ __forceinline__ unsigned xb_add(unsigned* p, unsigned v) { return __hip_atomic_fetch_add(p, v, __ATOMIC_RELAXED, __HIP_MEMORY_SCOPE_AGENT); }
__device__ __forceinline__ unsigned xb_xcc_id() { return (unsigned)__builtin_amdgcn_s_getreg((3 << 11) | 20) & 0xFu; }
#define XB_SPIN(cond, bar) do { unsigned _sp = 0; while (cond) { __builtin_amdgcn_s_sleep(1); \
    if ((++_sp & 255u) == 0u) { if (xb_ld(&(bar)[XB_TMO])) break; if (_sp > XB_SPIN_CAP) { atomicAdd(&(bar)[XB_TMO], 1u); break; } } } } while (0)

struct XcdBarrier {
    unsigned* bar; unsigned x;
    volatile LAS unsigned* st;
};

__device__ __forceinline__ XcdBarrier xcd_barrier_post(unsigned* bar, volatile LAS unsigned* st) {
    XcdBarrier b; b.bar = bar; b.x = xb_xcc_id(); b.st = st;
    if (threadIdx.x == 0) (void)xb_add(&bar[XB_XCNT(b.x)], 1u);
    return b;
}
__device__ __forceinline__ void xcd_barrier_complete(unsigned* bar, unsigned x, unsigned& nloc, unsigned& nx) {
    const unsigned G = gridDim.x * gridDim.y * gridDim.z;
    unsigned sum, cnt, mine, sp = 0u;
    for (;;) {
        sum = 0u; cnt = 0u; mine = 0u;
#pragma unroll
        for (unsigned j = 0; j < 16; ++j) { const unsigned c = xb_ld(&bar[XB_XCNT(j)]); sum += c; cnt += (c > 0u) ? 1u : 0u; mine = (j == x) ? c : mine; }
        if (sum == G) break;
        __builtin_amdgcn_s_sleep(1);
        if ((++sp & 255u) == 0u) { if (xb_ld(&bar[XB_TMO])) break; if (sp > XB_SPIN_CAP) { atomicAdd(&bar[XB_TMO], 1u); break; } }
    }
    nloc = mine > 0u ? mine : 1u; nx = cnt > 0u ? cnt : 1u;
}

__device__ __forceinline__ void xcd_barrier(const XcdBarrier& b) {
    asm volatile("s_waitcnt vmcnt(0)" ::: "memory");
    __syncthreads();
    if (threadIdx.x == 0) {
        unsigned* bar = b.bar;
        __builtin_amdgcn_s_waitcnt(0);
        unsigned nloc = b.st[0], nx = b.st[1];
        if (nloc == 0u) { xcd_barrier_complete(bar, b.x, nloc, nx); b.st[0] = nloc; b.st[1] = nx; }
        const unsigned old = xb_add(&bar[XB_XSUB(b.x)], 1u);
        const unsigned gen = old / nloc;
        if (old + 1u == (gen + 1u) * nloc) {
            __builtin_amdgcn_fence(__ATOMIC_RELEASE, "agent");
            asm volatile("s_waitcnt vmcnt(0)" ::: "memory");
            const unsigned og = xb_add(&bar[XB_TOP], 1u);
            const unsigned tg = og / nx;
            if (og + 1u == (tg + 1u) * nx) xb_add(&bar[XB_TOPGEN], 1u);
            else XB_SPIN(xb_ld(&bar[XB_TOPGEN]) == tg, bar);
            __builtin_amdgcn_fence(__ATOMIC_ACQUIRE, "agent");
            xb_add(&bar[XB_XGEN(b.x)], 1u);
            asm volatile("s_waitcnt vmcnt(0)" ::: "memory");
        } else {
            XB_SPIN(xb_ld(&bar[XB_XGEN(b.x)]) == gen, bar);
            __builtin_amdgcn_fence(__ATOMIC_ACQUIRE, "agent");
            asm volatile("s_waitcnt vmcnt(0)" ::: "memory");
        }
    }
    __syncthreads();
}
constexpr int NWAVES = 8;
constexpr int BATCH = 16, SEQ = 2048, DM = 1024, MTOK = BATCH * SEQ;
constexpr int EVEN_IN = 3584, ODD_IN = 3072;
constexpr int E_RQ = 0, E_RK = 256, E_RV = 512, E_RG = 1024, E_SQ = 1536, E_SK = 2048, E_SV = 2560, E_SG = 3072;
constexpr int O_HQ = 0, O_HF = 512, O_HI = 1024, O_HG = 1536, O_LX = 2048, O_LG = 2560;
constexpr float EPS = 1e-6f;
constexpr size_t MiB = 1u << 20;
constexpr size_t WS_CTL = 0, CTL_ZERO_BYTES = 1 * MiB;
constexpr size_t WS_WIN0 = 2 * MiB, WS_WIN1 = 9 * MiB, WS_WIN2 = 15 * MiB, WS_WIN3 = 22 * MiB;
constexpr size_t WS_WOUT = 28 * MiB;
constexpr size_t WS_TAB = 36 * MiB;
constexpr size_t WS_LB = 36 * MiB + 768 * 1024;
constexpr size_t WS_XN = 40 * MiB;
constexpr size_t WS_MIX = 104 * MiB;
constexpr size_t WS_PROJ = 168 * MiB;
constexpr size_t WS_VT0 = 392 * MiB, WS_VT1 = 424 * MiB;
constexpr size_t WS_KST = 456 * MiB;
constexpr size_t WS_END = 488 * MiB;
constexpr int CW_BAR = 4096;
constexpr int RING_BYTES = 131072;
constexpr int LDS_BYTES = 147456;
constexpr int LDSCTL_OFF = LDS_BYTES - 512;
constexpr int XTRA_OFF = RING_BYTES;
__device__ __forceinline__ float bf2f(bf16 u) { return __uint_as_float((unsigned)u << 16); }
__device__ __forceinline__ float wave_sum(float v) {
#pragma unroll
    for (int o = 1; o < 64; o <<= 1) v += __shfl_xor(v, o);
    return v;
}
__device__ __forceinline__ float sigmoidf_(float x) { return 1.f / (1.f + __expf(-x)); }
__device__ __forceinline__ float siluf_(float x) { return x * __builtin_amdgcn_rcpf(1.f + __expf(-x)); }
__device__ __forceinline__ float log_sigmoidf_(float z) { return fminf(z, 0.f) - log1pf(__expf(-fabsf(z))); }

#ifndef TSCALE
#define TSCALE 0
#endif
#define TWORD(C) ((volatile LAS unsigned*)((C).lds + LDSCTL_OFF) + 16)
#define TIC(C, sel) long long tic_##sel = 0; if (TSCALE && TSEL == sel && blockIdx.x == 0 && (C).wave == 0) tic_##sel = (long long)__builtin_amdgcn_s_memrealtime()
#define TOC(C, sel) do { if (TSCALE && TSEL == sel && blockIdx.x == 0 && (C).wave == 0) { const unsigned d_ = (unsigned)((long long)__builtin_amdgcn_s_memrealtime() - tic_##sel); if ((C).lane == 0) *TWORD(C) = *TWORD(C) + d_; } } while (0)
#ifndef TSEL
#define TSEL 0
#endif
struct Ctx {
    LAS unsigned char* lds;
    int tid, lane, wave, vcu, G;
    GAS unsigned char* ws;
};
struct Params { const float* in[15]; float* out; unsigned char* ws; };
__device__ __forceinline__ const float* IN(int i) { return (const float*)(const GAS float*)(((const __attribute__((address_space(4))) Params*)__builtin_amdgcn_kernarg_segment_ptr())->in[i]); }
__device__ __forceinline__ float* OUTP() { return (float*)(GAS float*)(((const __attribute__((address_space(4))) Params*)__builtin_amdgcn_kernarg_segment_ptr())->out); }
#define C_XN   ((bf16*)(C.ws + WS_XN))
#define C_MIX  ((bf16*)(C.ws + WS_MIX))
#define C_OI   ((bf16*)(C.ws + WS_XN + 32 * MiB))
#define C_PROJ ((bf16*)(C.ws + WS_PROJ))
#define C_VT0  ((bf16*)(C.ws + WS_VT0))
#define C_VT1  ((bf16*)(C.ws + WS_VT1))
#define C_KST  ((bf16*)(C.ws + WS_KST))
#define C_TABC ((const float*)(C.ws + WS_TAB))
#define C_TABS ((const float*)(C.ws + WS_TAB) + SEQ * 32)
#define C_LB   ((const float*)(C.ws + WS_LB))

__device__ __forceinline__ void p0_transpose_item(const float* W, int K, int N, bf16* WT, LAS float* scr, int item, int lane) {
    const int nblk = N / 32, kb = item / nblk, nb = item % nblk, k0 = 64 * kb, n0 = 32 * nb;
#pragma unroll 8
    for (int i = 0; i < 32; ++i) { const int kk = 2 * i + (lane >> 5); scr[kk * 33 + (lane & 31)] = W[(size_t)(k0 + kk) * N + n0 + (lane & 31)]; }
    LDS_WAIT(); asm volatile("" ::: "memory");
    const int c = lane & 7;
#pragma unroll
    for (int j = 0; j < 4; ++j) { const int n = (lane >> 3) + 8 * j; const LAS float* s = scr + (8 * c) * 33 + n;
        v4u o; o.x = pk2(s[0 * 33], s[1 * 33]); o.y = pk2(s[2 * 33], s[3 * 33]); o.z = pk2(s[4 * 33], s[5 * 33]); o.w = pk2(s[6 * 33], s[7 * 33]);
        *(GAS v4u*)(WT + (size_t)(n0 + n) * K + k0 + 8 * c) = o; }
    LDS_WAIT(); asm volatile("" ::: "memory");
}
__device__ __forceinline__ void rms_row_to_bf16(const float* xrow, const float* w, bf16* orow, int lane) {
    const GAS f32x4* xr = (const GAS f32x4*)xrow + lane; const GAS f32x4* wr = (const GAS f32x4*)w + lane;
    f32x4 v[4]; float s = 0.f;
#pragma unroll
    for (int j = 0; j < 4; ++j) { v[j] = xr[64 * j]; s += (v[j].x * v[j].x + v[j].y * v[j].y) + (v[j].z * v[j].z + v[j].w * v[j].w); }
    const float rstd = rsqrtf(wave_sum(s) * (1.f / DM) + EPS);
    GAS unsigned long long* o8 = (GAS unsigned long long*)orow + lane;
#pragma unroll
    for (int j = 0; j < 4; ++j) { const f32x4 g = wr[64 * j];
        o8[64 * j] = (unsigned long long)pk2(v[j].x * rstd * g.x, v[j].y * rstd * g.y) | ((unsigned long long)pk2(v[j].z * rstd * g.z, v[j].w * rstd * g.w) << 32); }
}
__device__ __forceinline__ void p0_prologue(Ctx& C) {
    LAS float* scr = (LAS float*)(C.lds + C.wave * 16384);
    const int gw = C.vcu * NWAVES + C.wave, NGW = C.G * NWAVES;
    constexpr int I_E = (DM / 64) * (EVEN_IN / 32), I_O = (DM / 64) * (ODD_IN / 32), I_W = (DM / 64) * (DM / 32);
    constexpr int NITEMS = 2 * I_E + 2 * I_O + 4 * I_W;
    for (int it = gw; it < NITEMS; it += NGW) {
        int r = it;
        if (r < 2 * I_E) { const int e = r / I_E; p0_transpose_item(IN(3) + (size_t)e * DM * EVEN_IN, DM, EVEN_IN, (bf16*)(C.ws + (e ? WS_WIN2 : WS_WIN0)), scr, r % I_E, C.lane); continue; } r -= 2 * I_E;
        if (r < 2 * I_O) { const int o = r / I_O; p0_transpose_item(IN(5) + (size_t)o * DM * ODD_IN, DM, ODD_IN, (bf16*)(C.ws + (o ? WS_WIN3 : WS_WIN1)), scr, r % I_O, C.lane); continue; } r -= 2 * I_O;
        { const int l = r / I_W; const float* src = (l & 1) ? IN(6) + (size_t)(l >> 1) * DM * DM : IN(4) + (size_t)(l >> 1) * DM * DM;
          p0_transpose_item(src, DM, DM, (bf16*)(C.ws + WS_WOUT + (size_t)l * 2 * MiB), scr, r % I_W, C.lane); }
    }
    for (int m = gw; m < MTOK; m += NGW) rms_row_to_bf16(IN(0) + (size_t)m * DM, IN(1), C_XN + (size_t)m * DM, C.lane);
    float* tc = (float*)(C.ws + WS_TAB); float* ts = tc + SEQ * 32;
    for (int e = C.vcu * 512 + C.tid; e < SEQ * 32; e += C.G * 512) {
        const int t = e >> 5, i = e & 31;
        const float inv = powf(10000.0f, -(float)i / 32.0f);
        const float ang = (float)t * inv;
        double r = (double)ang * 0.15915494309189533577; r -= floor(r);
        const float rev = (float)r;
        tc[e] = __builtin_amdgcn_cosf(rev); ts[e] = __builtin_amdgcn_sinf(rev);
    }
    float* lbp = (float*)(C.ws + WS_LB);
    if (C.vcu == 0) for (int c = C.tid; c < 512; c += 512) { const float l0 = IN(7)[c], l1 = IN(7)[512 + c]; lbp[c] = 0.f; lbp[512 + c] = 1.f / (1.f + expf(l0 - l1)); }
}

__device__ __forceinline__ void norm_rows_phase(Ctx& C, const bf16* Y, const float* xsrc, const float* wpost, const float* wpre_next) {
    const int gw = C.vcu * NWAVES + C.wave, NGW = C.G * NWAVES;
    for (int m = gw; m < MTOK; m += NGW) {
        const GAS unsigned long long* yr = (const GAS unsigned long long*)(Y + (size_t)m * DM) + C.lane;
        const GAS f32x4* xr = (const GAS f32x4*)(xsrc + (size_t)m * DM) + C.lane;
        GAS f32x4* xo = (GAS f32x4*)(OUTP() + (size_t)m * DM) + C.lane;
        f32x4 y[4], x[4]; float s = 0.f;
#pragma unroll
        for (int j = 0; j < 4; ++j) { const unsigned long long w = yr[64 * j]; x[j] = xr[64 * j];
            y[j].x = __uint_as_float(((unsigned)w) << 16); y[j].y = __uint_as_float(((unsigned)w) & 0xffff0000u);
            y[j].z = __uint_as_float(((unsigned)(w >> 32)) << 16); y[j].w = __uint_as_float(((unsigned)(w >> 32)) & 0xffff0000u);
            s += (y[j].x * y[j].x + y[j].y * y[j].y) + (y[j].z * y[j].z + y[j].w * y[j].w); }
        const float rstd = rsqrtf(wave_sum(s) * (1.f / DM) + EPS); float s2 = 0.f;
#pragma unroll
        for (int j = 0; j < 4; ++j) { const f32x4 g = ((const GAS f32x4*)wpost + C.lane)[64 * j];
            x[j].x += y[j].x * rstd * g.x; x[j].y += y[j].y * rstd * g.y; x[j].z += y[j].z * rstd * g.z; x[j].w += y[j].w * rstd * g.w;
            xo[64 * j] = x[j];
            s2 += (x[j].x * x[j].x + x[j].y * x[j].y) + (x[j].z * x[j].z + x[j].w * x[j].w); }
        if (wpre_next) {
            const float r2 = rsqrtf(wave_sum(s2) * (1.f / DM) + EPS);
            GAS unsigned long long* o8 = (GAS unsigned long long*)(C_XN + (size_t)m * DM) + C.lane;
#pragma unroll
            for (int j = 0; j < 4; ++j) { const f32x4 g = ((const GAS f32x4*)wpre_next + C.lane)[64 * j];
                o8[64 * j] = (unsigned long long)pk2(x[j].x * r2 * g.x, x[j].y * r2 * g.y) | ((unsigned long long)pk2(x[j].z * r2 * g.z, x[j].w * r2 * g.w) << 32); }
        }
    }
}

__device__ __forceinline__ void unpack8(const v4u w, float* f) {
    f[0] = __uint_as_float(w.x << 16); f[1] = __uint_as_float(w.x & 0xffff0000u); f[2] = __uint_as_float(w.y << 16); f[3] = __uint_as_float(w.y & 0xffff0000u);
    f[4] = __uint_as_float(w.z << 16); f[5] = __uint_as_float(w.z & 0xffff0000u); f[6] = __uint_as_float(w.w << 16); f[7] = __uint_as_float(w.w & 0xffff0000u);
}
__device__ __forceinline__ void naive_ret_token(Ctx& C, int b, int h, int t) {
    const int lane = C.lane; const size_t rs = EVEN_IN;
    const bf16* P = C_PROJ; const size_t m = (size_t)b * SEQ + t;
    float qa[32], qb[32];
    {
        float q[64];
#pragma unroll
        for (int c = 0; c < 8; ++c) unpack8(*(const GAS v4u*)(P + m * rs + E_RQ + h * 64 + 8 * c), q + 8 * c);
#pragma unroll
        for (int i = 0; i < 32; ++i) { const float cs = C_TABC[t * 32 + i], sn = C_TABS[t * 32 + i]; qa[i] = q[i] * cs - q[32 + i] * sn; qb[i] = q[i] * sn + q[32 + i] * cs; }
    }
    const float lg2 = log2f(1.0f - exp2f(-5.0f - (float)h));
    float o0 = 0.f, o1 = 0.f;
    for (int shi = t; shi >= 0; shi -= 64) {
        const int s = shi - lane; const bool valid = s >= 0; const int sc = valid ? s : 0;
        const size_t ms = (size_t)b * SEQ + sc;
        float k[64];
#pragma unroll
        for (int c = 0; c < 8; ++c) unpack8(*(const GAS v4u*)(P + ms * rs + E_RK + h * 64 + 8 * c), k + 8 * c);
        float acc = 0.f;
#pragma unroll
        for (int i = 0; i < 32; ++i) { const float cs = C_TABC[sc * 32 + i], sn = C_TABS[sc * 32 + i];
            acc += qa[i] * (k[i] * cs - k[32 + i] * sn) + qb[i] * (k[i] * sn + k[32 + i] * cs); }
        const float w = valid ? acc * 0.125f * exp2f((float)(t - s) * lg2) : 0.f;
#pragma unroll 8
        for (int j = 0; j < 64; ++j) { const float wj = __shfl(w, j); const int sj = shi - j; const size_t mj = (size_t)b * SEQ + (sj >= 0 ? sj : 0);
            o0 += wj * bf2f(P[mj * rs + E_RV + h * 128 + lane]); o1 += wj * bf2f(P[mj * rs + E_RV + h * 128 + 64 + lane]); }
    }
    const float rstd = rsqrtf(wave_sum(o0 * o0 + o1 * o1) * (1.f / 128.f) + EPS);
    const float g0 = bf2f(P[m * rs + E_RG + h * 128 + lane]), g1 = bf2f(P[m * rs + E_RG + h * 128 + 64 + lane]);
    C_MIX[m * DM + h * 128 + lane] = (bf16)f2bf(o0 * rstd * siluf_(g0)); C_MIX[m * DM + h * 128 + 64 + lane] = (bf16)f2bf(o1 * rstd * siluf_(g1));
}
template <bool EARLY> __device__ __forceinline__ void naive_sb_token(Ctx& C, int b, int hh, int t) {
    const int lane = C.lane; const size_t rs = EVEN_IN; const bf16* P = C_PROJ; const size_t m = (size_t)b * SEQ + t;
    float q[64];
#pragma unroll
    for (int c = 0; c < 8; ++c) unpack8(*(const GAS v4u*)(P + m * rs + E_SQ + hh * 64 + 8 * c), q + 8 * c);
    float R = 0.f, o = 0.f;
    for (int shi = t - 1; shi >= 0; shi -= 64) {
        const int s = shi - lane; const bool valid = s >= 0; const size_t ms = (size_t)b * SEQ + (valid ? s : 0);
        float acc = 0.f;
#pragma unroll
        for (int c = 0; c < 8; ++c) { float k[8]; unpack8(*(const GAS v4u*)(P + ms * rs + E_SK + hh * 64 + 8 * c), k);
#pragma unroll
            for (int j = 0; j < 8; ++j) acc += q[8 * c + j] * k[j]; }
        const float z = acc * 0.125f, lb = log_sigmoidf_(z), lom = valid ? lb - z : 0.f;
        float incl = lom;
#pragma unroll
        for (int off = 1; off < 64; off <<= 1) { const float tmp = __shfl_up(incl, off); if (lane >= off) incl += tmp; }
        const float w = valid ? __expf(lb + R + (incl - lom)) : 0.f;
        R += __shfl(incl, 63);
#pragma unroll 8
        for (int j = 0; j < 64; ++j) { const float wj = __shfl(w, j); const int sj = shi - j; const size_t mj = (size_t)b * SEQ + (sj >= 0 ? sj : 0);
            o += wj * bf2f(P[mj * rs + E_SV + hh * 64 + lane]); }
        if (EARLY && R < -100.f) break;
    }
    const float g = bf2f(P[m * rs + E_SG + hh * 64 + lane]);
    C_MIX[m * DM + 512 + hh * 64 + lane] = (bf16)f2bf(o * siluf_(g));
}
__device__ __forceinline__ void naive_even_mixer(Ctx& C) {
    constexpr int NRET = BATCH * 4 * 256, NSB = BATCH * 8 * 256;
    for (int u = C.vcu; u < NRET + NSB; u += C.G) {
        if (u < NRET) { const int bh = u >> 8, tb = (u + bh) & 255; naive_ret_token(C, bh >> 2, bh & 3, tb * 8 + C.wave); }
        else { const int v = u - NRET, bh = v >> 8, tb = (v + bh) & 255; naive_sb_token<false>(C, bh >> 3, bh & 7, tb * 8 + C.wave); }
    }
}
__device__ __forceinline__ void naive_hgrn_unit(Ctx& C, int b, int h, int vs, int o, float* OS) {
    const int tid = C.tid, lane = C.lane, k = tid >> 2, vq = tid & 3; const size_t rs = ODD_IN; const bf16* P = C_PROJ;
    LAS float* red = (LAS float*)C.lds;
    const float lb = C_LB[o * 512 + h * 128 + k];
    float st[8];
#pragma unroll
    for (int j = 0; j < 8; ++j) st[j] = 0.f;
    for (int t0 = 0; t0 < SEQ; t0 += 4) {
        float flv[4], qv[4]; v4u vvv[4];
#pragma unroll
        for (int u = 0; u < 4; ++u) { const size_t m = (size_t)b * SEQ + t0 + u; flv[u] = bf2f(P[m * rs + O_HF + h * 128 + k]); qv[u] = bf2f(P[m * rs + O_HQ + h * 128 + k]);
            vvv[u] = *(const GAS v4u*)(P + m * rs + O_HI + h * 128 + vs * 32 + vq * 8); }
#pragma unroll
        for (int u = 0; u < 4; ++u) {
            const int t = t0 + u; const size_t m = (size_t)b * SEQ + t;
            const float fl = flv[u], q = qv[u];
            const float sig = 1.f / (1.f + __expf(-fl)), f = lb + (1.f - lb) * sig, kk = (1.f - lb) / (1.f + __expf(fl));
            float v[8]; unpack8(vvv[u], v);
            float part[8];
#pragma unroll
            for (int j = 0; j < 8; ++j) { st[j] = f * st[j] + kk * v[j]; part[j] = q * st[j]; }
#pragma unroll
            for (int j = 0; j < 8; ++j) { part[j] += __shfl_xor(part[j], 4); part[j] += __shfl_xor(part[j], 8); part[j] += __shfl_xor(part[j], 16); part[j] += __shfl_xor(part[j], 32); }
            LAS float* rb = red + (t & 1) * 256;
            if (lane < 4) {
#pragma unroll
                for (int j = 0; j < 8; ++j) rb[C.wave * 32 + vq * 8 + j] = part[j];
            }
            __syncthreads();
            if (tid < 32) { float s = 0.f;
#pragma unroll
                for (int w = 0; w < 8; ++w) s += rb[w * 32 + tid];
                OS[m * 512 + h * 128 + vs * 32 + tid] = s; }
        }
    }
    __syncthreads();
}
__device__ __forceinline__ void naive_lru_unit(Ctx& C, int b, int n, int o) {
    const int lane = C.lane, wave = C.wave; const size_t rs = ODD_IN; const bf16* P = C_PROJ;
    LAS float* AU = (LAS float*)C.lds;
    LAS float* xb = (LAS float*)(C.lds + XTRA_OFF) + wave * 64;
    const int ch = n * 64 + lane;
    const float* cw = IN(8) + (size_t)o * 4 * 512; const float cb = IN(9)[o * 512 + ch];
    const float w0 = cw[0 * 512 + ch], w1 = cw[1 * 512 + ch], w2 = cw[2 * 512 + ch], w3 = cw[3 * 512 + ch];
    const float* Wa = IN(10) + ((size_t)o * 8 + n) * 4096; const float* Wx = IN(12) + ((size_t)o * 8 + n) * 4096;
    const float ba = IN(11)[o * 512 + ch], bx = IN(13)[o * 512 + ch], lam = IN(14)[o * 512 + ch];
    const float sp = log1pf(expf(-lam));
    float hst = 0.f;
    for (int c = 0; c < 8; ++c) {
        for (int tt = wave * 32; tt < wave * 32 + 32; ++tt) {
            const int t = c * 256 + tt; const size_t m = (size_t)b * SEQ + t;
            float xc = cb + w3 * bf2f(P[m * rs + O_LX + ch]);
            if (t >= 1) xc += w2 * bf2f(P[(m - 1) * rs + O_LX + ch]);
            if (t >= 2) xc += w1 * bf2f(P[(m - 2) * rs + O_LX + ch]);
            if (t >= 3) xc += w0 * bf2f(P[(m - 3) * rs + O_LX + ch]);
            xb[lane] = xc; LDS_WAIT(); asm volatile("" ::: "memory");
            float ra = ba, rx = bx;
            for (int i = 0; i < 64; ++i) { const float xi = xb[i]; ra += xi * Wa[i * 64 + lane]; rx += xi * Wx[i * 64 + lane]; }
            LDS_WAIT(); asm volatile("" ::: "memory");
            const float r = sigmoidf_(ra), ig = sigmoidf_(rx);
            const float la = -8.0f * r * sp, a = __expf(la);
            const float mult = (t == 0) ? 1.0f : sqrtf(-expm1f(2.0f * la));
            AU[(tt * 64 + lane) * 2] = a; AU[(tt * 64 + lane) * 2 + 1] = mult * ig * xc;
        }
        __syncthreads();
        if (wave == 0) {
            for (int tt = 0; tt < 256; ++tt) { const size_t m = (size_t)b * SEQ + c * 256 + tt;
                hst = AU[(tt * 64 + lane) * 2] * hst + AU[(tt * 64 + lane) * 2 + 1];
                const float g = bf2f(P[m * rs + O_LG + ch]);
                C_MIX[m * DM + 512 + ch] = (bf16)f2bf(hst * siluf_(g)); }
        }
        __syncthreads();
    }
}
__device__ __forceinline__ void naive_odd_mixer1(Ctx& C, int o) {
    float* OS = (float*)(C.ws + WS_XN);
    for (int u = C.vcu; u < 256 + 128; u += C.G) {
        if (u < 256) naive_hgrn_unit(C, u >> 4, (u >> 2) & 3, u & 3, o, OS);
        else naive_lru_unit(C, (u - 256) >> 3, (u - 256) & 7, o);
    }
}
__device__ __forceinline__ void naive_odd_mixer2(Ctx& C) {
    const float* OS = (const float*)(C.ws + WS_XN); const bf16* P = C_PROJ; const size_t rs = ODD_IN;
    const int gw = C.vcu * NWAVES + C.wave, NGW = C.G * NWAVES;
    for (int it = gw; it < MTOK * 4; it += NGW) { const size_t m = it >> 2; const int h = it & 3;
        const float o0 = OS[m * 512 + h * 128 + C.lane], o1 = OS[m * 512 + h * 128 + 64 + C.lane];
        const float rstd = rsqrtf(wave_sum(o0 * o0 + o1 * o1) * (1.f / 128.f) + EPS);
        const float g0 = bf2f(P[m * rs + O_HG + h * 128 + C.lane]), g1 = bf2f(P[m * rs + O_HG + h * 128 + 64 + C.lane]);
        C_MIX[m * DM + h * 128 + C.lane] = (bf16)f2bf(o0 * rstd * siluf_(g0)); C_MIX[m * DM + h * 128 + 64 + C.lane] = (bf16)f2bf(o1 * rstd * siluf_(g1)); }
}
#ifndef REP_RET
#define REP_RET 1
#endif
#ifndef REP_HG1
#define REP_HG1 1
#endif
#ifndef REP_HG2
#define REP_HG2 1
#endif
#ifndef REP_LRU
#define REP_LRU 1
#endif
typedef float f32x16 __attribute__((ext_vector_type(16)));
typedef short s16x4 __attribute__((ext_vector_type(4)));
typedef __bf16 bf16x2_t __attribute__((ext_vector_type(2)));
typedef float f32x2_t __attribute__((ext_vector_type(2)));
typedef unsigned u32x2 __attribute__((ext_vector_type(2)));
#define MFMA32(a, b, c) __builtin_amdgcn_mfma_f32_32x32x16_bf16((a), (b), (c), 0, 0, 0)
#define MFMA16(a, b, c) __builtin_amdgcn_mfma_f32_16x16x32_bf16((a), (b), (c), 0, 0, 0)
__device__ __forceinline__ unsigned pkbf(float lo, float hi) { const f32x2_t v = {lo, hi}; return __builtin_bit_cast(unsigned, __builtin_convertvector(v, bf16x2_t)); }
__device__ __forceinline__ bf16x8 pack8(float a0, float a1, float a2, float a3, float a4, float a5, float a6, float a7) {
    v4u p; p.x = pkbf(a0, a1); p.y = pkbf(a2, a3); p.z = pkbf(a4, a5); p.w = pkbf(a6, a7); return __builtin_bit_cast(bf16x8, p); }
__device__ __forceinline__ bf16x8 cat4(s16x4 lo, s16x4 hi) { return __builtin_shufflevector(lo, hi, 0, 1, 2, 3, 4, 5, 6, 7); }
__device__ __forceinline__ int crow32(int i, int h) { return (i & 3) + 8 * (i >> 2) + 4 * h; }
__device__ __forceinline__ float fast_log_sigmoid(float z) { return fminf(z, 0.f) - __logf(1.f + __expf(-fabsf(z))); }

struct SbFr { bf16x8 kf[4]; s16x4 va[2][2][2]; };
__device__ __forceinline__ void sb_load(SbFr& f, const GAS bf16* kp, const GAS bf16* vt, int s0) {
#pragma unroll
    for (int ks = 0; ks < 4; ++ks) f.kf[ks] = *(const GAS bf16x8*)(kp + (size_t)s0 * EVEN_IN + 16 * ks);
#pragma unroll
    for (int mt = 0; mt < 2; ++mt)
#pragma unroll
        for (int st = 0; st < 2; ++st)
#pragma unroll
            for (int hf = 0; hf < 2; ++hf) f.va[mt][st][hf] = *(const GAS s16x4*)(vt + (size_t)mt * 32 * 2048 + s0 + 16 * st + 8 * hf);
}
template <bool DIAG> __device__ __forceinline__ void sb_tile(const SbFr& f, const bf16x8 (&qf)[4], const bf16x8 (&tri)[2], f32x16& o0, f32x16& o1, float& R, int r, int h) {
    f32x16 x;
#pragma unroll
    for (int i = 0; i < 16; ++i) x[i] = 0.f;
#pragma unroll
    for (int ks = 0; ks < 4; ++ks) x = MFMA32(f.kf[ks], qf[ks], x);
    float lom[16], lbv[16];
#pragma unroll
    for (int i = 0; i < 16; ++i) { const float z = x[i] * (0.125f * 1.4426950408889634f);
        const float lb = fminf(z, 0.f) - __builtin_amdgcn_logf(1.f + __builtin_amdgcn_exp2f(-fabsf(z)));
        if (DIAG) { const bool valid = crow32(i, h) < r; lom[i] = valid ? lb - z : 0.f; lbv[i] = valid ? lb : -1e30f; }
        else { lom[i] = lb - z; lbv[i] = lb; } }
    const bf16x8 lf0 = pack8(lom[0], lom[1], lom[2], lom[3], lom[4], lom[5], lom[6], lom[7]);
    const bf16x8 lf1 = pack8(lom[8], lom[9], lom[10], lom[11], lom[12], lom[13], lom[14], lom[15]);
    f32x16 y;
#pragma unroll
    for (int i = 0; i < 16; ++i) y[i] = 0.f;
    y = MFMA32(tri[0], lf0, y); y = MFMA32(tri[1], lf1, y);
    const float tot = __shfl(y[0] + lom[0], r);
    float w[16];
#pragma unroll
    for (int i = 0; i < 16; ++i) w[i] = __builtin_amdgcn_exp2f(lbv[i] + y[i] + R);
    R += tot;
    const bf16x8 wf0 = pack8(w[0], w[1], w[2], w[3], w[4], w[5], w[6], w[7]);
    const bf16x8 wf1 = pack8(w[8], w[9], w[10], w[11], w[12], w[13], w[14], w[15]);
    o0 = MFMA32(cat4(f.va[0][0][0], f.va[0][0][1]), wf0, o0); o0 = MFMA32(cat4(f.va[0][1][0], f.va[0][1][1]), wf1, o0);
    o1 = MFMA32(cat4(f.va[1][0][0], f.va[1][0][1]), wf0, o1); o1 = MFMA32(cat4(f.va[1][1][0], f.va[1][1][1]), wf1, o1);
}
__device__ __forceinline__ void sb_wave_unit(Ctx& C, int b, int hh, int qblk) {
    const int lane = C.lane, r = lane & 31, h = lane >> 5;
    const bf16* P = C_PROJ; const size_t rs = EVEN_IN;
    const int t0 = qblk * 32; const size_t m0 = (size_t)b * SEQ + t0;
    const GAS bf16* kp = (const GAS bf16*)P + ((size_t)b * SEQ + r) * rs + E_SK + hh * 64 + 8 * h;
    const GAS bf16* vt = (const GAS bf16*)C_VT1 + ((size_t)(b * 512 + hh * 64 + r)) * 2048 + 4 * h;
    SbFr fa, fb;
    sb_load(fa, kp, vt, t0);
    sb_load(fb, kp, vt, t0 >= 32 ? t0 - 32 : 0);
    bf16x8 qf[4];
#pragma unroll
    for (int ks = 0; ks < 4; ++ks) qf[ks] = *(const GAS bf16x8*)(P + (m0 + r) * rs + E_SQ + hh * 64 + 16 * ks + 8 * h);
    u32x2 gvv[2][4];
    { const bf16* gp = P + (m0 + r) * rs + E_SG + hh * 64 + 4 * h;
#pragma unroll
      for (int mt = 0; mt < 2; ++mt)
#pragma unroll
          for (int q4 = 0; q4 < 4; ++q4) gvv[mt][q4] = *(const GAS u32x2*)(gp + 32 * mt + 8 * q4); }
    bf16x8 tri[2];
#pragma unroll
    for (int st = 0; st < 2; ++st)
#pragma unroll
        for (int j = 0; j < 8; ++j) { const int k = 16 * st + 8 * (j >> 2) + 4 * h + (j & 3); tri[st][j] = (k > r) ? (short)0x3F80 : (short)0; }
    f32x16 o0, o1;
#pragma unroll
    for (int i = 0; i < 16; ++i) { o0[i] = 0.f; o1[i] = 0.f; }
    float R = 0.f;
    const float RLIM = -100.f * 1.4426950408889634f;
    sb_tile<true>(fa, qf, tri, o0, o1, R, r, h);
    for (int s0 = t0 - 32; s0 >= 0; s0 -= 64) {
        if (__all(R < RLIM)) break;
        sb_load(fa, kp, vt, s0 >= 32 ? s0 - 32 : 0); __builtin_amdgcn_sched_barrier(0);
        sb_tile<false>(fb, qf, tri, o0, o1, R, r, h);
        if (s0 < 32 || __all(R < RLIM)) break;
        sb_load(fb, kp, vt, s0 >= 64 ? s0 - 64 : 0); __builtin_amdgcn_sched_barrier(0);
        sb_tile<false>(fa, qf, tri, o0, o1, R, r, h);
    }
    bf16* op = C_MIX + (m0 + r) * DM + 512 + hh * 64 + 4 * h;
#pragma unroll
    for (int mt = 0; mt < 2; ++mt)
#pragma unroll
        for (int q4 = 0; q4 < 4; ++q4) {
            const u32x2 gv = gvv[mt][q4];
            const float g0 = __uint_as_float(gv.x << 16), g1 = __uint_as_float(gv.x & 0xffff0000u), g2 = __uint_as_float(gv.y << 16), g3 = __uint_as_float(gv.y & 0xffff0000u);
            const float a0 = mt ? o1[4 * q4 + 0] : o0[4 * q4 + 0], a1 = mt ? o1[4 * q4 + 1] : o0[4 * q4 + 1], a2 = mt ? o1[4 * q4 + 2] : o0[4 * q4 + 2], a3 = mt ? o1[4 * q4 + 3] : o0[4 * q4 + 3];
            u32x2 ov; ov.x = pkbf(a0 * siluf_(g0), a1 * siluf_(g1)); ov.y = pkbf(a2 * siluf_(g2), a3 * siluf_(g3));
            *(GAS u32x2*)(op + 32 * mt + 8 * q4) = ov;
        }
}

constexpr int RT_Q = 0, RT_K = 18432, RT_KT = 36864, RT_V = 54272, RT_S = 89088;
__device__ __forceinline__ void ret_unit(Ctx& C, int b, int h) {
    const int tid = C.tid, lane = C.lane, w = C.wave, fr = lane & 15, g = lane >> 4;
    LAS unsigned char* L = C.lds;
    const bf16* P = C_PROJ; const size_t rs = EVEN_IN;
    const float lg2 = log2f(1.0f - exp2f(-5.0f - (float)h));
    const float gC = exp2f(128.0f * lg2);
    f32x4 st[4];
#pragma unroll
    for (int nt = 0; nt < 4; ++nt) st[nt] = (f32x4){0.f, 0.f, 0.f, 0.f};
    for (int i = tid; i < 18432 / 4; i += 512) ((LAS unsigned*)(L + RT_S))[i] = 0u;
    for (int c = 0; c < 16; ++c) {
        {
            const int tt = tid >> 2, part = tid & 3, t = 128 * c + tt; const size_t m = (size_t)b * SEQ + t;
            float qa[8], qb[8], ka[8], kb[8], cs[8], sn[8];
            unpack8(*(const GAS v4u*)(P + m * rs + E_RQ + h * 64 + 8 * part), qa); unpack8(*(const GAS v4u*)(P + m * rs + E_RQ + h * 64 + 32 + 8 * part), qb);
            unpack8(*(const GAS v4u*)(P + m * rs + E_RK + h * 64 + 8 * part), ka); unpack8(*(const GAS v4u*)(P + m * rs + E_RK + h * 64 + 32 + 8 * part), kb);
            { const f32x4 c0 = *(const GAS f32x4*)(C_TABC + t * 32 + 8 * part), c1 = *(const GAS f32x4*)(C_TABC + t * 32 + 8 * part + 4);
              const f32x4 s0 = *(const GAS f32x4*)(C_TABS + t * 32 + 8 * part), s1 = *(const GAS f32x4*)(C_TABS + t * 32 + 8 * part + 4);
              cs[0] = c0.x; cs[1] = c0.y; cs[2] = c0.z; cs[3] = c0.w; cs[4] = c1.x; cs[5] = c1.y; cs[6] = c1.z; cs[7] = c1.w;
              sn[0] = s0.x; sn[1] = s0.y; sn[2] = s0.z; sn[3] = s0.w; sn[4] = s1.x; sn[5] = s1.y; sn[6] = s1.z; sn[7] = s1.w; }
            const float fq = exp2f((float)tt * lg2), fk = 0.125f * exp2f(-(float)tt * lg2);
            float q1[8], q2[8], k1[8], k2[8];
#pragma unroll
            for (int j = 0; j < 8; ++j) { q1[j] = (qa[j] * cs[j] - qb[j] * sn[j]) * fq; q2[j] = (qa[j] * sn[j] + qb[j] * cs[j]) * fq;
                                          k1[j] = (ka[j] * cs[j] - kb[j] * sn[j]) * fk; k2[j] = (ka[j] * sn[j] + kb[j] * cs[j]) * fk; }
            *(LAS bf16x8*)(L + RT_Q + tt * 144 + 16 * part) = pack8(q1[0], q1[1], q1[2], q1[3], q1[4], q1[5], q1[6], q1[7]);
            *(LAS bf16x8*)(L + RT_Q + tt * 144 + 64 + 16 * part) = pack8(q2[0], q2[1], q2[2], q2[3], q2[4], q2[5], q2[6], q2[7]);
            *(LAS bf16x8*)(L + RT_K + tt * 144 + 16 * part) = pack8(k1[0], k1[1], k1[2], k1[3], k1[4], k1[5], k1[6], k1[7]);
            *(LAS bf16x8*)(L + RT_K + tt * 144 + 64 + 16 * part) = pack8(k2[0], k2[1], k2[2], k2[3], k2[4], k2[5], k2[6], k2[7]);
#pragma unroll
            for (int j = 0; j < 8; ++j) { *(LAS bf16*)(L + RT_KT + (8 * part + j) * 272 + tt * 2) = (bf16)f2bf(k1[j]); *(LAS bf16*)(L + RT_KT + (32 + 8 * part + j) * 272 + tt * 2) = (bf16)f2bf(k2[j]); }
            const int dv = tid >> 2, seg = tid & 3;
            const bf16* vsrc = C_VT0 + ((size_t)(b * 512 + h * 128 + dv)) * 2048 + 128 * c + seg * 32;
#pragma unroll
            for (int i = 0; i < 4; ++i) *(LAS v4u*)(L + RT_V + dv * 272 + (seg * 32 + 8 * i) * 2) = *(const GAS v4u*)(vsrc + 8 * i);
        }
        __syncthreads();
        bf16x8 qf[2];
#pragma unroll
        for (int ks = 0; ks < 2; ++ks) qf[ks] = *(const LAS bf16x8*)(L + RT_Q + (16 * w + fr) * 144 + (32 * ks + 8 * g) * 2);
        f32x4 o[8];
#pragma unroll
        for (int mt = 0; mt < 8; ++mt) o[mt] = (f32x4){0.f, 0.f, 0.f, 0.f};
#pragma unroll
        for (int kp = 0; kp < 4; ++kp) {
            if (kp <= (w >> 1)) {
                f32x4 s0 = (f32x4){0.f, 0.f, 0.f, 0.f}, s1 = (f32x4){0.f, 0.f, 0.f, 0.f};
#pragma unroll
                for (int ks = 0; ks < 2; ++ks) {
                    const bf16x8 a0 = *(const LAS bf16x8*)(L + RT_K + (32 * kp + fr) * 144 + (32 * ks + 8 * g) * 2);
                    const bf16x8 a1 = *(const LAS bf16x8*)(L + RT_K + (32 * kp + 16 + fr) * 144 + (32 * ks + 8 * g) * 2);
                    s0 = MFMA16(a0, qf[ks], s0); s1 = MFMA16(a1, qf[ks], s1);
                }
                const int tq = 16 * w + fr;
#pragma unroll
                for (int r = 0; r < 4; ++r) { if (32 * kp + 4 * g + r > tq) s0[r] = 0.f; if (32 * kp + 16 + 4 * g + r > tq) s1[r] = 0.f; }
                const bf16x8 pf = pack8(s0[0], s0[1], s0[2], s0[3], s1[0], s1[1], s1[2], s1[3]);
#pragma unroll
                for (int mt = 0; mt < 8; ++mt) {
                    const s16x4 lo = *(const LAS s16x4*)(L + RT_V + (16 * mt + fr) * 272 + (32 * kp + 4 * g) * 2);
                    const s16x4 hi = *(const LAS s16x4*)(L + RT_V + (16 * mt + fr) * 272 + (32 * kp + 16 + 4 * g) * 2);
                    o[mt] = MFMA16(cat4(lo, hi), pf, o[mt]);
                }
            }
        }
#pragma unroll
        for (int mt = 0; mt < 8; ++mt)
#pragma unroll
            for (int ks = 0; ks < 2; ++ks) o[mt] = MFMA16(*(const LAS bf16x8*)(L + RT_S + (16 * mt + fr) * 144 + (32 * ks + 8 * g) * 2), qf[ks], o[mt]);
#pragma unroll
        for (int ks = 0; ks < 4; ++ks) {
            const bf16x8 av = *(const LAS bf16x8*)(L + RT_V + (16 * w + fr) * 272 + (32 * ks + 8 * g) * 2);
#pragma unroll
            for (int nt = 0; nt < 4; ++nt) st[nt] = MFMA16(av, *(const LAS bf16x8*)(L + RT_KT + (16 * nt + fr) * 272 + (32 * ks + 8 * g) * 2), st[nt]);
        }
#pragma unroll
        for (int nt = 0; nt < 4; ++nt) st[nt] = st[nt] * gC;
        __syncthreads();
#pragma unroll
        for (int nt = 0; nt < 4; ++nt)
#pragma unroll
            for (int r = 0; r < 4; ++r) *(LAS bf16*)(L + RT_S + (16 * w + 4 * g + r) * 144 + (16 * nt + fr) * 2) = (bf16)f2bf(st[nt][r]);
        float ss = 0.f;
#pragma unroll
        for (int mt = 0; mt < 8; ++mt) ss += (o[mt][0] * o[mt][0] + o[mt][1] * o[mt][1]) + (o[mt][2] * o[mt][2] + o[mt][3] * o[mt][3]);
        ss += __shfl_xor(ss, 16); ss += __shfl_xor(ss, 32);
        const float rstd = rsqrtf(ss * (1.f / 128.f) + EPS);
        const size_t m = (size_t)b * SEQ + 128 * c + 16 * w + fr;
#pragma unroll
        for (int mt = 0; mt < 8; ++mt) {
            const u32x2 gv = *(const GAS u32x2*)(P + m * rs + E_RG + h * 128 + 16 * mt + 4 * g);
            const float g0 = __uint_as_float(gv.x << 16), g1 = __uint_as_float(gv.x & 0xffff0000u), g2 = __uint_as_float(gv.y << 16), g3 = __uint_as_float(gv.y & 0xffff0000u);
            u32x2 ov; ov.x = pkbf(o[mt][0] * rstd * siluf_(g0), o[mt][1] * rstd * siluf_(g1)); ov.y = pkbf(o[mt][2] * rstd * siluf_(g2), o[mt][3] * rstd * siluf_(g3));
            *(GAS u32x2*)(C_MIX + m * DM + h * 128 + 16 * mt + 4 * g) = ov;
        }
    }
    __syncthreads();
}
constexpr int CW_CTR = 64;
__device__ __forceinline__ void opt_even_mixer(Ctx& C, int li) {
    { TIC(C, 20); if (blockIdx.x < 64) for (int rr = 0; rr < REP_RET; ++rr) ret_unit(C, (int)blockIdx.x >> 2, (int)blockIdx.x & 3); TOC(C, 20); }
    TIC(C, 21);
    unsigned* ctr = (unsigned*)(C.ws + WS_CTL) + CW_CTR + 64 * li;
    for (;;) {
        unsigned u = 0; if (C.lane == 0) u = __hip_atomic_fetch_add(ctr, 1u, __ATOMIC_RELAXED, __HIP_MEMORY_SCOPE_AGENT);
        u = __builtin_amdgcn_readfirstlane(u);
        if (u >= (unsigned)(BATCH * 8 * 64)) break;
        const int qblk = 63 - (int)(u >> 7), bh = (int)(u & 127);
        sb_wave_unit(C, bh >> 3, bh & 7, qblk);
    }
    TOC(C, 21);
}

constexpr size_t WS_GD = 37 * MiB;
constexpr int H1_QR = 0, H1_KR = 17408, H1_KD = 34816, H1_QX = 52224, H1_TOT = 65280;
__device__ __forceinline__ void hg1_unit(Ctx& C, int u, int o) {
    const int sc = u & 31, bh = u >> 5, b = bh >> 2, h = bh & 3;
    const int lane = C.lane, w = C.wave, fr = lane & 15, g = lane >> 4;
    const int i = w >> 1, k = 64 * (w & 1) + lane;
    LAS unsigned char* L = C.lds; bf16* P = C_PROJ; const size_t rs = ODD_IN;
    const float lb = C_LB[o * 512 + h * 128 + k];
    const size_t m0 = (size_t)b * SEQ + 64 * sc + 16 * i;
    float q[16], kk[16], c[16]; float run = 0.f;
#pragma unroll
    for (int j = 0; j < 16; ++j) {
        const float fl = bf2f(P[(m0 + j) * rs + O_HF + h * 128 + k]); q[j] = bf2f(P[(m0 + j) * rs + O_HQ + h * 128 + k]);
        const float sig = 1.f / (1.f + __expf(-fl)), f = lb + (1.f - lb) * sig;
        run += __logf(f); c[j] = run; kk[j] = (1.f - lb) / (1.f + __expf(fl));
    }
    ((LAS float*)(L + H1_TOT))[i * 128 + k] = run;
    __syncthreads();
    const float t0 = ((LAS float*)(L + H1_TOT))[k], t1 = ((LAS float*)(L + H1_TOT))[128 + k], t2 = ((LAS float*)(L + H1_TOT))[256 + k], t3 = ((LAS float*)(L + H1_TOT))[384 + k];
    const float Bi = (i > 0 ? t0 : 0.f) + (i > 1 ? t1 : 0.f) + (i > 2 ? t2 : 0.f), B4 = (t0 + t1) + (t2 + t3), Bn = Bi + run;
    const float eBi = __expf(Bi), eEnd = __expf(B4 - Bn), eD = __expf(-run);
    const float fx0 = (i == 2) ? __expf(t1) : ((i == 3) ? __expf(t2) : 0.f), fx1 = (i == 3) ? __expf(t1 + t2) : 0.f;
    float ksv[16];
#pragma unroll
    for (int j = 0; j < 16; ++j) {
        const float qr = q[j] * __expf(c[j]), kr = kk[j] * __expf(run - c[j]);
        const int row = 16 * i + j;
        *(LAS bf16*)(L + H1_QR + row * 272 + k * 2) = (bf16)f2bf(qr);
        *(LAS bf16*)(L + H1_KR + row * 272 + k * 2) = (bf16)f2bf(kr);
        *(LAS bf16*)(L + H1_KD + row * 272 + k * 2) = (bf16)f2bf(kr * eD);
        if (i == 2) *(LAS bf16*)(L + H1_QX + j * 272 + k * 2) = (bf16)f2bf(qr * fx0);
        if (i == 3) { *(LAS bf16*)(L + H1_QX + (16 + j) * 272 + k * 2) = (bf16)f2bf(qr * fx0);
                      *(LAS bf16*)(L + H1_QX + (32 + j) * 272 + k * 2) = (bf16)f2bf(qr * fx1); }
        C_XN[(m0 + j) * 512 + h * 128 + k] = (bf16)f2bf(qr * eBi);
        ksv[j] = kr * eEnd;
    }
    {
        bf16* kd = C_KST + ((size_t)u * 128 + k) * 64 + 16 * i;
        v4u p0, p1; p0.x = pkbf(ksv[0], ksv[1]); p0.y = pkbf(ksv[2], ksv[3]); p0.z = pkbf(ksv[4], ksv[5]); p0.w = pkbf(ksv[6], ksv[7]);
        p1.x = pkbf(ksv[8], ksv[9]); p1.y = pkbf(ksv[10], ksv[11]); p1.z = pkbf(ksv[12], ksv[13]); p1.w = pkbf(ksv[14], ksv[15]);
        *(GAS v4u*)kd = p0; *(GAS v4u*)(kd + 8) = p1;
        if (i == 0) ((float*)(C.ws + WS_GD))[(size_t)u * 128 + k] = __expf(B4);
    }
    __syncthreads();
    const int ti = w & 3, vh = w >> 2;
    f32x4 at[4];
#pragma unroll
    for (int sj = 0; sj < 4; ++sj) {
        at[sj] = (f32x4){0.f, 0.f, 0.f, 0.f};
        if (sj <= ti) {
            const int kbase = (sj == ti) ? H1_KD : H1_KR;
            const int gap = ti - sj;
            const int qbase = (gap <= 1) ? (H1_QR + 16 * ti * 272) : ((ti == 2) ? H1_QX : ((sj == 1) ? (H1_QX + 16 * 272) : (H1_QX + 32 * 272)));
#pragma unroll
            for (int ks = 0; ks < 4; ++ks) {
                const bf16x8 a = *(const LAS bf16x8*)(L + kbase + (16 * sj + fr) * 272 + (32 * ks + 8 * g) * 2);
                const bf16x8 bq = *(const LAS bf16x8*)(L + qbase + fr * 272 + (32 * ks + 8 * g) * 2);
                at[sj] = MFMA16(a, bq, at[sj]);
            }
            if (sj == ti) {
#pragma unroll
                for (int r = 0; r < 4; ++r) if (4 * g + r > fr) at[sj][r] = 0.f;
            }
        }
    }
    f32x4 oo[4];
#pragma unroll
    for (int mt = 0; mt < 4; ++mt) oo[mt] = (f32x4){0.f, 0.f, 0.f, 0.f};
    const bf16* vtb = C_VT0 + ((size_t)(b * 512 + h * 128 + 64 * vh + fr)) * 2048 + 64 * sc + 4 * g;
#pragma unroll
    for (int kp = 0; kp < 2; ++kp) {
        if (2 * kp <= ti) {
            const bf16x8 pf = kp == 0 ? pack8(at[0][0], at[0][1], at[0][2], at[0][3], at[1][0], at[1][1], at[1][2], at[1][3]) : pack8(at[2][0], at[2][1], at[2][2], at[2][3], at[3][0], at[3][1], at[3][2], at[3][3]);
#pragma unroll
            for (int mt = 0; mt < 4; ++mt) {
                const s16x4 lo = *(const GAS s16x4*)(vtb + (size_t)mt * 16 * 2048 + 32 * kp), hi = *(const GAS s16x4*)(vtb + (size_t)mt * 16 * 2048 + 32 * kp + 16);
                oo[mt] = MFMA16(cat4(lo, hi), pf, oo[mt]);
            }
        }
    }
    bf16* op = C_OI + ((size_t)b * SEQ + 64 * sc + 16 * ti + fr) * 512 + h * 128 + 64 * vh + 4 * g;
#pragma unroll
    for (int mt = 0; mt < 4; ++mt) { u32x2 ov; ov.x = pkbf(oo[mt][0], oo[mt][1]); ov.y = pkbf(oo[mt][2], oo[mt][3]); *(GAS u32x2*)(op + 16 * mt) = ov; }
    __syncthreads();
}

constexpr int H2_ST = 0, H2_VT = 34816, H2_SS = 34816 + 2 * 18432;
__device__ __forceinline__ void hg2_unit(Ctx& C, int bh) {
    const int b = bh >> 2, h = bh & 3;
    const int tid = C.tid, lane = C.lane, w = C.wave, fr = lane & 15, g = lane >> 4, ti = w & 3, vh = w >> 2;
    LAS unsigned char* L = C.lds; const bf16* P = C_PROJ; const size_t rs = ODD_IN;
    f32x4 st[8];
#pragma unroll
    for (int nt = 0; nt < 8; ++nt) st[nt] = (f32x4){0.f, 0.f, 0.f, 0.f};
    for (int i = tid; i < 34816 / 4; i += 512) ((LAS unsigned*)(L + H2_ST))[i] = 0u;
    const int sv = tid >> 2, sseg = tid & 3;
    const bf16* vsrc = C_VT0 + ((size_t)(b * 512 + h * 128 + sv)) * 2048 + 16 * sseg;
    const float* gdp = (const float*)(C.ws + WS_GD) + (size_t)bh * 32 * 128 + 16 * w + 4 * g;
    const bf16* kstp = C_KST + ((size_t)bh * 32 * 128 + 16 * w + fr) * 64 + 8 * g;
    const size_t mrow = (size_t)b * SEQ + 16 * ti + fr;
    bf16x8 qf[4], ka[2]; f32x4 gd; u32x2 oi[4], gt[4]; v4u vs0, vs1;
    u32x2 ovp[4];
#pragma unroll
    for (int ks = 0; ks < 4; ++ks) qf[ks] = *(const GAS bf16x8*)(C_XN + mrow * 512 + h * 128 + 32 * ks + 8 * g);
#pragma unroll
    for (int ks = 0; ks < 2; ++ks) ka[ks] = *(const GAS bf16x8*)(kstp + 32 * ks);
    gd = *(const GAS f32x4*)gdp;
#pragma unroll
    for (int mt = 0; mt < 4; ++mt) { oi[mt] = *(const GAS u32x2*)(C_OI + mrow * 512 + h * 128 + 64 * vh + 16 * mt + 4 * g); gt[mt] = *(const GAS u32x2*)(P + mrow * rs + O_HG + h * 128 + 64 * vh + 16 * mt + 4 * g); }
    vs0 = *(const GAS v4u*)vsrc; vs1 = *(const GAS v4u*)(vsrc + 8);
    *(LAS v4u*)(L + H2_VT + sv * 144 + sseg * 32) = vs0; *(LAS v4u*)(L + H2_VT + sv * 144 + sseg * 32 + 16) = vs1;
    vs0 = *(const GAS v4u*)(vsrc + 64); vs1 = *(const GAS v4u*)(vsrc + 64 + 8);
    __syncthreads();
    TIC(C, 1);
    for (int sc = 0; sc < 32; ++sc) {
        { TIC(C, 2); if (TSCALE && TSEL == 2) asm volatile("s_waitcnt vmcnt(0)" ::: "memory"); TOC(C, 2); }
        const size_t m = mrow + 64 * sc;
        const int scn = sc < 31 ? sc + 1 : sc;
        const size_t mn = mrow + 64 * scn;
        if (sc > 0) { bf16* opp = C_MIX + (m - 64) * DM + h * 128 + 64 * vh + 4 * g;
#pragma unroll
            for (int mt = 0; mt < 4; ++mt) *(GAS u32x2*)(opp + 16 * mt) = ovp[mt]; }
        bf16x8 qfn[4], kan[2]; f32x4 gdn; u32x2 oin[4], gtn[4];
#pragma unroll
        for (int ks = 0; ks < 4; ++ks) qfn[ks] = *(const GAS bf16x8*)(C_XN + mn * 512 + h * 128 + 32 * ks + 8 * g);
#pragma unroll
        for (int ks = 0; ks < 2; ++ks) kan[ks] = *(const GAS bf16x8*)(kstp + (size_t)scn * 128 * 64 + 32 * ks);
        gdn = *(const GAS f32x4*)(gdp + scn * 128);
#pragma unroll
        for (int mt = 0; mt < 4; ++mt) { oin[mt] = *(const GAS u32x2*)(C_OI + mn * 512 + h * 128 + 64 * vh + 16 * mt + 4 * g); gtn[mt] = *(const GAS u32x2*)(P + mn * rs + O_HG + h * 128 + 64 * vh + 16 * mt + 4 * g); }
        { LAS unsigned char* vn = L + H2_VT + ((sc + 1) & 1) * 18432; *(LAS v4u*)(vn + sv * 144 + sseg * 32) = vs0; *(LAS v4u*)(vn + sv * 144 + sseg * 32 + 16) = vs1; }
        { const int sc2 = sc < 30 ? sc + 2 : 31; vs0 = *(const GAS v4u*)(vsrc + 64 * sc2); vs1 = *(const GAS v4u*)(vsrc + 64 * sc2 + 8); }
        f32x4 o[4];
#pragma unroll
        for (int mt = 0; mt < 4; ++mt) {
            o[mt] = (f32x4){0.f, 0.f, 0.f, 0.f};
#pragma unroll
            for (int ks = 0; ks < 4; ++ks) o[mt] = MFMA16(*(const LAS bf16x8*)(L + H2_ST + (64 * vh + 16 * mt + fr) * 272 + (32 * ks + 8 * g) * 2), qf[ks], o[mt]);
        }
        float ss = 0.f;
#pragma unroll
        for (int mt = 0; mt < 4; ++mt) { const u32x2 iv = oi[mt];
            o[mt][0] += __uint_as_float(iv.x << 16); o[mt][1] += __uint_as_float(iv.x & 0xffff0000u); o[mt][2] += __uint_as_float(iv.y << 16); o[mt][3] += __uint_as_float(iv.y & 0xffff0000u);
            ss += (o[mt][0] * o[mt][0] + o[mt][1] * o[mt][1]) + (o[mt][2] * o[mt][2] + o[mt][3] * o[mt][3]); }
        ss += __shfl_xor(ss, 16); ss += __shfl_xor(ss, 32);
        if (g == 0) ((LAS float*)(L + H2_SS))[vh * 64 + 16 * ti + fr] = ss;
        { TIC(C, 3); __syncthreads(); TOC(C, 3); }
        const LAS unsigned char* vt = L + H2_VT + (sc & 1) * 18432;
#pragma unroll
        for (int nt = 0; nt < 8; ++nt) { st[nt] = st[nt] * gd;
#pragma unroll
            for (int ks = 0; ks < 2; ++ks) st[nt] = MFMA16(ka[ks], *(const LAS bf16x8*)(vt + (16 * nt + fr) * 144 + (32 * ks + 8 * g) * 2), st[nt]); }
#pragma unroll
        for (int nt = 0; nt < 8; ++nt) { u32x2 svv; svv.x = pkbf(st[nt][0], st[nt][1]); svv.y = pkbf(st[nt][2], st[nt][3]); *(LAS u32x2*)(L + H2_ST + (16 * nt + fr) * 272 + (16 * w + 4 * g) * 2) = svv; }
        const float tot = ((LAS float*)(L + H2_SS))[16 * ti + fr] + ((LAS float*)(L + H2_SS))[64 + 16 * ti + fr];
        const float rstd = rsqrtf(tot * (1.f / 128.f) + EPS);
#pragma unroll
        for (int mt = 0; mt < 4; ++mt) {
            const u32x2 gv = gt[mt];
            const float g0 = __uint_as_float(gv.x << 16), g1 = __uint_as_float(gv.x & 0xffff0000u), g2 = __uint_as_float(gv.y << 16), g3 = __uint_as_float(gv.y & 0xffff0000u);
            ovp[mt].x = pkbf(o[mt][0] * rstd * siluf_(g0), o[mt][1] * rstd * siluf_(g1)); ovp[mt].y = pkbf(o[mt][2] * rstd * siluf_(g2), o[mt][3] * rstd * siluf_(g3));
        }
#pragma unroll
        for (int ks = 0; ks < 4; ++ks) qf[ks] = qfn[ks];
        ka[0] = kan[0]; ka[1] = kan[1]; gd = gdn;
#pragma unroll
        for (int mt = 0; mt < 4; ++mt) { oi[mt] = oin[mt]; gt[mt] = gtn[mt]; }
        { TIC(C, 4); __syncthreads(); TOC(C, 4); }
    }
    TOC(C, 1);
    { bf16* opp = C_MIX + (mrow + 64 * 31) * DM + h * 128 + 64 * vh + 4 * g;
#pragma unroll
      for (int mt = 0; mt < 4; ++mt) *(GAS u32x2*)(opp + 16 * mt) = ovp[mt]; }
}
__device__ __forceinline__ bf16 ldg_u16(const GAS bf16* ubase, unsigned voff) { asm volatile("" : "+s"(ubase)); return *(const GAS bf16*)((const GAS unsigned char*)ubase + voff); }
__device__ __forceinline__ void stg_u16(GAS bf16* ubase, unsigned voff, bf16 v) { asm volatile("" : "+s"(ubase)); *(GAS bf16*)((GAS unsigned char*)ubase + voff) = v; }
constexpr int LR_WA = 0, LR_WX = 9216, LR_PW = 18432, LR_PWSZ = 14848, LR_XC = 0, LR_XCF = 2304, LR_AU = 6400, LR_CAR = 18432 + 8 * 14848;
__device__ __forceinline__ void lru_unit(Ctx& C, int b, int n, int o) {
    const int tid = C.tid, lane = C.lane, w = C.wave, fr = lane & 15, g = lane >> 4;
    LAS unsigned char* L = C.lds; const bf16* P = C_PROJ; const size_t rs = ODD_IN;
    {
        const float* Wa = IN(10) + ((size_t)o * 8 + n) * 4096; const float* Wx = IN(12) + ((size_t)o * 8 + n) * 4096;
        for (int e = tid; e < 4096; e += 512) { const int i = e >> 6, j = e & 63;
            *(LAS bf16*)(L + LR_WA + j * 144 + i * 2) = (bf16)f2bf(Wa[e]); *(LAS bf16*)(L + LR_WX + j * 144 + i * 2) = (bf16)f2bf(Wx[e]); }
    }
    const int ch = n * 64 + lane;
    const float* cw = IN(8) + (size_t)o * 4 * 512; const float cb = IN(9)[o * 512 + ch];
    const float w0 = cw[ch], w1 = cw[512 + ch], w2 = cw[1024 + ch], w3 = cw[1536 + ch];
    float ba[4], bx[4], sp8[4];
#pragma unroll
    for (int nt = 0; nt < 4; ++nt) { const int cj = o * 512 + n * 64 + 16 * nt + fr; ba[nt] = IN(11)[cj]; bx[nt] = IN(13)[cj]; sp8[nt] = 8.0f * log1pf(expf(-IN(14)[cj])); }
    LAS unsigned char* PW = L + LR_PW + w * LR_PWSZ;
    __syncthreads();
    float hin = 0.f;
    const size_t mb = (size_t)b * SEQ;
    for (int pass = 0; pass < 2; ++pass) {
        float hs = hin, aprod = 1.f;
        const int tw = 256 * w;
        float xm1 = tw >= 1 ? bf2f(P[(mb + tw - 1) * rs + O_LX + ch]) : 0.f, xm2 = tw >= 2 ? bf2f(P[(mb + tw - 2) * rs + O_LX + ch]) : 0.f, xm3 = tw >= 3 ? bf2f(P[(mb + tw - 3) * rs + O_LX + ch]) : 0.f;
        bf16 xv[16], gv[16];
#pragma unroll
        for (int p = 0; p < 16; ++p) { const GAS bf16* rowp = (const GAS bf16*)P + (mb + tw + p) * rs + n * 64; xv[p] = ldg_u16(rowp + O_LX, lane * 2u); gv[p] = ldg_u16(rowp + (pass ? O_LG : O_LX), lane * 2u); }
        bf16 outv[16];
        for (int tile = 0; tile < 16; ++tile) {
            const int t0 = tw + 16 * tile, tn = tw + 16 * (tile < 15 ? tile + 1 : tile);
            if (pass && tile > 0) {
#pragma unroll
                for (int p = 0; p < 16; ++p) stg_u16((GAS bf16*)C_MIX + (mb + t0 - 16 + p) * DM + 512 + n * 64, lane * 2u, outv[p]); }
            bf16 xn[16], gn[16];
#pragma unroll
            for (int p = 0; p < 16; ++p) { const GAS bf16* rowp = (const GAS bf16*)P + (mb + tn + p) * rs + n * 64; xn[p] = ldg_u16(rowp + O_LX, lane * 2u); gn[p] = ldg_u16(rowp + (pass ? O_LG : O_LX), lane * 2u); }
#pragma unroll
            for (int p = 0; p < 16; ++p) { const float xcur = bf2f(xv[p]); const float xc = cb + w3 * xcur + w2 * xm1 + w1 * xm2 + w0 * xm3; xm3 = xm2; xm2 = xm1; xm1 = xcur;
                *(LAS bf16*)(PW + LR_XC + p * 144 + lane * 2) = (bf16)f2bf(xc); ((LAS float*)(PW + LR_XCF))[p * 64 + lane] = xc; }
            asm volatile("s_waitcnt lgkmcnt(0)" ::: "memory");
            f32x4 ra[4], rx[4];
#pragma unroll
            for (int nt = 0; nt < 4; ++nt) { ra[nt] = (f32x4){0.f, 0.f, 0.f, 0.f}; rx[nt] = (f32x4){0.f, 0.f, 0.f, 0.f}; }
#pragma unroll
            for (int ks = 0; ks < 2; ++ks) {
                const bf16x8 a = *(const LAS bf16x8*)(PW + LR_XC + fr * 144 + (32 * ks + 8 * g) * 2);
#pragma unroll
                for (int nt = 0; nt < 4; ++nt) {
                    ra[nt] = MFMA16(a, *(const LAS bf16x8*)(L + LR_WA + (16 * nt + fr) * 144 + (32 * ks + 8 * g) * 2), ra[nt]);
                    rx[nt] = MFMA16(a, *(const LAS bf16x8*)(L + LR_WX + (16 * nt + fr) * 144 + (32 * ks + 8 * g) * 2), rx[nt]);
                }
            }
#pragma unroll
            for (int nt = 0; nt < 4; ++nt)
#pragma unroll
                for (int r = 0; r < 4; ++r) {
                    const int p = 4 * g + r, j = 16 * nt + fr;
                    const float rr = __builtin_amdgcn_rcpf(1.f + __expf(-(ra[nt][r] + ba[nt]))), ig = __builtin_amdgcn_rcpf(1.f + __expf(-(rx[nt][r] + bx[nt])));
                    const float la = -rr * sp8[nt], a = __expf(la);
                    const float mult = (t0 + p == 0) ? 1.0f : __builtin_amdgcn_sqrtf(fmaxf(1.0f - a * a, 0.f));
                    const float xcv = ((const LAS float*)(PW + LR_XCF))[p * 64 + j];
                    f32x2_t au; au.x = a; au.y = mult * ig * xcv;
                    *(LAS f32x2_t*)(PW + LR_AU + (p * 64 + j) * 8) = au;
                }
            asm volatile("s_waitcnt lgkmcnt(0)" ::: "memory");
            if (pass == 0) {
#pragma unroll
                for (int p = 0; p < 16; ++p) { const f32x2_t au = *(const LAS f32x2_t*)(PW + LR_AU + (p * 64 + lane) * 8); hs = au.x * hs + au.y; aprod *= au.x; }
            } else {
#pragma unroll
                for (int p = 0; p < 16; ++p) { const f32x2_t au = *(const LAS f32x2_t*)(PW + LR_AU + (p * 64 + lane) * 8); hs = au.x * hs + au.y;
                    const float gg = bf2f(gv[p]); outv[p] = (bf16)f2bf(hs * gg * __builtin_amdgcn_rcpf(1.f + __expf(-gg))); }
            }
            asm volatile("s_waitcnt lgkmcnt(0)" ::: "memory");
#pragma unroll
            for (int p = 0; p < 16; ++p) { xv[p] = xn[p]; gv[p] = gn[p]; }
        }
        if (pass) {
#pragma unroll
            for (int p = 0; p < 16; ++p) stg_u16((GAS bf16*)C_MIX + (mb + tw + 240 + p) * DM + 512 + n * 64, lane * 2u, outv[p]); }
        if (pass == 0) {
            f32x2_t cr; cr.x = aprod; cr.y = hs;
            *(LAS f32x2_t*)(L + LR_CAR + (w * 64 + lane) * 8) = cr;
            __syncthreads();
            hin = 0.f;
            for (int ww = 0; ww < w; ++ww) { const f32x2_t cc = *(const LAS f32x2_t*)(L + LR_CAR + (ww * 64 + lane) * 8); hin = cc.x * hin + cc.y; }
        }
    }
    __syncthreads();
}
__device__ __forceinline__ void opt_odd_mixer1(Ctx& C, int o) {
    const int per = (2048 + C.G - 1) / C.G;
    for (int kk = 0; kk < per; ++kk) { const int u = C.vcu * per + kk; if (u < 2048) for (int rr = 0; rr < REP_HG1; ++rr) hg1_unit(C, u, o); }
}
__device__ __forceinline__ void opt_odd_mixer2(Ctx& C, int o) {
    const int bx = (int)blockIdx.x;
    if (bx < 64) for (int rr = 0; rr < REP_HG2; ++rr) hg2_unit(C, bx);
    else if (bx < 192) for (int rr = 0; rr < REP_LRU; ++rr) lru_unit(C, (bx - 64) >> 3, (bx - 64) & 7, o);
}

constexpr size_t WS_CAR = 38 * MiB;
__device__ __forceinline__ GAS bf16* sst_base(Ctx& C, int b, int h, int sc) {
    return (GAS bf16*)(C.ws + (b < 8 ? (WS_PROJ + 192 * MiB) : WS_VT1) + ((size_t)(((b & 7) * 4 + h) * 32 + sc)) * 32768);
}
template <int PASS> __device__ __forceinline__ void lru_pass(Ctx& C, int b, int n, int half, int o) {
    const int tid = C.tid, lane = C.lane, w = C.wave, fr = lane & 15, g = lane >> 4;
    LAS unsigned char* L = C.lds; const bf16* P = C_PROJ; const size_t rs = ODD_IN;
    {
        const float* Wa = IN(10) + ((size_t)o * 8 + n) * 4096; const float* Wx = IN(12) + ((size_t)o * 8 + n) * 4096;
        for (int e = tid; e < 4096; e += 512) { const int i = e >> 6, j = e & 63;
            *(LAS bf16*)(L + LR_WA + j * 144 + i * 2) = (bf16)f2bf(Wa[e]); *(LAS bf16*)(L + LR_WX + j * 144 + i * 2) = (bf16)f2bf(Wx[e]); }
    }
    const int ch = n * 64 + lane, c = 8 * half + w;
    const float* cw = IN(8) + (size_t)o * 4 * 512; const float cb = IN(9)[o * 512 + ch];
    const float w0 = cw[ch], w1 = cw[512 + ch], w2 = cw[1024 + ch], w3 = cw[1536 + ch];
    float ba[4], bx[4], sp8[4];
#pragma unroll
    for (int nt = 0; nt < 4; ++nt) { const int cj = o * 512 + n * 64 + 16 * nt + fr; ba[nt] = IN(11)[cj]; bx[nt] = IN(13)[cj]; sp8[nt] = 8.0f * log1pf(expf(-IN(14)[cj])); }
    LAS unsigned char* PW = L + LR_PW + w * LR_PWSZ;
    GAS f32x2_t* car = (GAS f32x2_t*)(C.ws + WS_CAR) + ((size_t)(b * 8 + n) * 16) * 64 + lane;
    float hs = 0.f, aprod = 1.f;
    if (PASS == 1) { for (int cc = 0; cc < c; ++cc) { const f32x2_t v = car[cc * 64]; hs = v.x * hs + v.y; } }
    __syncthreads();
    const size_t mb = (size_t)b * SEQ; const int tw = 128 * c;
    const GAS bf16* xbase = (const GAS bf16*)P + (mb + tw) * rs + n * 64;
    float xm1 = tw >= 1 ? bf2f(ldg_u16(xbase - rs + O_LX, lane * 2u)) : 0.f, xm2 = tw >= 2 ? bf2f(ldg_u16(xbase - 2 * rs + O_LX, lane * 2u)) : 0.f, xm3 = tw >= 3 ? bf2f(ldg_u16(xbase - 3 * rs + O_LX, lane * 2u)) : 0.f;
    bf16 xv[16], gv[16], outv[16];
#pragma unroll
    for (int p = 0; p < 16; ++p) { const GAS bf16* rowp = xbase + (size_t)p * rs; xv[p] = ldg_u16(rowp + O_LX, lane * 2u); gv[p] = ldg_u16(rowp + (PASS ? O_LG : O_LX), lane * 2u); }
    for (int tile = 0; tile < 8; ++tile) {
        const int t0 = tw + 16 * tile, tn = tw + 16 * (tile < 7 ? tile + 1 : tile);
        if (PASS && tile > 0) {
#pragma unroll
            for (int p = 0; p < 16; ++p) stg_u16((GAS bf16*)C_MIX + (mb + t0 - 16 + p) * DM + 512 + n * 64, lane * 2u, outv[p]); }
        bf16 xn[16], gn[16];
#pragma unroll
        for (int p = 0; p < 16; ++p) { const GAS bf16* rowp = (const GAS bf16*)P + (mb + tn + p) * rs + n * 64; xn[p] = ldg_u16(rowp + O_LX, lane * 2u); gn[p] = ldg_u16(rowp + (PASS ? O_LG : O_LX), lane * 2u); }
        __builtin_amdgcn_sched_barrier(0);
#pragma unroll
        for (int p = 0; p < 16; ++p) { const float xcur = bf2f(xv[p]); const float xc = cb + w3 * xcur + w2 * xm1 + w1 * xm2 + w0 * xm3; xm3 = xm2; xm2 = xm1; xm1 = xcur;
            *(LAS bf16*)(PW + LR_XC + p * 144 + lane * 2) = (bf16)f2bf(xc); ((LAS float*)(PW + LR_XCF))[p * 64 + lane] = xc; }
        asm volatile("s_waitcnt lgkmcnt(0)" ::: "memory");
        f32x4 ra[4], rx[4];
#pragma unroll
        for (int nt = 0; nt < 4; ++nt) { ra[nt] = (f32x4){0.f, 0.f, 0.f, 0.f}; rx[nt] = (f32x4){0.f, 0.f, 0.f, 0.f}; }
#pragma unroll
        for (int ks = 0; ks < 2; ++ks) {
            const bf16x8 a = *(const LAS bf16x8*)(PW + LR_XC + fr * 144 + (32 * ks + 8 * g) * 2);
#pragma unroll
            for (int nt = 0; nt < 4; ++nt) {
                ra[nt] = MFMA16(a, *(const LAS bf16x8*)(L + LR_WA + (16 * nt + fr) * 144 + (32 * ks + 8 * g) * 2), ra[nt]);
                rx[nt] = MFMA16(a, *(const LAS bf16x8*)(L + LR_WX + (16 * nt + fr) * 144 + (32 * ks + 8 * g) * 2), rx[nt]);
            }
        }
#pragma unroll
        for (int nt = 0; nt < 4; ++nt)
#pragma unroll
            for (int r = 0; r < 4; ++r) {
                const int p = 4 * g + r, j = 16 * nt + fr;
                const float rr = __builtin_amdgcn_rcpf(1.f + __expf(-(ra[nt][r] + ba[nt]))), ig = __builtin_amdgcn_rcpf(1.f + __expf(-(rx[nt][r] + bx[nt])));
                const float la = -rr * sp8[nt], a = __expf(la);
                const float mult = (t0 + p == 0) ? 1.0f : __builtin_amdgcn_sqrtf(fmaxf(1.0f - a * a, 0.f));
                const float xcv = ((const LAS float*)(PW + LR_XCF))[p * 64 + j];
                f32x2_t au; au.x = a; au.y = mult * ig * xcv;
                *(LAS f32x2_t*)(PW + LR_AU + (p * 64 + j) * 8) = au;
            }
        asm volatile("s_waitcnt lgkmcnt(0)" ::: "memory");
        if (PASS == 0) {
#pragma unroll
            for (int p = 0; p < 16; ++p) { const f32x2_t au = *(const LAS f32x2_t*)(PW + LR_AU + (p * 64 + lane) * 8); hs = au.x * hs + au.y; aprod *= au.x; }
        } else {
#pragma unroll
            for (int p = 0; p < 16; ++p) { const f32x2_t au = *(const LAS f32x2_t*)(PW + LR_AU + (p * 64 + lane) * 8); hs = au.x * hs + au.y;
                const float gg = bf2f(gv[p]); outv[p] = (bf16)f2bf(hs * gg * __builtin_amdgcn_rcpf(1.f + __expf(-gg))); }
        }
        asm volatile("s_waitcnt lgkmcnt(0)" ::: "memory");
#pragma unroll
        for (int p = 0; p < 16; ++p) { xv[p] = xn[p]; gv[p] = gn[p]; }
    }
    if (PASS) {
#pragma unroll
        for (int p = 0; p < 16; ++p) stg_u16((GAS bf16*)C_MIX + (mb + tw + 112 + p) * DM + 512 + n * 64, lane * 2u, outv[p]);
    } else { f32x2_t cr; cr.x = aprod; cr.y = hs; car[c * 64] = cr; }
    __syncthreads();
}
struct Hg2Ops { bf16x8 ka[2], vb[2][2]; f32x4 gd; };
__device__ __forceinline__ void hg2_load(Hg2Ops& r, const GAS bf16* kstp, const GAS bf16* vtp, const GAS float* gdp, int sc) {
    const int s = sc < 32 ? sc : 31;
#pragma unroll
    for (int ks = 0; ks < 2; ++ks) { r.ka[ks] = *(const GAS bf16x8*)(kstp + (size_t)s * 128 * 64 + 32 * ks); r.vb[0][ks] = *(const GAS bf16x8*)(vtp + 64 * s + 32 * ks); r.vb[1][ks] = *(const GAS bf16x8*)(vtp + (size_t)16 * 2048 + 64 * s + 32 * ks); }
    r.gd = *(const GAS f32x4*)(gdp + s * 128);
}
__device__ __forceinline__ void hg2_step(f32x4 (&st)[2], Hg2Ops& r, GAS bf16* sp) {
    if (sp) {
#pragma unroll
        for (int nt = 0; nt < 2; ++nt) { u32x2 sv; sv.x = pkbf(st[nt][0], st[nt][1]); sv.y = pkbf(st[nt][2], st[nt][3]); *(GAS u32x2*)(sp + (size_t)nt * 16 * 128) = sv; }
    }
#pragma unroll
    for (int nt = 0; nt < 2; ++nt) { st[nt] = st[nt] * r.gd;
#pragma unroll
        for (int ks = 0; ks < 2; ++ks) st[nt] = MFMA16(r.ka[ks], r.vb[nt][ks], st[nt]); }
}
__device__ __forceinline__ void hg2seq_unit(Ctx& C, int b, int h, int vq) {
    const int lane = C.lane, w = C.wave, fr = lane & 15, g = lane >> 4; const int bh = b * 4 + h;
    f32x4 st[2] = {(f32x4){0.f, 0.f, 0.f, 0.f}, (f32x4){0.f, 0.f, 0.f, 0.f}};
    const GAS bf16* kstp = (const GAS bf16*)C_KST + ((size_t)bh * 32 * 128 + 16 * w + fr) * 64 + 8 * g;
    const GAS bf16* vtp = (const GAS bf16*)C_VT0 + ((size_t)(b * 512 + h * 128 + 32 * vq + fr)) * 2048 + 8 * g;
    const GAS float* gdp = (const GAS float*)(C.ws + WS_GD) + (size_t)bh * 32 * 128 + 16 * w + 4 * g;
    const size_t spo = (size_t)(32 * vq + fr) * 128 + 16 * w + 4 * g;
    Hg2Ops r0, r1, r2, r3;
    hg2_load(r0, kstp, vtp, gdp, 0); hg2_load(r1, kstp, vtp, gdp, 1); hg2_load(r2, kstp, vtp, gdp, 2); hg2_load(r3, kstp, vtp, gdp, 3);
    for (int sc = 0; sc < 32; sc += 4) {
        hg2_step(st, r0, sc > 0 ? sst_base(C, b, h, sc) + spo : (GAS bf16*)nullptr); hg2_load(r0, kstp, vtp, gdp, sc + 4); __builtin_amdgcn_sched_barrier(0);
        hg2_step(st, r1, sst_base(C, b, h, sc + 1) + spo); hg2_load(r1, kstp, vtp, gdp, sc + 5); __builtin_amdgcn_sched_barrier(0);
        hg2_step(st, r2, sst_base(C, b, h, sc + 2) + spo); hg2_load(r2, kstp, vtp, gdp, sc + 6); __builtin_amdgcn_sched_barrier(0);
        hg2_step(st, r3, sst_base(C, b, h, sc + 3) + spo); hg2_load(r3, kstp, vtp, gdp, sc + 7); __builtin_amdgcn_sched_barrier(0);
    }
}
__device__ __forceinline__ void hg3_wave_unit(Ctx& C, int b, int h, int sc, int ti) {
    const int lane = C.lane, fr = lane & 15, g = lane >> 4; const bf16* P = C_PROJ; const size_t rs = ODD_IN;
    const size_t m = (size_t)b * SEQ + 64 * sc + 16 * ti + fr;
    u32x2 oi[8], gt[8];
#pragma unroll
    for (int mt = 0; mt < 8; ++mt) { oi[mt] = *(const GAS u32x2*)(C_OI + m * 512 + h * 128 + 16 * mt + 4 * g); gt[mt] = *(const GAS u32x2*)(P + m * rs + O_HG + h * 128 + 16 * mt + 4 * g); }
    f32x4 o[8];
#pragma unroll
    for (int mt = 0; mt < 8; ++mt) o[mt] = (f32x4){0.f, 0.f, 0.f, 0.f};
    if (sc > 0) {
        bf16x8 qf[4];
#pragma unroll
        for (int ks = 0; ks < 4; ++ks) qf[ks] = *(const GAS bf16x8*)(C_XN + m * 512 + h * 128 + 32 * ks + 8 * g);
        const GAS bf16* sp = sst_base(C, b, h, sc) + (size_t)fr * 128 + 8 * g;
#pragma unroll
        for (int hf = 0; hf < 2; ++hf) {
            bf16x8 af[4][4];
#pragma unroll
            for (int mt = 0; mt < 4; ++mt)
#pragma unroll
                for (int ks = 0; ks < 4; ++ks) af[mt][ks] = *(const GAS bf16x8*)(sp + (size_t)(64 * hf + 16 * mt) * 128 + 32 * ks);
#pragma unroll
            for (int mt = 0; mt < 4; ++mt)
#pragma unroll
                for (int ks = 0; ks < 4; ++ks) o[4 * hf + mt] = MFMA16(af[mt][ks], qf[ks], o[4 * hf + mt]);
        }
    }
    float ss = 0.f;
#pragma unroll
    for (int mt = 0; mt < 8; ++mt) { const u32x2 iv = oi[mt];
        o[mt][0] += __uint_as_float(iv.x << 16); o[mt][1] += __uint_as_float(iv.x & 0xffff0000u); o[mt][2] += __uint_as_float(iv.y << 16); o[mt][3] += __uint_as_float(iv.y & 0xffff0000u);
        ss += (o[mt][0] * o[mt][0] + o[mt][1] * o[mt][1]) + (o[mt][2] * o[mt][2] + o[mt][3] * o[mt][3]); }
    ss += __shfl_xor(ss, 16); ss += __shfl_xor(ss, 32);
    const float rstd = rsqrtf(ss * (1.f / 128.f) + EPS);
    bf16* op = C_MIX + m * DM + h * 128 + 4 * g;
#pragma unroll
    for (int mt = 0; mt < 8; ++mt) {
        const u32x2 gv = gt[mt];
        const float g0 = __uint_as_float(gv.x << 16), g1 = __uint_as_float(gv.x & 0xffff0000u), g2 = __uint_as_float(gv.y << 16), g3 = __uint_as_float(gv.y & 0xffff0000u);
        u32x2 ov; ov.x = pkbf(o[mt][0] * rstd * siluf_(g0), o[mt][1] * rstd * siluf_(g1)); ov.y = pkbf(o[mt][2] * rstd * siluf_(g2), o[mt][3] * rstd * siluf_(g3));
        *(GAS u32x2*)(op + 16 * mt) = ov;
    }
}

constexpr int H1_TOT8 = 65280;
__device__ __forceinline__ f32x2_t bf2x(unsigned w) { f32x2_t r; r.x = __uint_as_float(w << 16); r.y = __uint_as_float(w & 0xffff0000u); return r; }
__device__ __forceinline__ f32x2_t exp2x(f32x2_t v) { f32x2_t r; r.x = __expf(v.x); r.y = __expf(v.y); return r; }
__device__ __forceinline__ unsigned pk2x(f32x2_t v) { return pkbf(v.x, v.y); }
__device__ __forceinline__ void hg1_units(Ctx& C, int u0, int nu, int o) {
    const int lane = C.lane, w = C.wave, fr = lane & 15, g = lane >> 4;
    const int i = w >> 1, hf = w & 1, ti = w & 3, vh = w >> 2;
    LAS unsigned char* L = C.lds; const size_t rs = ODD_IN;
    unsigned flr[8], qr_[8];
    {
        const int u = u0, sc = u & 31, bh = u >> 5, b = bh >> 2, h = bh & 3;
        const GAS bf16* src = (const GAS bf16*)C_PROJ + ((size_t)b * SEQ + 64 * sc + 16 * i + 8 * hf) * rs + h * 128 + 2 * lane;
#pragma unroll
        for (int j = 0; j < 8; ++j) { flr[j] = *(const GAS unsigned*)(src + (size_t)j * rs + O_HF); qr_[j] = *(const GAS unsigned*)(src + (size_t)j * rs + O_HQ); }
    }
    for (int un = 0; un < nu; ++un) {
        const int u = u0 + un, sc = u & 31, bh = u >> 5, b = bh >> 2, h = bh & 3;
        s16x4 vlo[4][2], vhi[4][2];
        {
            const GAS bf16* vtb = (const GAS bf16*)C_VT0 + ((size_t)(b * 512 + h * 128 + 64 * vh + fr)) * 2048 + 64 * sc + 4 * g;
#pragma unroll
            for (int mt = 0; mt < 4; ++mt)
#pragma unroll
                for (int kp = 0; kp < 2; ++kp) { vlo[mt][kp] = *(const GAS s16x4*)(vtb + (size_t)mt * 16 * 2048 + 32 * kp); vhi[mt][kp] = *(const GAS s16x4*)(vtb + (size_t)mt * 16 * 2048 + 32 * kp + 16); }
        }
        unsigned fln[8], qn[8];
        {
            const int u2 = (un + 1 < nu) ? u + 1 : u, sc2 = u2 & 31, bh2 = u2 >> 5;
            const GAS bf16* src = (const GAS bf16*)C_PROJ + ((size_t)(bh2 >> 2) * SEQ + 64 * sc2 + 16 * i + 8 * hf) * rs + (bh2 & 3) * 128 + 2 * lane;
#pragma unroll
            for (int j = 0; j < 8; ++j) { fln[j] = *(const GAS unsigned*)(src + (size_t)j * rs + O_HF); qn[j] = *(const GAS unsigned*)(src + (size_t)j * rs + O_HQ); }
        }
        __builtin_amdgcn_sched_barrier(0);
        const f32x2_t lb = *(const GAS f32x2_t*)(C_LB + o * 512 + h * 128 + 2 * lane);
        const f32x2_t omlb = (f32x2_t){1.f, 1.f} - lb;
        f32x2_t c[8], kk[8]; f32x2_t run = {0.f, 0.f};
#pragma unroll
        for (int j = 0; j < 8; ++j) {
            const f32x2_t fl = bf2x(flr[j]); const f32x2_t e = exp2x(-fl);
            f32x2_t sig; sig.x = __builtin_amdgcn_rcpf(1.f + e.x); sig.y = __builtin_amdgcn_rcpf(1.f + e.y);
            const f32x2_t f = lb + omlb * sig;
            run.x += __logf(f.x); run.y += __logf(f.y); c[j] = run; kk[j] = omlb * ((f32x2_t){1.f, 1.f} - sig);
        }
        *(LAS f32x2_t*)(L + H1_TOT8 + (w * 128 + 2 * lane) * 4) = run;
        __syncthreads();
        f32x2_t pt[8];
#pragma unroll
        for (int ww = 0; ww < 8; ++ww) pt[ww] = *(const LAS f32x2_t*)(L + H1_TOT8 + (ww * 128 + 2 * lane) * 4);
        const f32x2_t t0 = pt[0] + pt[1], t1 = pt[2] + pt[3], t2 = pt[4] + pt[5], t3 = pt[6] + pt[7];
        const f32x2_t zz = {0.f, 0.f};
        const f32x2_t toti = i == 0 ? t0 : (i == 1 ? t1 : (i == 2 ? t2 : t3));
        const f32x2_t hb = hf ? (i == 0 ? pt[0] : (i == 1 ? pt[2] : (i == 2 ? pt[4] : pt[6]))) : zz;
        const f32x2_t Bi = (i > 0 ? t0 : zz) + (i > 1 ? t1 : zz) + (i > 2 ? t2 : zz), B4 = (t0 + t1) + (t2 + t3), Bn = Bi + toti;
        const f32x2_t eBi = exp2x(Bi), eEnd = exp2x(B4 - Bn), eD = exp2x(-toti);
        const f32x2_t fx0 = (i == 2) ? exp2x(t1) : ((i == 3) ? exp2x(t2) : zz), fx1 = (i == 3) ? exp2x(t1 + t2) : zz;
        const size_t m0 = (size_t)b * SEQ + 64 * sc + 16 * i + 8 * hf;
        unsigned ks0[4], ks1[4];
#pragma unroll
        for (int j = 0; j < 8; ++j) {
            const f32x2_t cc = hb + c[j];
            const f32x2_t qr = bf2x(qr_[j]) * exp2x(cc), kr = kk[j] * exp2x(toti - cc);
            const int row = 16 * i + 8 * hf + j;
            *(LAS unsigned*)(L + H1_QR + row * 272 + lane * 4) = pk2x(qr);
            *(LAS unsigned*)(L + H1_KR + row * 272 + lane * 4) = pk2x(kr);
            *(LAS unsigned*)(L + H1_KD + row * 272 + lane * 4) = pk2x(kr * eD);
            if (i == 2) *(LAS unsigned*)(L + H1_QX + (8 * hf + j) * 272 + lane * 4) = pk2x(qr * fx0);
            if (i == 3) { *(LAS unsigned*)(L + H1_QX + (16 + 8 * hf + j) * 272 + lane * 4) = pk2x(qr * fx0); *(LAS unsigned*)(L + H1_QX + (32 + 8 * hf + j) * 272 + lane * 4) = pk2x(qr * fx1); }
            *(GAS unsigned*)(C_XN + (m0 + j) * 512 + h * 128 + 2 * lane) = pk2x(qr * eBi);
            const f32x2_t ks = kr * eEnd;
            if (j & 1) { ks0[j >> 1] = pkbf(__uint_as_float(ks0[j >> 1]), ks.x); ks1[j >> 1] = pkbf(__uint_as_float(ks1[j >> 1]), ks.y); }
            else { ks0[j >> 1] = __float_as_uint(ks.x); ks1[j >> 1] = __float_as_uint(ks.y); }
        }
        {
            bf16* kd = C_KST + ((size_t)u * 128 + 2 * lane) * 64 + 16 * i + 8 * hf;
            v4u p0, p1; p0.x = ks0[0]; p0.y = ks0[1]; p0.z = ks0[2]; p0.w = ks0[3]; p1.x = ks1[0]; p1.y = ks1[1]; p1.z = ks1[2]; p1.w = ks1[3];
            *(GAS v4u*)kd = p0; *(GAS v4u*)(kd + 64) = p1;
            if (w == 0) *(GAS f32x2_t*)((float*)(C.ws + WS_GD) + (size_t)u * 128 + 2 * lane) = exp2x(B4);
        }
        __syncthreads();
        f32x4 at[4];
#pragma unroll
        for (int sj = 0; sj < 4; ++sj) {
            at[sj] = (f32x4){0.f, 0.f, 0.f, 0.f};
            if (sj <= ti) {
                const int kbase = (sj == ti) ? H1_KD : H1_KR;
                const int gap = ti - sj;
                const int qbase = (gap <= 1) ? (H1_QR + 16 * ti * 272) : ((ti == 2) ? H1_QX : ((sj == 1) ? (H1_QX + 16 * 272) : (H1_QX + 32 * 272)));
#pragma unroll
                for (int ks = 0; ks < 4; ++ks) {
                    const bf16x8 a = *(const LAS bf16x8*)(L + kbase + (16 * sj + fr) * 272 + (32 * ks + 8 * g) * 2);
                    const bf16x8 bq = *(const LAS bf16x8*)(L + qbase + fr * 272 + (32 * ks + 8 * g) * 2);
                    at[sj] = MFMA16(a, bq, at[sj]);
                }
                if (sj == ti) {
#pragma unroll
                    for (int r = 0; r < 4; ++r) if (4 * g + r > fr) at[sj][r] = 0.f;
                }
            }
        }
        f32x4 oo[4];
#pragma unroll
        for (int mt = 0; mt < 4; ++mt) oo[mt] = (f32x4){0.f, 0.f, 0.f, 0.f};
#pragma unroll
        for (int kp = 0; kp < 2; ++kp) {
            if (2 * kp <= ti) {
                const bf16x8 pf = kp == 0 ? pack8(at[0][0], at[0][1], at[0][2], at[0][3], at[1][0], at[1][1], at[1][2], at[1][3]) : pack8(at[2][0], at[2][1], at[2][2], at[2][3], at[3][0], at[3][1], at[3][2], at[3][3]);
#pragma unroll
                for (int mt = 0; mt < 4; ++mt) oo[mt] = MFMA16(cat4(vlo[mt][kp], vhi[mt][kp]), pf, oo[mt]);
            }
        }
        bf16* op = C_OI + ((size_t)b * SEQ + 64 * sc + 16 * ti + fr) * 512 + h * 128 + 64 * vh + 4 * g;
#pragma unroll
        for (int mt = 0; mt < 4; ++mt) { u32x2 ov; ov.x = pkbf(oo[mt][0], oo[mt][1]); ov.y = pkbf(oo[mt][2], oo[mt][3]); *(GAS u32x2*)(op + 16 * mt) = ov; }
#pragma unroll
        for (int j = 0; j < 8; ++j) { flr[j] = fln[j]; qr_[j] = qn[j]; }
        __syncthreads();
    }
}
__device__ __forceinline__ void odd_phase1(Ctx& C, int o) {
    const int per = (2048 + C.G - 1) / C.G;
    { TIC(C, 13); { const int ub = C.vcu * per, ne = (ub + per <= 2048) ? per : (2048 - ub); if (ne > 0) hg1_units(C, ub, ne, o); } TOC(C, 13); }
    { TIC(C, 14); for (int u = C.vcu; u < 256; u += C.G) lru_pass<0>(C, u >> 4, (u >> 1) & 7, u & 1, o); TOC(C, 14); }
}
__device__ __forceinline__ void odd_phase2(Ctx& C, int o) {
    { TIC(C, 15); for (int u = C.vcu; u < 256; u += C.G) hg2seq_unit(C, u >> 4, (u >> 2) & 3, u & 3); TOC(C, 15); }
    { TIC(C, 16); for (int u = C.vcu; u < 256; u += C.G) lru_pass<1>(C, u >> 4, (u >> 1) & 7, u & 1, o); TOC(C, 16); }
}
__device__ __forceinline__ void odd_phase3(Ctx& C) {
    TIC(C, 12); for (int u = C.vcu * 2 + (C.wave >> 2); u < 2048; u += 2 * C.G) hg3_wave_unit(C, u >> 7, (u >> 5) & 3, u & 31, C.wave & 3); TOC(C, 12);
}

#define C_ROI  ((bf16*)(C.ws + WS_XN))
#define C_RQT  ((bf16*)(C.ws + WS_XN + 32 * MiB))
#define C_RKV  ((float*)(C.ws + WS_KST))
__device__ __forceinline__ void retA_unit(Ctx& C, int b, int h, int c) {
    const int tid = C.tid, lane = C.lane, w = C.wave, fr = lane & 15, g = lane >> 4;
    LAS unsigned char* L = C.lds;
    const bf16* P = C_PROJ; const size_t rs = EVEN_IN;
    const float lg2 = log2f(1.0f - exp2f(-5.0f - (float)h));
    {
        const int tt = tid >> 2, part = tid & 3, t = 128 * c + tt; const size_t m = (size_t)b * SEQ + t;
        float qa[8], qb[8], ka[8], kb[8], cs[8], sn[8];
        unpack8(*(const GAS v4u*)(P + m * rs + E_RQ + h * 64 + 8 * part), qa); unpack8(*(const GAS v4u*)(P + m * rs + E_RQ + h * 64 + 32 + 8 * part), qb);
        unpack8(*(const GAS v4u*)(P + m * rs + E_RK + h * 64 + 8 * part), ka); unpack8(*(const GAS v4u*)(P + m * rs + E_RK + h * 64 + 32 + 8 * part), kb);
        { const f32x4 c0 = *(const GAS f32x4*)(C_TABC + t * 32 + 8 * part), c1 = *(const GAS f32x4*)(C_TABC + t * 32 + 8 * part + 4);
          const f32x4 s0 = *(const GAS f32x4*)(C_TABS + t * 32 + 8 * part), s1 = *(const GAS f32x4*)(C_TABS + t * 32 + 8 * part + 4);
          cs[0] = c0.x; cs[1] = c0.y; cs[2] = c0.z; cs[3] = c0.w; cs[4] = c1.x; cs[5] = c1.y; cs[6] = c1.z; cs[7] = c1.w;
          sn[0] = s0.x; sn[1] = s0.y; sn[2] = s0.z; sn[3] = s0.w; sn[4] = s1.x; sn[5] = s1.y; sn[6] = s1.z; sn[7] = s1.w; }
        const float fq = exp2f((float)tt * lg2), fk = 0.125f * exp2f(-(float)tt * lg2);
        float q1[8], q2[8], k1[8], k2[8];
#pragma unroll
        for (int j = 0; j < 8; ++j) { q1[j] = (qa[j] * cs[j] - qb[j] * sn[j]) * fq; q2[j] = (qa[j] * sn[j] + qb[j] * cs[j]) * fq;
                                      k1[j] = (ka[j] * cs[j] - kb[j] * sn[j]) * fk; k2[j] = (ka[j] * sn[j] + kb[j] * cs[j]) * fk; }
        const bf16x8 pq1 = pack8(q1[0], q1[1], q1[2], q1[3], q1[4], q1[5], q1[6], q1[7]), pq2 = pack8(q2[0], q2[1], q2[2], q2[3], q2[4], q2[5], q2[6], q2[7]);
        *(LAS bf16x8*)(L + RT_Q + tt * 144 + 16 * part) = pq1; *(LAS bf16x8*)(L + RT_Q + tt * 144 + 64 + 16 * part) = pq2;
        *(GAS bf16x8*)(C_RQT + m * 256 + h * 64 + 8 * part) = pq1; *(GAS bf16x8*)(C_RQT + m * 256 + h * 64 + 32 + 8 * part) = pq2;
        *(LAS bf16x8*)(L + RT_K + tt * 144 + 16 * part) = pack8(k1[0], k1[1], k1[2], k1[3], k1[4], k1[5], k1[6], k1[7]);
        *(LAS bf16x8*)(L + RT_K + tt * 144 + 64 + 16 * part) = pack8(k2[0], k2[1], k2[2], k2[3], k2[4], k2[5], k2[6], k2[7]);
#pragma unroll
        for (int j = 0; j < 8; ++j) { *(LAS bf16*)(L + RT_KT + (8 * part + j) * 272 + tt * 2) = (bf16)f2bf(k1[j]); *(LAS bf16*)(L + RT_KT + (32 + 8 * part + j) * 272 + tt * 2) = (bf16)f2bf(k2[j]); }
        const int dv = tid >> 2, seg = tid & 3;
        const bf16* vsrc = C_VT0 + ((size_t)(b * 512 + h * 128 + dv)) * 2048 + 128 * c + seg * 32;
#pragma unroll
        for (int i = 0; i < 4; ++i) *(LAS v4u*)(L + RT_V + dv * 272 + (seg * 32 + 8 * i) * 2) = *(const GAS v4u*)(vsrc + 8 * i);
    }
    __syncthreads();
    bf16x8 qf[2];
#pragma unroll
    for (int ks = 0; ks < 2; ++ks) qf[ks] = *(const LAS bf16x8*)(L + RT_Q + (16 * w + fr) * 144 + (32 * ks + 8 * g) * 2);
    f32x4 o[8];
#pragma unroll
    for (int mt = 0; mt < 8; ++mt) o[mt] = (f32x4){0.f, 0.f, 0.f, 0.f};
#pragma unroll
    for (int kp = 0; kp < 4; ++kp) {
        if (kp <= (w >> 1)) {
            f32x4 s0 = (f32x4){0.f, 0.f, 0.f, 0.f}, s1 = (f32x4){0.f, 0.f, 0.f, 0.f};
#pragma unroll
            for (int ks = 0; ks < 2; ++ks) {
                const bf16x8 a0 = *(const LAS bf16x8*)(L + RT_K + (32 * kp + fr) * 144 + (32 * ks + 8 * g) * 2);
                const bf16x8 a1 = *(const LAS bf16x8*)(L + RT_K + (32 * kp + 16 + fr) * 144 + (32 * ks + 8 * g) * 2);
                s0 = MFMA16(a0, qf[ks], s0); s1 = MFMA16(a1, qf[ks], s1);
            }
            const int tq = 16 * w + fr;
#pragma unroll
            for (int r = 0; r < 4; ++r) { if (32 * kp + 4 * g + r > tq) s0[r] = 0.f; if (32 * kp + 16 + 4 * g + r > tq) s1[r] = 0.f; }
            const bf16x8 pf = pack8(s0[0], s0[1], s0[2], s0[3], s1[0], s1[1], s1[2], s1[3]);
#pragma unroll
            for (int mt = 0; mt < 8; ++mt) {
                const s16x4 lo = *(const LAS s16x4*)(L + RT_V + (16 * mt + fr) * 272 + (32 * kp + 4 * g) * 2);
                const s16x4 hi = *(const LAS s16x4*)(L + RT_V + (16 * mt + fr) * 272 + (32 * kp + 16 + 4 * g) * 2);
                o[mt] = MFMA16(cat4(lo, hi), pf, o[mt]);
            }
        }
    }
    {
        bf16* op = C_ROI + ((size_t)b * SEQ + 128 * c + 16 * w + fr) * 512 + h * 128 + 4 * g;
#pragma unroll
        for (int mt = 0; mt < 8; ++mt) { u32x2 ov; ov.x = pkbf(o[mt][0], o[mt][1]); ov.y = pkbf(o[mt][2], o[mt][3]); *(GAS u32x2*)(op + 16 * mt) = ov; }
    }
    f32x4 kv[4];
#pragma unroll
    for (int nt = 0; nt < 4; ++nt) kv[nt] = (f32x4){0.f, 0.f, 0.f, 0.f};
#pragma unroll
    for (int ks = 0; ks < 4; ++ks) {
        const bf16x8 av = *(const LAS bf16x8*)(L + RT_V + (16 * w + fr) * 272 + (32 * ks + 8 * g) * 2);
#pragma unroll
        for (int nt = 0; nt < 4; ++nt) kv[nt] = MFMA16(av, *(const LAS bf16x8*)(L + RT_KT + (16 * nt + fr) * 272 + (32 * ks + 8 * g) * 2), kv[nt]);
    }
    {
        float* kp = C_RKV + ((size_t)((b * 4 + h) * 16 + c)) * 8192 + (size_t)(16 * w + 4 * g) * 64 + fr;
#pragma unroll
        for (int nt = 0; nt < 4; ++nt)
#pragma unroll
            for (int r = 0; r < 4; ++r) kp[r * 64 + 16 * nt] = kv[nt][r];
    }
    __syncthreads();
}
__device__ __forceinline__ void retB_unit(Ctx& C, int b, int h, int c) {
    const int tid = C.tid, lane = C.lane, w = C.wave, fr = lane & 15, g = lane >> 4;
    LAS unsigned char* L = C.lds;
    const bf16* P = C_PROJ; const size_t rs = EVEN_IN;
    const float lg2 = log2f(1.0f - exp2f(-5.0f - (float)h));
    const size_t m = (size_t)b * SEQ + 128 * c + 16 * w + fr;
    bf16x8 qf[2]; u32x2 oi[8], gt[8];
#pragma unroll
    for (int ks = 0; ks < 2; ++ks) qf[ks] = *(const GAS bf16x8*)(C_RQT + m * 256 + h * 64 + 32 * ks + 8 * g);
#pragma unroll
    for (int mt = 0; mt < 8; ++mt) { oi[mt] = *(const GAS u32x2*)(C_ROI + m * 512 + h * 128 + 16 * mt + 4 * g); gt[mt] = *(const GAS u32x2*)(P + m * rs + E_RG + h * 128 + 16 * mt + 4 * g); }
    {
        f32x4 acc[4];
#pragma unroll
        for (int i = 0; i < 4; ++i) acc[i] = (f32x4){0.f, 0.f, 0.f, 0.f};
        const float* kvb = C_RKV + ((size_t)((b * 4 + h) * 16)) * 8192 + tid * 16;
        for (int mm = 0; mm < c; ++mm) { const float f = exp2f(128.0f * (float)(c - mm) * lg2);
#pragma unroll
            for (int i = 0; i < 4; ++i) acc[i] += *(const GAS f32x4*)(kvb + (size_t)mm * 8192 + 4 * i) * f; }
        const int dv = tid >> 2, dk0 = (tid & 3) * 16;
        *(LAS bf16x8*)(L + RT_S + dv * 144 + dk0 * 2) = pack8(acc[0][0], acc[0][1], acc[0][2], acc[0][3], acc[1][0], acc[1][1], acc[1][2], acc[1][3]);
        *(LAS bf16x8*)(L + RT_S + dv * 144 + dk0 * 2 + 16) = pack8(acc[2][0], acc[2][1], acc[2][2], acc[2][3], acc[3][0], acc[3][1], acc[3][2], acc[3][3]);
    }
    __syncthreads();
    f32x4 o[8];
#pragma unroll
    for (int mt = 0; mt < 8; ++mt) { o[mt] = (f32x4){0.f, 0.f, 0.f, 0.f};
#pragma unroll
        for (int ks = 0; ks < 2; ++ks) o[mt] = MFMA16(*(const LAS bf16x8*)(L + RT_S + (16 * mt + fr) * 144 + (32 * ks + 8 * g) * 2), qf[ks], o[mt]); }
    float ss = 0.f;
#pragma unroll
    for (int mt = 0; mt < 8; ++mt) { const u32x2 iv = oi[mt];
        o[mt][0] += __uint_as_float(iv.x << 16); o[mt][1] += __uint_as_float(iv.x & 0xffff0000u); o[mt][2] += __uint_as_float(iv.y << 16); o[mt][3] += __uint_as_float(iv.y & 0xffff0000u);
        ss += (o[mt][0] * o[mt][0] + o[mt][1] * o[mt][1]) + (o[mt][2] * o[mt][2] + o[mt][3] * o[mt][3]); }
    ss += __shfl_xor(ss, 16); ss += __shfl_xor(ss, 32);
    const float rstd = rsqrtf(ss * (1.f / 128.f) + EPS);
#pragma unroll
    for (int mt = 0; mt < 8; ++mt) {
        const u32x2 gv = gt[mt];
        const float g0 = __uint_as_float(gv.x << 16), g1 = __uint_as_float(gv.x & 0xffff0000u), g2 = __uint_as_float(gv.y << 16), g3 = __uint_as_float(gv.y & 0xffff0000u);
        u32x2 ov; ov.x = pkbf(o[mt][0] * rstd * siluf_(g0), o[mt][1] * rstd * siluf_(g1)); ov.y = pkbf(o[mt][2] * rstd * siluf_(g2), o[mt][3] * rstd * siluf_(g3));
        *(GAS u32x2*)(C_MIX + m * DM + h * 128 + 16 * mt + 4 * g) = ov;
    }
    __syncthreads();
}
__device__ __forceinline__ void sb_static(Ctx& C, int i0, int i1) {
    const int gw = C.vcu * NWAVES + C.wave, NGW = C.G * NWAVES;
    for (int i = i0; i < i1; ++i)
        for (int u = gw + i * 2048; u < (i + 1) * 2048; u += NGW) { const int qblk = u >> 7, bh = u & 127; sb_wave_unit(C, bh >> 3, bh & 7, qblk); }
}
#ifndef SB_I1
#define SB_I1 2
#endif
__device__ __forceinline__ void even_phase1(Ctx& C, int li) {
    { TIC(C, 20); for (int u = C.vcu; u < 1024; u += C.G) retA_unit(C, u >> 6, (u >> 4) & 3, u & 15); TOC(C, 20); }
    { TIC(C, 21); sb_static(C, 0, SB_I1); TOC(C, 21); }
}
__device__ __forceinline__ void even_phase2(Ctx& C, int li) {
    { TIC(C, 22); for (int u = C.vcu; u < 1024; u += C.G) retB_unit(C, u >> 6, (u >> 4) & 3, u & 15); TOC(C, 22); }
    if (SB_I1 < 4) { TIC(C, 23); sb_static(C, SB_I1, 4); TOC(C, 23); }
}
#ifndef REP_GEMM
#define REP_GEMM 1
#endif
#ifndef REP_EVEN
#define REP_EVEN 1
#endif
#ifndef REP_ODD
#define REP_ODD 1
#endif
__global__ void __launch_bounds__(NWAVES * 64, 2) mega_fwd(Params prm) {
    extern __shared__ __attribute__((aligned(16))) unsigned char lds_raw[];
    Ctx C0;
    Ctx& C = C0;
    C.lds = (LAS unsigned char*)lds_raw;
    volatile LAS unsigned* MISC = (volatile LAS unsigned*)(C.lds + LDSCTL_OFF);
    C.tid = threadIdx.x; C.lane = C.tid & 63; C.wave = __builtin_amdgcn_readfirstlane(C.tid >> 6);
    C.G = gridDim.x; { const int bx = blockIdx.x; C.vcu = (C.G % 8 == 0) ? (bx % 8) * (C.G / 8) + bx / 8 : bx; }
    C.ws = (GAS unsigned char*)prm.ws;
    gu32* ctl = (gu32*)((GAS unsigned char*)prm.ws + WS_CTL);
    for (int u = C.tid; u < (LDS_BYTES - LDSCTL_OFF) / 4; u += NWAVES * 64) ((LAS unsigned*)(C.lds + LDSCTL_OFF))[u] = 0u;
    __syncthreads();
    XcdBarrier bar = xcd_barrier_post((unsigned*)(ctl + CW_BAR), MISC + 8);
    const unsigned my_xcc = bar.x;
#define GRID_BAR() do { GAS unsigned char* wsb_ = C0.ws; asm volatile("" : "+s"(wsb_)); XcdBarrier bb_; bb_.bar = (unsigned*)(wsb_ + WS_CTL) + CW_BAR; bb_.x = my_xcc; bb_.st = (volatile LAS unsigned*)(C0.lds + LDSCTL_OFF) + 8; TIC(C0, 7); xcd_barrier(bb_); TOC(C0, 7); } while (0)
#define FRESH() Ctx C = C0; asm volatile("" : "+v"(C.tid)); C.lane = C.tid & 63; C.wave = __builtin_amdgcn_readfirstlane(C.tid >> 6); asm volatile("" : "+s"(C.ws)); asm volatile("" : "+s"(C.vcu))

    { FRESH(); TIC(C, 6); p0_prologue(C); TOC(C, 6); }
    GRID_BAR();

    for (int L = 0; L < 4; ++L) {
        const bool even = (L & 1) == 0; const int li = L >> 1;
        for (int rep = 0; rep < REP_GEMM; ++rep) { if (rep) GRID_BAR(); FRESH();
            const int N = even ? EVEN_IN : ODD_IN;
            const size_t woff = (L == 0) ? WS_WIN0 : (L == 1) ? WS_WIN1 : (L == 2) ? WS_WIN2 : WS_WIN3;
            pg8::Gemm g{C_XN, (const bf16*)(C.ws + woff), MTOK, N, DM}; pg8::StaticOrder S; S.init(MTOK, N, C.G, (int)blockIdx.x);
            pg8::EpiProj E{C_PROJ, N, C_VT0, even ? E_RV : O_HI, C_VT1, even ? E_SV : -100000, 1};
            TIC(C, 8); pg8::gemm_phase<pg8::EpiProj, pg8::StaticOrder, true, true>(C.lds, g, S, E); TOC(C, 8);
        }
        GRID_BAR();
        if (even) { { FRESH(); even_phase1(C, li); } GRID_BAR(); { FRESH(); even_phase2(C, li); } GRID_BAR(); }
        else { for (int rep = 0; rep < REP_ODD; ++rep) { { FRESH(); odd_phase1(C, li); } GRID_BAR(); { FRESH(); odd_phase2(C, li); } GRID_BAR(); { FRESH(); odd_phase3(C); } GRID_BAR(); } }
        for (int rep = 0; rep < REP_GEMM; ++rep) { if (rep) GRID_BAR(); FRESH();
            pg8::Gemm g{C_MIX, (const bf16*)(C.ws + WS_WOUT + (size_t)L * 2 * MiB), MTOK, DM, DM}; pg8::StaticOrder S; S.init(MTOK, DM, C.G, (int)blockIdx.x);
            pg8::EpiProj E{C_PROJ, DM, nullptr, -100000, nullptr, -100000, 1};
            pg8::gemm_phase<pg8::EpiProj, pg8::StaticOrder, true, true>(C.lds, g, S, E);
        }
        GRID_BAR();
        { FRESH(); TIC(C, 5); norm_rows_phase(C, C_PROJ, L == 0 ? IN(0) : OUTP(), IN(2) + (size_t)L * DM, L < 3 ? IN(1) + (size_t)(L + 1) * DM : nullptr); TOC(C, 5); }
        if (L < 3) GRID_BAR();
    }
    if (TSCALE && blockIdx.x == 0 && C0.tid == 0) { const unsigned acc = *TWORD(C0); const long long t0 = (long long)__builtin_amdgcn_s_memrealtime(); while ((long long)__builtin_amdgcn_s_memrealtime() - t0 < (long long)acc * TSCALE) __builtin_amdgcn_s_sleep(8); }
}

extern "C" void kernel_launch(void* const* d_in, const int* in_sizes, int n_in, void* d_out, int out_size, void* d_ws, size_t ws_size, hipStream_t stream) {
    static int grid = 0;
    if (grid == 0) {
        if (n_in != 15 || in_sizes[0] != MTOK * DM || out_size != MTOK * DM || ws_size < WS_END) { fprintf(stderr, "kernel_launch: unexpected shapes (n_in %d, in0 %d, out %d, ws %zu)\n", n_in, n_in > 0 ? in_sizes[0] : -1, out_size, ws_size); grid = -1; return; }
        int dev = 0, cus = 0, per_cu = 0;
        if (hipGetDevice(&dev) != hipSuccess || hipDeviceGetAttribute(&cus, hipDeviceAttributeMultiprocessorCount, dev) != hipSuccess) { grid = -1; return; }
        if (hipFuncSetAttribute((const void*)mega_fwd, hipFuncAttributeMaxDynamicSharedMemorySize, LDS_BYTES) != hipSuccess) { fprintf(stderr, "kernel_launch: hipFuncSetAttribute failed\n"); grid = -1; return; }
        if (hipOccupancyMaxActiveBlocksPerMultiprocessor(&per_cu, (const void*)mega_fwd, NWAVES * 64, LDS_BYTES) != hipSuccess || per_cu < 1) { fprintf(stderr, "kernel_launch: occupancy query reports %d blocks per CU\n", per_cu); (void)hipGetLastError(); per_cu = 1; }
        grid = cus;
    }
    if (grid < 0) return;
    if (hipMemsetAsync((char*)d_ws + WS_CTL, 0, CTL_ZERO_BYTES, stream) != hipSuccess) { fprintf(stderr, "kernel_launch: memset failed\n"); return; }
    Params a{};
    for (int i = 0; i < 15; ++i) a.in[i] = (const float*)d_in[i];
    a.out = (float*)d_out; a.ws = (unsigned char*)d_ws;
    hipLaunchKernelGGL(mega_fwd, dim3(grid), dim3(NWAVES * 64), LDS_BYTES, stream, a);
    const hipError_t le = hipPeekAtLastError();
    if (le != hipSuccess) fprintf(stderr, "kernel_launch: launch failed: %s\n", hipGetErrorName(le));
}
```
